# Optimizing an MI355X kernel written in HIP

```python
import jax, jax.numpy as jnp
from jax import lax
import numpy as np

D_MODEL = 1024
BATCH = 8
SEQ = 2048
DEPTH = 2
DEC_BATCH = 128
DEC_SEQ = 8
PAST_LEN = 8192
PAGE_SIZE = 128

N_MIXERS = 2
N_ATTN_LAYERS = (DEPTH + N_MIXERS - 1) // N_MIXERS
N_REC_LAYERS = DEPTH // N_MIXERS
N_HEADS = 16
QK_NOPE = 64
QK_ROPE = 32
V_HEAD = 64
Q_LORA = 512
KV_LORA = 256
ROPE_THETA = 10000.0
SOFTMAX_SCALE = (QK_NOPE + QK_ROPE) ** -0.5
Q_BLOCK = 128
LRU_WIDTH = D_MODEL
N_LRU_BLOCKS = 8
LRU_BLOCK = LRU_WIDTH // N_LRU_BLOCKS
LRU_C = 8.0
REC_CONV_W = 4
D_FF = 3 * D_MODEL
FFN_CONV_W = 3
EPS = 1e-6

kernel_name = "hybrid_mla_rglru_convffn_step"


def rmsnorm(x, g):
    xf = x.astype(jnp.float32)
    y = xf * lax.rsqrt(jnp.mean(xf * xf, axis=-1, keepdims=True) + EPS)
    return (y * g.astype(jnp.float32)).astype(x.dtype)


def rope_cos_sin(pos):
    inv = ROPE_THETA ** (-jnp.arange(0, QK_ROPE, 2, dtype=jnp.float32) / QK_ROPE)
    ang = pos.astype(jnp.float32)[:, None] * inv[None, :]
    return jnp.cos(ang), jnp.sin(ang)


def apply_rope(x, cos, sin):
    half = x.shape[-1] // 2
    x1 = x[..., :half].astype(jnp.float32)
    x2 = x[..., half:].astype(jnp.float32)
    return jnp.concatenate([x1 * cos - x2 * sin, x1 * sin + x2 * cos], axis=-1).astype(x.dtype)


def causal_dwconv(x, buf, w, b):
    t = x.shape[1]
    width = w.shape[0]
    xp = jnp.concatenate([buf.astype(x.dtype), x], axis=1)
    y = xp[:, 0:t] * w[0] + b
    for k in range(1, width):
        y = y + xp[:, k:k + t] * w[k]
    return y, xp[:, t:]


def block_diag(x, w, b):
    xb = x.reshape(x.shape[:-1] + (N_LRU_BLOCKS, LRU_BLOCK))
    y = jnp.einsum('btnc,ncd->btnd', xb, w) + b
    return y.reshape(x.shape)


def rglru(x, h0, w_a, b_a, w_i, b_i, lam):
    r = jax.nn.sigmoid(block_diag(x, w_a, b_a).astype(jnp.float32))
    gi = jax.nn.sigmoid(block_diag(x, w_i, b_i).astype(jnp.float32))
    log_a = -LRU_C * r * jax.nn.softplus(-lam.astype(jnp.float32))
    a = jnp.exp(log_a)
    bx = jnp.sqrt(-jnp.expm1(2.0 * log_a)) * (gi * x.astype(jnp.float32))

    def step(h, inp):
        a_t, b_t = inp
        h = a_t * h + b_t
        return h, h

    h_last, hs = lax.scan(step, h0.astype(jnp.float32), (jnp.moveaxis(a, 1, 0), jnp.moveaxis(bx, 1, 0)))
    return jnp.moveaxis(hs, 0, 1).astype(x.dtype), h_last.astype(x.dtype)


def recurrent_mixer(xn, h0, conv_buf, w_in, conv_w, conv_b, w_a, b_a, w_i, b_i, lam, w_out):
    z = xn @ w_in
    xr, gate_in = z[..., :LRU_WIDTH], z[..., LRU_WIDTH:]
    gate = jax.nn.gelu(gate_in, approximate=True)
    xc, new_buf = causal_dwconv(xr, conv_buf, conv_w, conv_b)
    y, h_last = rglru(xc, h0, w_a, b_a, w_i, b_i, lam)
    return (y * gate) @ w_out, h_last, new_buf


def conv_ffn(xn, buf, w_up, conv_w, conv_b, w_down):
    gu = xn @ w_up
    g, u = gu[..., :D_FF], gu[..., D_FF:]
    gc, new_buf = causal_dwconv(g, buf, conv_w, conv_b)
    return (jax.nn.silu(gc) * u) @ w_down, new_buf


def mla_project(xn, pos, w_down, g_q_lora, w_uq, g_kv_lora, g_qn, g_qr, g_kr):
    b, t = xn.shape[:2]
    d = xn @ w_down
    cq = rmsnorm(d[..., :Q_LORA], g_q_lora)
    c_kv = rmsnorm(d[..., Q_LORA:Q_LORA + KV_LORA], g_kv_lora)
    kr = d[..., Q_LORA + KV_LORA:]
    q = (cq @ w_uq).reshape(b, t, N_HEADS, QK_NOPE + QK_ROPE)
    cos, sin = rope_cos_sin(pos)
    q_nope = rmsnorm(q[..., :QK_NOPE], g_qn)
    q_rope = apply_rope(rmsnorm(q[..., QK_NOPE:], g_qr), cos[:, None], sin[:, None])
    k_rope = apply_rope(rmsnorm(kr, g_kr), cos, sin)
    return q_nope, q_rope, c_kv, k_rope


def mla_prompt(q_nope, q_rope, c_kv, k_rope, w_uk, w_uv, g_kn):
    b, t = c_kv.shape[:2]
    k_nope = rmsnorm(jnp.einsum('btc,chd->bthd', c_kv, w_uk), g_kn)
    v = jnp.einsum('btc,chd->bthd', c_kv, w_uv)
    key_pos = jnp.arange(t)

    def attend_block(i):
        start = i * Q_BLOCK
        qn = lax.dynamic_slice_in_dim(q_nope, start, Q_BLOCK, axis=1)
        qr = lax.dynamic_slice_in_dim(q_rope, start, Q_BLOCK, axis=1)
        s = jnp.einsum('bqhd,bkhd->bhqk', qn, k_nope) + jnp.einsum('bqhr,bkr->bhqk', qr, k_rope)
        q_pos = start + jnp.arange(Q_BLOCK)
        mask = key_pos[None, :] <= q_pos[:, None]
        p = jax.nn.softmax(jnp.where(mask, s.astype(jnp.float32) * SOFTMAX_SCALE, -jnp.inf), axis=-1)
        return jnp.einsum('bhqk,bkhd->bqhd', p.astype(v.dtype), v)

    o = lax.map(attend_block, jnp.arange(t // Q_BLOCK))
    return jnp.moveaxis(o, 0, 1).reshape(b, t, N_HEADS * V_HEAD)


def mla_sample(q_nope, q_rope, c_kv, k_rope, page_table, cache_ckv, cache_krope, layer, w_uk, w_uv, g_kn):
    s_new = c_kv.shape[1]
    past = page_table.shape[1] * PAGE_SIZE
    key_pos = jnp.arange(past + s_new)
    q_pos = past + jnp.arange(s_new)
    mask = key_pos[None, :] <= q_pos[:, None]

    def attend_seq(args):
        pt, qn, qr, cn, krn = args
        c_all = jnp.concatenate([cache_ckv[layer, pt].reshape(past, KV_LORA).astype(cn.dtype), cn], axis=0)
        kr_all = jnp.concatenate([cache_krope[layer, pt].reshape(past, QK_ROPE).astype(krn.dtype), krn], axis=0)
        k_nope = rmsnorm(jnp.einsum('lc,chd->lhd', c_all, w_uk), g_kn)
        s = jnp.einsum('qhd,lhd->hql', qn, k_nope) + jnp.einsum('qhr,lr->hql', qr, kr_all)
        p = jax.nn.softmax(jnp.where(mask[None], s.astype(jnp.float32) * SOFTMAX_SCALE, -jnp.inf), axis=-1)
        ctx = jnp.einsum('hql,lc->qhc', p.astype(c_all.dtype), c_all)
        return jnp.einsum('qhc,chd->qhd', ctx, w_uv).reshape(s_new, N_HEADS * V_HEAD)

    return lax.map(attend_seq, (page_table, q_nope, q_rope, c_kv, k_rope))


def setup_inputs(seed: int = 0) -> dict:
    key = jax.random.key(seed)
    ks = iter(jax.random.split(key, 48))

    def nrm(shape, scale):
        return jax.random.normal(next(ks), shape, jnp.float32) * scale

    def gain(shape):
        return 1.0 + nrm(shape, 0.02)

    n_pages = PAST_LEN // PAGE_SIZE
    n_used = DEC_BATCH * n_pages
    n_pool = n_used + max(1, n_used // 4)
    page_table = jax.random.permutation(next(ks), n_pool)[:n_used].astype(jnp.int32).reshape(DEC_BATCH, n_pages)

    u = jax.random.uniform(next(ks), (N_REC_LAYERS, LRU_WIDTH), jnp.float32, 0.9, 0.999)
    s_lam = u ** (1.0 / LRU_C)
    rec_lambda = jnp.log(s_lam / (1.0 - s_lam))

    return {
        "x_prompt": nrm((BATCH, SEQ, D_MODEL), 1.0),
        "x_sample": nrm((DEC_BATCH, DEC_SEQ, D_MODEL), 1.0),
        "cache_ckv": nrm((N_ATTN_LAYERS, n_pool, PAGE_SIZE, KV_LORA), 1.0),
        "cache_krope": nrm((N_ATTN_LAYERS, n_pool, PAGE_SIZE, QK_ROPE), 1.0),
        "page_table": page_table,
        "state_lru_h": nrm((N_REC_LAYERS, DEC_BATCH, LRU_WIDTH), 0.5),
        "state_lru_conv": nrm((N_REC_LAYERS, DEC_BATCH, REC_CONV_W - 1, LRU_WIDTH), 1.0),
        "state_ffn_conv": nrm((DEPTH, DEC_BATCH, FFN_CONV_W - 1, D_FF), 1.0),
        "norm_mix": gain((DEPTH, D_MODEL)),
        "norm_ffn": gain((DEPTH, D_MODEL)),
        "attn_w_down": nrm((N_ATTN_LAYERS, D_MODEL, Q_LORA + KV_LORA + QK_ROPE), D_MODEL ** -0.5),
        "attn_g_q_lora": gain((N_ATTN_LAYERS, Q_LORA)),
        "attn_w_uq": nrm((N_ATTN_LAYERS, Q_LORA, N_HEADS * (QK_NOPE + QK_ROPE)), Q_LORA ** -0.5),
        "attn_g_kv_lora": gain((N_ATTN_LAYERS, KV_LORA)),
        "attn_g_qn": gain((N_ATTN_LAYERS, QK_NOPE)),
        "attn_g_qr": gain((N_ATTN_LAYERS, QK_ROPE)),
        "attn_g_kn": gain((N_ATTN_LAYERS, QK_NOPE)),
        "attn_g_kr": gain((N_ATTN_LAYERS, QK_ROPE)),
        "attn_w_uk": nrm((N_ATTN_LAYERS, KV_LORA, N_HEADS, QK_NOPE), KV_LORA ** -0.5),
        "attn_w_uv": nrm((N_ATTN_LAYERS, KV_LORA, N_HEADS, V_HEAD), KV_LORA ** -0.5),
        "attn_w_o": nrm((N_ATTN_LAYERS, N_HEADS * V_HEAD, D_MODEL), (N_HEADS * V_HEAD) ** -0.5),
        "rec_w_in": nrm((N_REC_LAYERS, D_MODEL, 2 * LRU_WIDTH), D_MODEL ** -0.5),
        "rec_conv_w": nrm((N_REC_LAYERS, REC_CONV_W, LRU_WIDTH), REC_CONV_W ** -0.5),
        "rec_conv_b": nrm((N_REC_LAYERS, LRU_WIDTH), 0.01),
        "rec_w_a": nrm((N_REC_LAYERS, N_LRU_BLOCKS, LRU_BLOCK, LRU_BLOCK), LRU_BLOCK ** -0.5),
        "rec_b_a": nrm((N_REC_LAYERS, N_LRU_BLOCKS, LRU_BLOCK), 0.01),
        "rec_w_i": nrm((N_REC_LAYERS, N_LRU_BLOCKS, LRU_BLOCK, LRU_BLOCK), LRU_BLOCK ** -0.5),
        "rec_b_i": nrm((N_REC_LAYERS, N_LRU_BLOCKS, LRU_BLOCK), 0.01),
        "rec_lambda": rec_lambda,
        "rec_w_out": nrm((N_REC_LAYERS, LRU_WIDTH, D_MODEL), LRU_WIDTH ** -0.5),
        "ffn_w_up": nrm((DEPTH, D_MODEL, 2 * D_FF), D_MODEL ** -0.5),
        "ffn_conv_w": nrm((DEPTH, FFN_CONV_W, D_FF), FFN_CONV_W ** -0.5),
        "ffn_conv_b": nrm((DEPTH, D_FF), 0.01),
        "ffn_w_down": nrm((DEPTH, D_FF, D_MODEL), D_FF ** -0.5),
    }


def reference(x_prompt, x_sample, cache_ckv, cache_krope, page_table, state_lru_h, state_lru_conv, state_ffn_conv,
              norm_mix, norm_ffn, attn_w_down, attn_g_q_lora, attn_w_uq, attn_g_kv_lora, attn_g_qn, attn_g_qr,
              attn_g_kn, attn_g_kr, attn_w_uk, attn_w_uv, attn_w_o, rec_w_in, rec_conv_w, rec_conv_b, rec_w_a,
              rec_b_a, rec_w_i, rec_b_i, rec_lambda, rec_w_out, ffn_w_up, ffn_conv_w, ffn_conv_b, ffn_w_down):
    bp, tp = x_prompt.shape[:2]
    bs, ts = x_sample.shape[:2]
    past = page_table.shape[1] * PAGE_SIZE
    pos_p = jnp.arange(tp)
    pos_s = past + jnp.arange(ts)
    xp, xs = x_prompt, x_sample
    ckv_p, kr_p, ckv_s, kr_s = [], [], [], []
    lh_p, lh_s, lc_p, lc_s = [], [], [], []
    fc_p, fc_s = [], []
    for i in range(DEPTH):
        j = i // N_MIXERS
        hp = rmsnorm(xp, norm_mix[i])
        hs = rmsnorm(xs, norm_mix[i])
        if i % N_MIXERS == 0:
            proj = (attn_w_down[j], attn_g_q_lora[j], attn_w_uq[j], attn_g_kv_lora[j], attn_g_qn[j], attn_g_qr[j], attn_g_kr[j])
            qn_p, qr_p, c_p, k_p = mla_project(hp, pos_p, *proj)
            qn_s, qr_s, c_s, k_s = mla_project(hs, pos_s, *proj)
            o_p = mla_prompt(qn_p, qr_p, c_p, k_p, attn_w_uk[j], attn_w_uv[j], attn_g_kn[j])
            o_s = mla_sample(qn_s, qr_s, c_s, k_s, page_table, cache_ckv, cache_krope, j,
                             attn_w_uk[j], attn_w_uv[j], attn_g_kn[j])
            xp = xp + o_p @ attn_w_o[j]
            xs = xs + o_s @ attn_w_o[j]
            ckv_p.append(c_p)
            kr_p.append(k_p)
            ckv_s.append(c_s)
            kr_s.append(k_s)
        else:
            rec = (rec_w_in[j], rec_conv_w[j], rec_conv_b[j], rec_w_a[j], rec_b_a[j], rec_w_i[j], rec_b_i[j],
                   rec_lambda[j], rec_w_out[j])
            h0_p = jnp.zeros((bp, LRU_WIDTH), xp.dtype)
            buf0_p = jnp.zeros((bp, REC_CONV_W - 1, LRU_WIDTH), xp.dtype)
            o_p, h_p, cv_p = recurrent_mixer(hp, h0_p, buf0_p, *rec)
            o_s, h_s, cv_s = recurrent_mixer(hs, state_lru_h[j], state_lru_conv[j], *rec)
            xp = xp + o_p
            xs = xs + o_s
            lh_p.append(h_p)
            lh_s.append(h_s)
            lc_p.append(cv_p)
            lc_s.append(cv_s)
        gp = rmsnorm(xp, norm_ffn[i])
        gs = rmsnorm(xs, norm_ffn[i])
        fbuf0_p = jnp.zeros((bp, FFN_CONV_W - 1, D_FF), xp.dtype)
        f_p, fb_p = conv_ffn(gp, fbuf0_p, ffn_w_up[i], ffn_conv_w[i], ffn_conv_b[i], ffn_w_down[i])
        f_s, fb_s = conv_ffn(gs, state_ffn_conv[i], ffn_w_up[i], ffn_conv_w[i], ffn_conv_b[i], ffn_w_down[i])
        xp = xp + f_p
        xs = xs + f_s
        fc_p.append(fb_p)
        fc_s.append(fb_s)
    return (xp, xs, jnp.stack(ckv_p), jnp.stack(kr_p), jnp.stack(ckv_s), jnp.stack(kr_s),
            jnp.stack(lh_p), jnp.stack(lh_s), jnp.stack(lc_p), jnp.stack(lc_s), jnp.stack(fc_p), jnp.stack(fc_s))
```

```cpp
#include <hip/hip_runtime.h>
#include <cstdio>
#include <cstdint>

constexpr int D = 1024, MP = 16384, MS = 1024, M = MP + MS, T = 2048, NBATCH = 8, NSEQ = 128, DSEQ = 8, PAST = 8192, PAGE = 128, NPAGES = 64;
constexpr int NH = 16, QKN = 64, QKR = 32, QKD = 96, VH = 64, QL = 512, KVL = 256, DFF = 3072, NLB = 8, LB = 128;
constexpr float EPS = 1e-6f;
constexpr float QSCALE = 0.10206207261596577f * 1.4426950408889634f;
constexpr int NSPLIT = 2;
constexpr int NROPE = T + DSEQ;

constexpr size_t OFF_YP = 0, OFF_YS = OFF_YP + (size_t)MP * D, OFF_CKVP = OFF_YS + (size_t)MS * D, OFF_KRP = OFF_CKVP + (size_t)MP * KVL,
                 OFF_CKVS = OFF_KRP + (size_t)MP * QKR, OFF_KRS = OFF_CKVS + (size_t)MS * KVL, OFF_LHP = OFF_KRS + (size_t)MS * QKR,
                 OFF_LHS = OFF_LHP + (size_t)NBATCH * D, OFF_LCP = OFF_LHS + (size_t)NSEQ * D, OFF_LCS = OFF_LCP + (size_t)NBATCH * 3 * D,
                 OFF_FCP = OFF_LCS + (size_t)NSEQ * 3 * D, OFF_FCS = OFF_FCP + (size_t)2 * NBATCH * 2 * DFF, OUT_TOTAL = OFF_FCS + (size_t)2 * NSEQ * 2 * DFF;
static_assert(OUT_TOTAL == 25067520, "output size");

enum { I_XP = 0, I_XS, I_CCKV, I_CKR, I_PT, I_SLH, I_SLC, I_SFC, I_NMIX, I_NFFN, I_WD, I_GQL, I_WUQ, I_GKV, I_GQN, I_GQR, I_GKN, I_GKR, I_WUK, I_WUV, I_WO,
       I_WIN, I_RCW, I_RCB, I_WA, I_BA, I_WI, I_BI, I_LAM, I_WOUT, I_WUP, I_FCW, I_FCB, I_WDN, N_IN };
static_assert(N_IN == 34, "34 inputs");

constexpr size_t al256(size_t x) { return (x + 255) & ~(size_t)255; }
constexpr size_t WS_CTL = 0, CTL_ZERO_BYTES = 1u << 20;
constexpr size_t WS_WD = CTL_ZERO_BYTES;
constexpr size_t WS_WUQ = WS_WD + (size_t)1024 * 1024 * 2;
constexpr size_t WS_WK = WS_WUQ + (size_t)1536 * 512 * 2;
constexpr size_t WS_WV = WS_WK + (size_t)1024 * 256 * 2;
constexpr size_t WS_WO = WS_WV + (size_t)1024 * 256 * 2;
constexpr size_t WS_WUP = WS_WO + (size_t)1024 * 1024 * 2;
constexpr size_t WS_WDN = WS_WUP + (size_t)2 * 6144 * 1024 * 2;
constexpr size_t WS_WIN = WS_WDN + (size_t)2 * 1024 * 3072 * 2;
constexpr size_t WS_WAI = WS_WIN + (size_t)2048 * 1024 * 2;
constexpr size_t WS_WOUT = WS_WAI + (size_t)8 * 256 * 128 * 2;
constexpr size_t WS_RCOS = WS_WOUT + (size_t)1024 * 1024 * 2;
constexpr size_t WS_RSIN = WS_RCOS + al256((size_t)NROPE * 16 * 4);
constexpr size_t WS_SP8 = WS_RSIN + al256((size_t)NROPE * 16 * 4);
constexpr size_t WS_XN = WS_SP8 + 4096;
constexpr size_t WS_CQ = WS_XN + (size_t)M * D * 2;
constexpr size_t WS_SSQ1 = WS_CQ + (size_t)M * QL * 2;
constexpr size_t WS_CKVRAW = WS_SSQ1 + (size_t)M * 8 * 4;
constexpr size_t WS_KRRAW = WS_CKVRAW + (size_t)M * KVL * 4;
constexpr size_t WS_CKVB = WS_KRRAW + (size_t)M * QKR * 4;
constexpr size_t WS_KRB = WS_CKVB + (size_t)M * KVL * 2;
constexpr size_t WS_Q = WS_KRB + (size_t)M * QKR * 2;
constexpr size_t WS_K96 = WS_Q + (size_t)M * NH * QKD * 2;
constexpr size_t WS_VT = WS_K96 + (size_t)MP * NH * QKD * 2;
constexpr size_t WS_RSN = WS_VT + (size_t)MP * NH * VH * 2;
constexpr size_t WS_QABS = WS_RSN + (size_t)MS * 16 * 4;
constexpr size_t WS_CB16 = WS_QABS + (size_t)NSEQ * 128 * KVL * 2;
constexpr size_t WS_KRB16 = WS_CB16 + (size_t)NSEQ * PAST * KVL * 2;
constexpr size_t WS_RS = WS_KRB16 + (size_t)NSEQ * PAST * QKR * 2;
constexpr size_t WS_CTXP = WS_RS + (size_t)NSEQ * PAST * 16 * 4;
constexpr size_t WS_MLM = WS_CTXP + (size_t)NSEQ * NSPLIT * 128 * KVL * 4;
constexpr size_t WS_MLL = WS_MLM + (size_t)NSEQ * NSPLIT * 128 * 4;
constexpr size_t WS_O = WS_MLL + (size_t)NSEQ * NSPLIT * 2 * 128 * 4;
constexpr size_t WS_X1 = WS_O + (size_t)M * D * 2;
constexpr size_t WS_X1B = WS_X1 + (size_t)M * D * 4;
constexpr size_t WS_SS1 = WS_X1B + (size_t)M * D * 2;
constexpr size_t WS_G = WS_SS1 + (size_t)M * 16 * 4;
constexpr size_t WS_U = WS_G + (size_t)M * DFF * 2;
constexpr size_t WS_HB = WS_U + (size_t)M * DFF * 2;
constexpr size_t WS_X2 = WS_HB + (size_t)M * DFF * 2;
constexpr size_t WS_X2B = WS_X2 + (size_t)M * D * 4;
constexpr size_t WS_SS2 = WS_X2B + (size_t)M * D * 2;
constexpr size_t WS_XR = WS_SS2 + (size_t)M * 16 * 4;
constexpr size_t WS_GATE = WS_XR + (size_t)M * D * 4;
constexpr size_t WS_XC = WS_GATE + (size_t)M * D * 2;
constexpr size_t WS_LA = WS_XC + (size_t)M * D * 2;
constexpr size_t WS_BX = WS_LA + (size_t)M * D * 4;
constexpr size_t WS_PA = WS_BX + (size_t)M * D * 4;
constexpr size_t WS_HL = WS_PA + (size_t)NBATCH * 16 * D * 4;
constexpr size_t WS_Y = WS_HL + (size_t)NBATCH * 16 * D * 4;
constexpr size_t WS_X3 = WS_Y + (size_t)M * D * 2;
constexpr size_t WS_X3B = WS_X3 + (size_t)M * D * 4;
constexpr size_t WS_SS3 = WS_X3B + (size_t)M * D * 2;
constexpr size_t WS_END = WS_SS3 + (size_t)M * 16 * 4;

namespace pg8 {
#define PG8_LAS __attribute__((address_space(3)))
typedef unsigned short bf16_t;
typedef short bf16x8 __attribute__((ext_vector_type(8)));
typedef float f32x4 __attribute__((ext_vector_type(4)));
typedef unsigned u32x4 __attribute__((ext_vector_type(4)));
constexpr int BM = 256, BK = 64, HALF = 128, HTB = HALF * BK * 2  , STAGE_BYTES = 8 * HTB, NXCD = 8, WGM = 8;

__host__ __device__ __forceinline__ int lds_byte(int r, int c) { const int st = (r >> 4) * 2 + (c >> 5), rr = r & 15, cc = c & 31, ob = rr * 64 + cc * 2; return st * 1024 + (ob ^ (((ob >> 9) & 1) << 5)); }
__host__ __device__ __forceinline__ void stage_rc(int b, int& R, int& C) { const int st = b / 1024, sb = b % 1024, swz = sb ^ (((sb >> 9) & 1) << 5); R = (st >> 1) * 16 + swz / 64; C = (st & 1) * 32 + (swz % 64) / 2; }
__host__ __device__ __forceinline__ int perm32(int rho) { const int n = rho >> 4, i = rho & 15; return 8 * (i >> 2) + 4 * n + (i & 3); }

struct Unit { int pm, pn; };
struct Gemm { const bf16_t* A; const bf16_t* Bt; int lda, ldb, K, a_pn_off; };

struct StaticOrder {
    int nM, nN, nwg, G, c;
    __host__ __device__ void init(int M, int N, int G_, int c_) { nM = M / BM; nN = N / BM; nwg = nM * nN; G = G_; c = c_; }
    __host__ __device__ bool next(int i, Unit& u) const {
        const long L = (long)i * G + c; if (L >= nwg) return false;
        int wgid = (int)L; { const int q = nwg / NXCD, r = nwg % NXCD, xcd = wgid % NXCD, off = wgid / NXCD; wgid = (xcd < r ? xcd * (q + 1) : r * (q + 1) + (xcd - r) * q) + off; }
        const int nig = WGM * nN, gid = wgid / nig, fm = gid * WGM, gsz = (nM - fm) < WGM ? (nM - fm) : WGM;
        u.pm = fm + ((wgid % nig) % gsz); u.pn = (wgid % nig) / gsz; return true;
    }
    __device__ __forceinline__ void a_ready(const Unit&) const {}
    __device__ __forceinline__ void done(const Unit&) const {}
};

typedef float f32x2_t __attribute__((ext_vector_type(2))); typedef __bf16 bf16x2_t __attribute__((ext_vector_type(2)));
__device__ __forceinline__ unsigned cvt_pk_bf16(float lo, float hi) { f32x2_t v = {lo, hi}; bf16x2_t b = __builtin_convertvector(v, bf16x2_t); return __builtin_bit_cast(unsigned, b); }
typedef float f32x2 __attribute__((ext_vector_type(2)));
typedef unsigned u32x2 __attribute__((ext_vector_type(2)));
__device__ __forceinline__ u32x4 pack8(const f32x4& a, const f32x4& b) { u32x4 w; w.x = cvt_pk_bf16(a[0], a[1]); w.y = cvt_pk_bf16(a[2], a[3]); w.z = cvt_pk_bf16(b[0], b[1]); w.w = cvt_pk_bf16(b[2], b[3]); return w; }
__device__ __forceinline__ float dot4(const f32x4& a) { return (a[0] * a[0] + a[1] * a[1]) + (a[2] * a[2] + a[3] * a[3]); }
__device__ __forceinline__ float quad_sum(float s) { s += __shfl_xor(s, 16); s += __shfl_xor(s, 32); return s; }
__device__ __forceinline__ float sum_parts(const float* p, int n) { float s = 0.f; for (int i = 0; i < n; i += 4) { const f32x4 v = *(const f32x4*)(p + i); s += (v[0] + v[1]) + (v[2] + v[3]); } return s; }
__device__ __forceinline__ int rope_row(int row) { return row < MP ? (row & (T - 1)) : T + (row & (DSEQ - 1)); }

struct EpiDown {
    static constexpr bool PERM = true, AFTER_DRAIN = false;
    bf16_t* CQ; float* CKVRAW; float* KRRAW; float* SSQ;
    __device__ __forceinline__ void operator()(const f32x4 (&acc)[2][2][4][2], const Unit& u, int wr, int wc, int fr, int fq) const {
        const int row0 = u.pm * BM + wr * 64 + fr;
        if (u.pn < 2) {
#pragma unroll
            for (int ai = 0; ai < 2; ++ai)
#pragma unroll
                for (int m = 0; m < 4; ++m) { const int row = row0 + ai * HALF + m * 16; float ss = 0.f;
#pragma unroll
                    for (int bj = 0; bj < 2; ++bj) { ss += dot4(acc[ai][bj][m][0]) + dot4(acc[ai][bj][m][1]);
                        *(u32x4*)(CQ + (size_t)row * QL + u.pn * BM + bj * HALF + wc * 32 + 8 * fq) = pack8(acc[ai][bj][m][0], acc[ai][bj][m][1]); }
                    ss = quad_sum(ss);
                    if (fq == 0) SSQ[(size_t)row * 8 + u.pn * 4 + wc] = ss; }
        } else if (u.pn == 2) {
#pragma unroll
            for (int ai = 0; ai < 2; ++ai)
#pragma unroll
                for (int m = 0; m < 4; ++m) { const int row = row0 + ai * HALF + m * 16;
#pragma unroll
                    for (int bj = 0; bj < 2; ++bj) { float* o = CKVRAW + (size_t)row * KVL + bj * HALF + wc * 32 + 8 * fq; *(f32x4*)o = acc[ai][bj][m][0]; *(f32x4*)(o + 4) = acc[ai][bj][m][1]; } }
        } else if (wc == 0) {
#pragma unroll
            for (int ai = 0; ai < 2; ++ai)
#pragma unroll
                for (int m = 0; m < 4; ++m) { const int row = row0 + ai * HALF + m * 16; float* o = KRRAW + (size_t)row * QKR + 8 * fq; *(f32x4*)o = acc[ai][0][m][0]; *(f32x4*)(o + 4) = acc[ai][0][m][1]; }
        }
    }
};

struct EpiQ {
    static constexpr bool PERM = true, AFTER_DRAIN = false;
    bf16_t* Q; const float* SSQ; const float* g_qn; const float* g_qr; const float* rcos; const float* rsin;
    __device__ __forceinline__ void operator()(const f32x4 (&acc)[2][2][4][2], const Unit& u, int wr, int wc, int fr, int fq) const {
        const int row0 = u.pm * BM + wr * 64 + fr;
        if (u.pn < 4) {
            const int h = u.pn * 4 + wc;
            f32x4 gq[2][2];
#pragma unroll
            for (int bj = 0; bj < 2; ++bj)
#pragma unroll
                for (int n = 0; n < 2; ++n) gq[bj][n] = *(const f32x4*)(g_qn + 32 * bj + 8 * fq + 4 * n);
#pragma unroll
            for (int ai = 0; ai < 2; ++ai)
#pragma unroll
                for (int m = 0; m < 4; ++m) { const int row = row0 + ai * HALF + m * 16;
                    const float rq = __builtin_amdgcn_rsqf(sum_parts(SSQ + (size_t)row * 8, 8) * (1.0f / QL) + EPS);
                    f32x4 v[2][2]; float ss = 0.f;
#pragma unroll
                    for (int bj = 0; bj < 2; ++bj)
#pragma unroll
                        for (int n = 0; n < 2; ++n) { v[bj][n] = acc[ai][bj][m][n] * rq; ss += dot4(v[bj][n]); }
                    ss = quad_sum(ss);
                    const float r = __builtin_amdgcn_rsqf(ss * (1.0f / QKN) + EPS) * QSCALE;
#pragma unroll
                    for (int bj = 0; bj < 2; ++bj)
                        *(u32x4*)(Q + (size_t)row * (NH * QKD) + h * QKD + 32 * bj + 8 * fq) = pack8(v[bj][0] * gq[bj][0] * r, v[bj][1] * gq[bj][1] * r); }
        } else {
            const f32x4 g1 = *(const f32x4*)(g_qr + 4 * fq), g2 = *(const f32x4*)(g_qr + 16 + 4 * fq);
#pragma unroll
            for (int ai = 0; ai < 2; ++ai)
#pragma unroll
                for (int m = 0; m < 4; ++m) { const int row = row0 + ai * HALF + m * 16;
                    const float rq = __builtin_amdgcn_rsqf(sum_parts(SSQ + (size_t)row * 8, 8) * (1.0f / QL) + EPS);
                    const int rr = rope_row(row);
                    const f32x4 cs = *(const f32x4*)(rcos + rr * 16 + 4 * fq), sn = *(const f32x4*)(rsin + rr * 16 + 4 * fq);
#pragma unroll
                    for (int bj = 0; bj < 2; ++bj) { const int h = (u.pn - 4) * 8 + bj * 4 + wc;
                        const f32x4 x1 = acc[ai][bj][m][0] * rq, x2 = acc[ai][bj][m][1] * rq;
                        const float ss = quad_sum(dot4(x1) + dot4(x2));
                        const float r = __builtin_amdgcn_rsqf(ss * (1.0f / QKR) + EPS);
                        const f32x4 a1 = x1 * g1 * r, a2 = x2 * g2 * r;
                        const f32x4 o1 = (a1 * cs - a2 * sn) * QSCALE, o2 = (a1 * sn + a2 * cs) * QSCALE;
                        bf16_t* qp = Q + (size_t)row * (NH * QKD) + h * QKD + QKN + 4 * fq;
                        u32x2 w1, w2; w1.x = cvt_pk_bf16(o1[0], o1[1]); w1.y = cvt_pk_bf16(o1[2], o1[3]); w2.x = cvt_pk_bf16(o2[0], o2[1]); w2.y = cvt_pk_bf16(o2[2], o2[3]);
                        *(u32x2*)qp = w1; *(u32x2*)(qp + 16) = w2; } }
        }
    }
};

struct EpiK {
    static constexpr bool PERM = true, AFTER_DRAIN = false;
    bf16_t* K96; const bf16_t* KRB; const float* g_kn; float* RSN;
    __device__ __forceinline__ void operator()(const f32x4 (&acc)[2][2][4][2], const Unit& u, int wr, int wc, int fr, int fq) const {
        const int row0 = u.pm * BM + wr * 64 + fr, h = u.pn * 4 + wc;
        if (u.pm < MP / BM) {
            const unsigned kbase = (unsigned)(((row0 >> 11) * NH + h) * T + (row0 & (T - 1))) * QKD + 8 * fq;
#pragma unroll
            for (int ai = 0; ai < 2; ++ai)
#pragma unroll
                for (int m = 0; m < 4; ++m) { float ss = 0.f;
#pragma unroll
                    for (int bj = 0; bj < 2; ++bj) ss += dot4(acc[ai][bj][m][0]) + dot4(acc[ai][bj][m][1]);
                    ss = quad_sum(ss);
                    const float r = __builtin_amdgcn_rsqf(ss * (1.0f / QKN) + EPS);
                    bf16_t* kp = K96 + kbase + (unsigned)((ai * HALF + m * 16) * QKD);
#pragma unroll
                    for (int bj = 0; bj < 2; ++bj) { const f32x4 g0 = *(const f32x4*)(g_kn + 32 * bj + 8 * fq) * r, g1 = *(const f32x4*)(g_kn + 32 * bj + 8 * fq + 4) * r;
                        *(u32x4*)(kp + 32 * bj) = pack8(acc[ai][bj][m][0] * g0, acc[ai][bj][m][1] * g1); }
                    *(u32x4*)(kp + QKN) = *(const u32x4*)(KRB + (size_t)(row0 + ai * HALF + m * 16) * QKR + 8 * fq);
                    asm volatile("" ::: "memory"); }
        } else {
#pragma unroll
            for (int ai = 0; ai < 2; ++ai)
#pragma unroll
                for (int m = 0; m < 4; ++m) { float ss = 0.f;
#pragma unroll
                    for (int bj = 0; bj < 2; ++bj) ss += dot4(acc[ai][bj][m][0]) + dot4(acc[ai][bj][m][1]);
                    ss = quad_sum(ss);
                    if (fq == 0) RSN[(size_t)(row0 + ai * HALF + m * 16 - MP) * 16 + h] = __builtin_amdgcn_rsqf(ss * (1.0f / QKN) + EPS); }
        }
    }
};

struct EpiVT {
    static constexpr bool PERM = true, AFTER_DRAIN = false;
    bf16_t* VT;
    __device__ __forceinline__ void operator()(const f32x4 (&acc)[2][2][4][2], const Unit& u, int wr, int wc, int fr, int fq) const {
        const int row0 = u.pm * BM + wr * 64 + fr;
#pragma unroll
        for (int ai = 0; ai < 2; ++ai)
#pragma unroll
            for (int m = 0; m < 4; ++m) { const int hd = row0 + ai * HALF + m * 16;
#pragma unroll
                for (int bj = 0; bj < 2; ++bj) { const int tok = u.pn * BM + bj * HALF + wc * 32 + 8 * fq;
                    *(u32x4*)(VT + ((size_t)(tok >> 11) * (NH * VH) + hd) * T + (tok & (T - 1))) = pack8(acc[ai][bj][m][0], acc[ai][bj][m][1]); } }
    }
};

struct EpiRS {
    static constexpr bool PERM = true, AFTER_DRAIN = false;
    float* RS;
    __device__ __forceinline__ void operator()(const f32x4 (&acc)[2][2][4][2], const Unit& u, int wr, int wc, int fr, int fq) const {
        const int row0 = u.pm * BM + wr * 64 + fr, h = u.pn * 4 + wc;
#pragma unroll
        for (int ai = 0; ai < 2; ++ai)
#pragma unroll
            for (int m = 0; m < 4; ++m) { float ss = 0.f;
#pragma unroll
                for (int bj = 0; bj < 2; ++bj) ss += dot4(acc[ai][bj][m][0]) + dot4(acc[ai][bj][m][1]);
                ss = quad_sum(ss);
                if (fq == 0) RS[(size_t)(row0 + ai * HALF + m * 16) * 16 + h] = __builtin_amdgcn_rsqf(ss * (1.0f / QKN) + EPS); }
    }
};

struct EpiRes {
    static constexpr bool PERM = true, AFTER_DRAIN = false;
    const float* baseP; const float* baseS; float* outP; float* outS; bf16_t* outB; float* ssq;
    __device__ __forceinline__ void operator()(const f32x4 (&acc)[2][2][4][2], const Unit& u, int wr, int wc, int fr, int fq) const {
        const int row0 = u.pm * BM + wr * 64 + fr; const bool pr = u.pm < MP / BM;
        const float* base = pr ? baseP : baseS - (size_t)MP * D; float* out = pr ? outP : outS - (size_t)MP * D;
#pragma unroll
        for (int ai = 0; ai < 2; ++ai)
#pragma unroll
            for (int m = 0; m < 4; ++m) { const int row = row0 + ai * HALF + m * 16; float ss = 0.f;
#pragma unroll
                for (int bj = 0; bj < 2; ++bj) { const size_t off = (size_t)row * D + u.pn * BM + bj * HALF + wc * 32 + 8 * fq;
                    const f32x4 v0 = *(const f32x4*)(base + off) + acc[ai][bj][m][0], v1 = *(const f32x4*)(base + off + 4) + acc[ai][bj][m][1];
                    *(f32x4*)(out + off) = v0; *(f32x4*)(out + off + 4) = v1;
                    if (outB) { *(u32x4*)(outB + off) = pack8(v0, v1); ss += dot4(v0) + dot4(v1); } }
                if (outB) { ss = quad_sum(ss); if (fq == 0) ssq[(size_t)row * 16 + u.pn * 4 + wc] = ss; } }
    }
};

struct EpiUp {
    static constexpr bool PERM = true, AFTER_DRAIN = false;
    const float* ssq; bf16_t* G; bf16_t* U; float* convP; float* convS;
    __device__ __forceinline__ void operator()(const f32x4 (&acc)[2][2][4][2], const Unit& u, int wr, int wc, int fr, int fq) const {
        const int row0 = u.pm * BM + wr * 64 + fr, ch = u.pn * HALF + wc * 32 + 8 * fq;
#pragma unroll
        for (int ai = 0; ai < 2; ++ai)
#pragma unroll
            for (int m = 0; m < 4; ++m) { const int row = row0 + ai * HALF + m * 16;
                const float rs = __builtin_amdgcn_rsqf(sum_parts(ssq + (size_t)row * 16, 16) * (1.0f / D) + EPS);
                const f32x4 g0 = acc[ai][0][m][0] * rs, g1 = acc[ai][0][m][1] * rs;
                *(u32x4*)(G + (size_t)row * DFF + ch) = pack8(g0, g1);
                *(u32x4*)(U + (size_t)row * DFF + ch) = pack8(acc[ai][1][m][0] * rs, acc[ai][1][m][1] * rs);
                float* cp = nullptr;
                if (row < MP) { const int t = row & (T - 1); if (t >= T - 2) cp = convP + ((size_t)(row >> 11) * 2 + (t - (T - 2))) * DFF + ch; }
                else { const int s = row & (DSEQ - 1); if (s >= DSEQ - 2) cp = convS + ((size_t)((row - MP) >> 3) * 2 + (s - (DSEQ - 2))) * DFF + ch; }
                if (cp) { *(f32x4*)cp = g0; *(f32x4*)(cp + 4) = g1; } }
    }
};

__device__ __forceinline__ float gelu_tanh(float x) { const float t = 1.5957691216057308f * (x + 0.044715f * x * x * x); return x * __builtin_amdgcn_rcpf(1.0f + __builtin_amdgcn_exp2f(-1.4426950408889634f * t)); }
struct EpiIn {
    static constexpr bool PERM = true, AFTER_DRAIN = false;
    const float* ssq; float* XR; bf16_t* GATE; float* convP; float* convS;
    __device__ __forceinline__ void operator()(const f32x4 (&acc)[2][2][4][2], const Unit& u, int wr, int wc, int fr, int fq) const {
        const int row0 = u.pm * BM + wr * 64 + fr, ch = u.pn * HALF + wc * 32 + 8 * fq;
#pragma unroll
        for (int ai = 0; ai < 2; ++ai)
#pragma unroll
            for (int m = 0; m < 4; ++m) { const int row = row0 + ai * HALF + m * 16;
                const float rs = __builtin_amdgcn_rsqf(sum_parts(ssq + (size_t)row * 16, 16) * (1.0f / D) + EPS);
                const f32x4 x0 = acc[ai][0][m][0] * rs, x1 = acc[ai][0][m][1] * rs;
                *(f32x4*)(XR + (size_t)row * D + ch) = x0; *(f32x4*)(XR + (size_t)row * D + ch + 4) = x1;
                f32x4 t0 = acc[ai][1][m][0] * rs, t1 = acc[ai][1][m][1] * rs;
#pragma unroll
                for (int j = 0; j < 4; ++j) { t0[j] = gelu_tanh(t0[j]); t1[j] = gelu_tanh(t1[j]); }
                *(u32x4*)(GATE + (size_t)row * D + ch) = pack8(t0, t1);
                float* cp = nullptr;
                if (row < MP) { const int t = row & (T - 1); if (t >= T - 3) cp = convP + ((size_t)(row >> 11) * 3 + (t - (T - 3))) * D + ch; }
                else { const int s = row & (DSEQ - 1); if (s >= DSEQ - 3) cp = convS + ((size_t)((row - MP) >> 3) * 3 + (s - (DSEQ - 3))) * D + ch; }
                if (cp) { *(f32x4*)cp = x0; *(f32x4*)(cp + 4) = x1; } }
    }
};

struct EpiLru {
    static constexpr bool PERM = true, AFTER_DRAIN = false;
    const bf16_t* XC; const float* b_a; const float* b_i; const float* sp8; float* LA; float* BX;
    __device__ __forceinline__ void operator()(const f32x4 (&acc)[2][2][4][2], const Unit& u, int wr, int wc, int fr, int fq) const {
        const int row0 = u.pm * BM + wr * 64 + fr, ch = u.pn * HALF + wc * 32 + 8 * fq;
#pragma unroll
        for (int ai = 0; ai < 2; ++ai)
#pragma unroll
            for (int m = 0; m < 4; ++m) { const int row = row0 + ai * HALF + m * 16;
                const u32x4 xw = *(const u32x4*)(XC + (size_t)row * D + ch);
                float* lp = LA + (size_t)row * D + ch; float* bp = BX + (size_t)row * D + ch;
#pragma unroll
                for (int n = 0; n < 2; ++n) {
                    const f32x4 ba = *(const f32x4*)(b_a + ch + 4 * n), bi = *(const f32x4*)(b_i + ch + 4 * n), sp = *(const f32x4*)(sp8 + ch + 4 * n);
                    f32x4 av, bv;
#pragma unroll
                    for (int j = 0; j < 4; ++j) { const float ra = acc[ai][0][m][n][j] + ba[j], ia = acc[ai][1][m][n][j] + bi[j];
                        const float r = __builtin_amdgcn_rcpf(1.0f + __expf(-ra)), gi = __builtin_amdgcn_rcpf(1.0f + __expf(-ia));
                        const float la = r * sp[j], a = __expf(la), x2 = 2.0f * la;
                        const float om = (x2 > -0.05f) ? -x2 * (1.0f + x2 * (0.5f + x2 * (0.16666667f + x2 * 0.041666668f))) : 1.0f - a * a;
                        const unsigned wv = xw[2 * n + (j >> 1)]; const float xc = __uint_as_float((j & 1) ? (wv & 0xffff0000u) : (wv << 16));
                        av[j] = a; bv[j] = __builtin_sqrtf(om) * gi * xc; }
                    *(f32x4*)(lp + 4 * n) = av; *(f32x4*)(bp + 4 * n) = bv; }
                asm volatile("" ::: "memory"); }
    }
};

template <class Epi, class Sched, bool ALIGN_EPI = false, bool SP2 = false>
__device__ __forceinline__ void gemm_phase(PG8_LAS unsigned char* lds, const Gemm g, const Sched& S, const Epi& E) {
    const int tid = threadIdx.x, wid = __builtin_amdgcn_readfirstlane(tid >> 6), lane = tid & 63, wr = wid >> 2, wc = wid & 3, fr = lane & 15, fq = lane >> 4;
    const int K = g.K, nt = K / BK;
    unsigned voffA[2], voffB[2];
#pragma unroll
    for (int i = 0; i < 2; ++i) { int R, C; stage_rc(tid * 16 + i * 8192, R, C); const int Rb = Epi::PERM ? ((R & ~31) + perm32(R & 31)) : R;
        voffA[i] = (unsigned)(R * g.lda + C) * 2u; voffB[i] = (unsigned)(Rb * g.ldb + C) * 2u; }
    const size_t kstep = (size_t)(BK * 2);
    const size_t hstepA = (size_t)HALF * g.lda * 2, hstepB = (size_t)HALF * g.ldb * 2;
    const size_t tstepA = 2 * hstepA, tstepB = 2 * hstepB;
    const size_t pnoffA = (size_t)g.a_pn_off * 2;
    const unsigned ldsw = (unsigned)wid * 1024u;
    const int aoff = lds_byte(wr * 64 + fr, fq * 8), boff = lds_byte(wc * 32 + fr, fq * 8);
#define PG8_SA(b, h) (((b) * 2 + (h)) * HTB)
#define PG8_SB(b, h) ((4 + (b) * 2 + (h)) * HTB)
#define PG8_STAGE(bufoff, gbase, voff) do { _Pragma("unroll") for (int _i = 0; _i < 2; ++_i) \
        __builtin_amdgcn_global_load_lds((const unsigned*)((const char*)(gbase) + (voff)[_i]), (PG8_LAS unsigned*)(lds + (bufoff) + ldsw + _i * 8192), 16, 0, 0); } while (0)
#define PG8_LDA(dst, b, h) do { _Pragma("unroll") for (int m = 0; m < 4; ++m) _Pragma("unroll") for (int k = 0; k < 2; ++k) dst[m][k] = *(const PG8_LAS bf16x8*)(lds + PG8_SA(b, h) + aoff + m * 2048 + k * 1024); } while (0)
#define PG8_LDB(dst, b, h) do { _Pragma("unroll") for (int n = 0; n < 2; ++n) _Pragma("unroll") for (int k = 0; k < 2; ++k) dst[n][k] = *(const PG8_LAS bf16x8*)(lds + PG8_SB(b, h) + boff + n * 2048 + k * 1024); } while (0)
#define PG8_MMA(ai, bj, At, Bt) do { __builtin_amdgcn_s_setprio(1); _Pragma("unroll") for (int m = 0; m < 4; ++m) _Pragma("unroll") for (int n = 0; n < 2; ++n) _Pragma("unroll") for (int k = 0; k < 2; ++k) \
        acc[ai][bj][m][n] = __builtin_amdgcn_mfma_f32_16x16x32_bf16(Bt[n][k], At[m][k], acc[ai][bj][m][n], 0, 0, 0); __builtin_amdgcn_s_setprio(0); } while (0)
#define PG8_WAIT_V(n) asm volatile("s_waitcnt vmcnt(" #n ")" ::: "memory")
#define PG8_WAIT_L(n) asm volatile("s_waitcnt lgkmcnt(" #n ")" ::: "memory")
#define PG8_BAR __builtin_amdgcn_s_barrier()
#define PG8_SCHED __builtin_amdgcn_sched_barrier(0)
    Unit cur, nxt; int ui = 0;
    if (!S.next(0, cur)) return;
    f32x4 acc[2][2][4][2];
#pragma unroll
    for (int a = 0; a < 2; ++a)
#pragma unroll
        for (int b = 0; b < 2; ++b)
#pragma unroll
            for (int m = 0; m < 4; ++m)
#pragma unroll
                for (int n = 0; n < 2; ++n) acc[a][b][m][n] = (f32x4){0.f, 0.f, 0.f, 0.f};
    bf16x8 At[4][2], B0[2][2], B1[2][2];
    const char* cA = (const char*)g.A + (size_t)cur.pm * tstepA + (size_t)cur.pn * pnoffA; const char* cB = (const char*)g.Bt + (size_t)cur.pn * tstepB;
    S.a_ready(cur);
    if constexpr (SP2) {
        PG8_STAGE(PG8_SB(0, 0), cB, voffB); PG8_STAGE(PG8_SB(0, 1), cB + hstepB, voffB); PG8_STAGE(PG8_SA(0, 0), cA, voffA); PG8_STAGE(PG8_SA(0, 1), cA + hstepA, voffA);
        if (wr == 1) PG8_BAR;
        PG8_WAIT_V(2); PG8_BAR;
        PG8_STAGE(PG8_SB(1, 0), cB + kstep, voffB); PG8_STAGE(PG8_SA(1, 0), cA + kstep, voffA); PG8_STAGE(PG8_SB(1, 1), cB + hstepB + kstep, voffB);
        PG8_WAIT_V(6); PG8_BAR;
    } else {
        PG8_STAGE(PG8_SB(0, 0), cB, voffB); PG8_STAGE(PG8_SA(0, 0), cA, voffA); PG8_STAGE(PG8_SB(0, 1), cB + hstepB, voffB); PG8_STAGE(PG8_SA(0, 1), cA + hstepA, voffA);
        if (wr == 1) PG8_BAR;
        PG8_WAIT_V(4); PG8_BAR;
        PG8_STAGE(PG8_SB(1, 0), cB + kstep, voffB); PG8_STAGE(PG8_SA(1, 0), cA + kstep, voffA); PG8_STAGE(PG8_SB(1, 1), cB + hstepB + kstep, voffB);
        PG8_WAIT_V(6); PG8_BAR;
    }
    for (;;) {
        const bool has_next = S.next(ui + 1, nxt);
        const char* nA = has_next ? (const char*)g.A + (size_t)nxt.pm * tstepA + (size_t)nxt.pn * pnoffA : cA; const char* nB = has_next ? (const char*)g.Bt + (size_t)nxt.pn * tstepB : cB;
#pragma nounroll
        for (int t = 0; t < nt; t += 2) {
            const bool last = (t == nt - 2);
            const char* a1 = cA + (size_t)(t + 1) * kstep;
            const char* a2 = last ? nA : cA + (size_t)(t + 2) * kstep; const char* b2 = last ? nB : cB + (size_t)(t + 2) * kstep;
            const char* a3 = a2 + kstep; const char* b3 = b2 + kstep;
            if (last && has_next) S.a_ready(nxt);
            if constexpr (SP2) {
            PG8_LDB(B0, 0, 0); PG8_LDB(B1, 0, 1); PG8_SCHED; PG8_LDA(At, 0, 0); PG8_STAGE(PG8_SA(1, 1), a1 + hstepA, voffA);
            PG8_WAIT_V(8); PG8_WAIT_L(0); PG8_BAR; PG8_MMA(0, 0, At, B0); PG8_MMA(0, 1, At, B1); PG8_BAR; PG8_SCHED;
            PG8_LDA(At, 0, 1); PG8_STAGE(PG8_SB(0, 0), b2, voffB); PG8_STAGE(PG8_SB(0, 1), b2 + hstepB, voffB); PG8_STAGE(PG8_SA(0, 0), a2, voffA);
            PG8_WAIT_V(8); PG8_WAIT_L(0); PG8_BAR; PG8_MMA(1, 0, At, B0); PG8_MMA(1, 1, At, B1); PG8_BAR; PG8_SCHED;
            PG8_LDB(B0, 1, 0); PG8_LDB(B1, 1, 1); PG8_SCHED; PG8_LDA(At, 1, 0); PG8_STAGE(PG8_SA(0, 1), a2 + hstepA, voffA);
            PG8_WAIT_V(8); PG8_WAIT_L(0); PG8_BAR; PG8_MMA(0, 0, At, B0); PG8_MMA(0, 1, At, B1); PG8_BAR; PG8_SCHED;
            PG8_LDA(At, 1, 1); PG8_STAGE(PG8_SB(1, 0), b3, voffB); PG8_STAGE(PG8_SB(1, 1), b3 + hstepB, voffB); PG8_STAGE(PG8_SA(1, 0), a3, voffA);
            PG8_WAIT_V(8); PG8_WAIT_L(0); PG8_BAR; PG8_MMA(1, 0, At, B0); PG8_MMA(1, 1, At, B1); PG8_BAR; PG8_SCHED;
            } else {
            PG8_LDB(B0, 0, 0); PG8_SCHED; PG8_LDA(At, 0, 0); PG8_STAGE(PG8_SA(1, 1), a1 + hstepA, voffA);
            PG8_WAIT_L(8); PG8_BAR; PG8_WAIT_L(0); PG8_MMA(0, 0, At, B0); PG8_BAR; PG8_SCHED;
            PG8_LDB(B1, 0, 1); PG8_STAGE(PG8_SB(0, 0), b2, voffB);
            PG8_BAR; PG8_WAIT_L(0); PG8_MMA(0, 1, At, B1); PG8_BAR;
            PG8_LDA(At, 0, 1); PG8_STAGE(PG8_SA(0, 0), a2, voffA);
            PG8_BAR; PG8_WAIT_L(0); PG8_MMA(1, 0, At, B0); PG8_BAR; PG8_SCHED;
            PG8_STAGE(PG8_SB(0, 1), b2 + hstepB, voffB);
            PG8_WAIT_V(6); PG8_BAR; PG8_MMA(1, 1, At, B1); PG8_BAR;
            PG8_LDB(B0, 1, 0); PG8_SCHED; PG8_LDA(At, 1, 0); PG8_STAGE(PG8_SA(0, 1), a2 + hstepA, voffA);
            PG8_WAIT_L(8); PG8_BAR; PG8_WAIT_L(0); PG8_MMA(0, 0, At, B0); PG8_BAR; PG8_SCHED;
            PG8_LDB(B1, 1, 1); PG8_STAGE(PG8_SB(1, 0), b3, voffB);
            PG8_BAR; PG8_WAIT_L(0); PG8_MMA(0, 1, At, B1); PG8_BAR;
            PG8_LDA(At, 1, 1); PG8_STAGE(PG8_SA(1, 0), a3, voffA);
            PG8_BAR; PG8_WAIT_L(0); PG8_MMA(1, 0, At, B0); PG8_BAR; PG8_SCHED;
            PG8_STAGE(PG8_SB(1, 1), b3 + hstepB, voffB);
            PG8_WAIT_V(6); PG8_BAR; PG8_MMA(1, 1, At, B1); PG8_BAR;
            }
        }
        if constexpr (ALIGN_EPI) { if (wr == 0) PG8_BAR; }
        if constexpr (!Epi::AFTER_DRAIN) { E(acc, cur, wr, wc, fr, fq); S.done(cur); }
        if (!has_next) break;
#pragma unroll
        for (int a = 0; a < 2; ++a)
#pragma unroll
            for (int b = 0; b < 2; ++b)
#pragma unroll
                for (int m = 0; m < 4; ++m)
#pragma unroll
                    for (int n = 0; n < 2; ++n) acc[a][b][m][n] = (f32x4){0.f, 0.f, 0.f, 0.f};
        cur = nxt; cA = nA; cB = nB; ++ui;
        if constexpr (ALIGN_EPI) { if (wr == 1) PG8_BAR; }
    }
    PG8_WAIT_V(0);
    if constexpr (!ALIGN_EPI) { if (wr == 0) PG8_BAR; }
    PG8_BAR;
    if constexpr (Epi::AFTER_DRAIN) { E.fused(acc, cur, wr, wc, fr, fq, lds, wid, lane); S.done(cur); }
#undef PG8_SA
#undef PG8_SB
#undef PG8_STAGE
#undef PG8_LDA
#undef PG8_LDB
#undef PG8_MMA
#undef PG8_WAIT_V
#undef PG8_WAIT_L
#undef PG8_BAR
#undef PG8_SCHED
}
}

#define GAS __attribute__((address_space(1)))
#define LAS __attribute__((address_space(3)))
typedef unsigned short bf16;
typedef unsigned v4u __attribute__((ext_vector_type(4)));
typedef float f32x4 __attribute__((ext_vector_type(4)));
typedef short bf16x8 __attribute__((ext_vector_type(8)));
typedef GAS unsigned gu32;
typedef GAS unsigned long long gu64;
#define RLX_AGENT __ATOMIC_RELAXED, __HIP_MEMORY_SCOPE_AGENT
#define LDS_WAIT() asm volatile("s_waitcnt lgkmcnt(0)" ::: "memory")
#define VM_WAIT() asm volatile("s_waitcnt vmcnt(0)" ::: "memory")
__device__ __forceinline__ unsigned long long rt() { return __builtin_amdgcn_s_memrealtime(); }
__device__ __forceinline__ unsigned f2bf(float f) { unsigned u = __builtin_bit_cast(unsigned, f); return (u + 0x7fffu + ((u >> 16) & 1u)) >> 16; }
__device__ __forceinline__ unsigned pk2(float lo, float hi) { return f2bf(lo) | (f2bf(hi) << 16); }
#define XB_TMO      128
#define XB_XCNT(j)  (256  + 64 * (j))
#define XB_XSUB(j)  (1280 + 64 * (j))
#define XB_XGEN(j)  (2304 + 64 * (j))
#define XB_TOP      3328
#define XB_TOPGEN   3392
#define XCD_BAR_WORDS 3456
#define XB_SPIN_CAP (1u << 18)

__device__ __forceinline__ unsigned xb_ld(unsigned* p)              { return __hip_atomic_load(p, __ATOMIC_RELAXED, __HIP_MEMORY_SCOPE_AGENT); }
__device__ __forceinline__ unsigned xb_add(unsigned* p, unsigned v) { return __hip_atomic_fetch_add(p, v, __ATOMIC_RELAXED, __HIP_MEMORY_SCOPE_AGENT); }
__device__ __forceinline__ unsigned xb_xcc_id() { return (unsigned)__builtin_amdgcn_s_getreg((3 << 11) | 20) & 0xFu; }
#define XB_SPIN(cond, bar) do { unsigned _sp = 0; while (cond) { __builtin_amdgcn_s_sleep(1); \
    if ((++_sp & 255u) == 0u) { if (xb_ld(&(bar)[XB_TMO])) break; if (_sp > XB_SPIN_CAP) { atomicAdd(&(bar)[XB_TMO], 1u); break; } } } } while (0)

struct XcdBarrier {
    unsigned* bar; unsigned x;
    volatile LAS unsigned* st;
};

__device__ __forceinline__ XcdBarrier xcd_barrier_post(unsigned* bar, volatile LAS unsigned* st) {
    XcdBarrier b; b.bar = bar; b.x = xb_xcc_id(); b.st = st;
    if (threadIdx.x == 0) (void)xb_add(&bar[XB_XCNT(b.x)], 1u);
    return b;
}
__device__ __forceinline__ void xcd_barrier_complete(unsigned* bar, unsigned x, unsigned& nloc, unsigned& nx) {
    const unsigned G = gridDim.x * gridDim.y * gridDim.z;
    unsigned sum, cnt, mine, sp = 0u;
    for (;;) {
        sum = 0u; cnt = 0u; mine = 0u;
#pragma unroll
        for (unsigned j = 0; j < 16; ++j) { const unsigned c = xb_ld(&bar[XB_XCNT(j)]); sum += c; cnt += (c > 0u) ? 1u : 0u; mine = (j == x) ? c : mine; }
        if (sum == G) break;
        __builtin_amdgcn_s_sleep(1);
        if ((++sp & 255u) == 0u) { if (xb_ld(&bar[XB_TMO])) break; if (sp > XB_SPIN_CAP) { atomicAdd(&bar[XB_TMO], 1u); break; } }
    }
    nloc = mine > 0u ? mine : 1u; nx = cnt > 0u ? cnt : 1u;
}

__device__ __forceinline__ void xcd_barrier(const XcdBarrier& b) {
    asm volatile("s_waitcnt vmcnt(0)" ::: "memory");
    __syncthreads();
    if (threadIdx.x == 0) {
        unsigned* bar = b.bar;
        __builtin_amdgcn_s_waitcnt(0);
        unsigned nloc = b.st[0], nx = b.st[1];
        if (nloc == 0u) { xcd_barrier_complete(bar, b.x, nloc, nx); b.st[0] = nloc; b.st[1] = nx; }
        const unsigned old = xb_add(&bar[XB_XSUB(b.x)], 1u);
        const unsigned gen = old / nloc;
        if (old + 1u == (gen + 1u) * nloc) {
            __builtin_amdgcn_fence(__ATOMIC_RELEASE, "agent");
            asm volatile("s_waitcnt vmcnt(0)" ::: "memory");
            const unsigned og = xb_add(&bar[XB_TOP], 1u);
            const unsigned tg = og / nx;
            if (og + 1u == (tg + 1u) * nx) xb_add(&bar[XB_TOPGEN], 1u);
            else XB_SPIN(xb_ld(&bar[XB_TOPGEN]) == tg, bar);
            __builtin_amdgcn_fence(__ATOMIC_ACQUIRE, "agent");
            xb_add(&bar[XB_XGEN(b.x)], 1u);
            asm volatile("s_waitcnt vmcnt(0)" ::: "memory");
        } else {
            XB_SPIN(xb_ld(&bar[XB_XGEN(b.x)]) == gen, bar);
            __builtin_amdgcn_fence(__ATOMIC_ACQUIRE, "agent");
            asm volatile("s_waitcnt vmcnt(0)" ::: "memory");
        }
    }
    __syncthreads();
}

struct Params { const float* in[N_IN]; float* out; unsigned char* ws; int ph_lo, ph_hi; };
static_assert(sizeof(Params) == N_IN * 8 + 8 + 8 + 8, "Params has no padding bytes");
constexpr int NWAVES = 8, NTHR = NWAVES * 64;
#define WSP(T_, off) ((T_*)(p.ws + (off)))

__device__ __forceinline__ float wave_sum(float v) {
#pragma unroll
    for (int o = 1; o < 64; o <<= 1) v += __shfl_xor(v, o);
    return v;
}
__device__ __forceinline__ unsigned pkbf(float lo, float hi) { return pg8::cvt_pk_bf16(lo, hi); }
__device__ __forceinline__ float bf_lo(unsigned w) { return __uint_as_float(w << 16); }
__device__ __forceinline__ float bf_hi(unsigned w) { return __uint_as_float(w & 0xffff0000u); }

__device__ __forceinline__ void transpose_item(const float* W, int ldw, int src_col0, bf16* WT, int K, int dst_row0, const float* gain, int mode, LAS float* scr, int kb, int lane) {
    const int k0 = 64 * kb;
#pragma unroll 8
    for (int i = 0; i < 32; ++i) { const int kk = 2 * i + (lane >> 5); float v = W[(size_t)(k0 + kk) * ldw + src_col0 + (lane & 31)]; if (gain) v *= gain[k0 + kk]; scr[kk * 33 + (lane & 31)] = v; }
    LDS_WAIT(); asm volatile("" ::: "memory");
    const int c = lane & 7;
#pragma unroll
    for (int j = 0; j < 4; ++j) { const int n = (lane >> 3) + 8 * j; const LAS float* s = scr + (8 * c) * 33 + n;
        const int dn = mode ? (8 * ((n >> 2) & 3) + 4 * (n >> 4) + (n & 3)) : n;
        v4u o; o.x = pkbf(s[0 * 33], s[1 * 33]); o.y = pkbf(s[2 * 33], s[3 * 33]); o.z = pkbf(s[4 * 33], s[5 * 33]); o.w = pkbf(s[6 * 33], s[7 * 33]);
        *(GAS v4u*)(WT + (size_t)(dst_row0 + dn) * K + k0 + 8 * c) = o; }
    LDS_WAIT(); asm volatile("" ::: "memory");
}

__device__ __forceinline__ void p0_prologue(const Params& p, LAS unsigned char* lds, int wave, int lane) {
    LAS float* scr = (LAS float*)(lds + wave * 16384);
    const int gw = blockIdx.x * NWAVES + wave, NGW = gridDim.x * NWAVES;
    constexpr int J0 = 16 * 25, J1 = 8 * 48, J2 = 4 * 32, J3 = 4 * 32, J4 = 16 * 32, J5 = 16 * 192, J6 = 48 * 32, J7 = 16 * 64, J8 = 128, J9 = 16 * 32;
    constexpr int NITEMS = J0 + J1 + J2 + J3 + J4 + 2 * J5 + 2 * J6 + J7 + J8 + J9;
    for (int it = gw; it < NITEMS; it += NGW) {
        int r = it;
        if (r < J0) { const int kb = r / 25, nb = r % 25; transpose_item(p.in[I_WD], 800, 32 * nb, WSP(bf16, WS_WD), 1024, 32 * nb, nullptr, 0, scr, kb, lane); continue; } r -= J0;
        if (r < J1) { const int kb = r / 48, db = r % 48; int src, mode;
            if (db < 32) { const int pn = db >> 3, bj = (db >> 2) & 1, wc = db & 3; src = (4 * pn + wc) * QKD + 32 * bj; mode = 0; }
            else { const int rb = db - 32, pr = rb >> 3, bj = (rb >> 2) & 1, wc = rb & 3; src = (8 * pr + 4 * bj + wc) * QKD + QKN; mode = 1; }
            transpose_item(p.in[I_WUQ], NH * QKD, src, WSP(bf16, WS_WUQ), QL, 32 * db, p.in[I_GQL], mode, scr, kb, lane); continue; } r -= J1;
        if (r < J2) { const int kb = r / 32, db = r % 32, pn = db >> 3, bj = (db >> 2) & 1, wc = db & 3;
            transpose_item(p.in[I_WUK], NH * QKN, (4 * pn + wc) * QKN + 32 * bj, WSP(bf16, WS_WK), KVL, 32 * db, nullptr, 0, scr, kb, lane); continue; } r -= J2;
        if (r < J3) { const int kb = r / 32, db = r % 32; transpose_item(p.in[I_WUV], NH * VH, 32 * db, WSP(bf16, WS_WV), KVL, 32 * db, nullptr, 0, scr, kb, lane); continue; } r -= J3;
        if (r < J4) { const int kb = r / 32, db = r % 32; transpose_item(p.in[I_WO], D, 32 * db, WSP(bf16, WS_WO), D, 32 * db, nullptr, 0, scr, kb, lane); continue; } r -= J4;
        if (r < 2 * J5) { const int l = r / J5, q = r % J5, kb = q / 192, db = q % 192, pn = db >> 3, bj = (db >> 2) & 1, cb = db & 3;
            transpose_item(p.in[I_WUP] + (size_t)l * D * 2 * DFF, 2 * DFF, bj * DFF + 128 * pn + 32 * cb, WSP(bf16, WS_WUP) + (size_t)l * 2 * DFF * D, D, 32 * db, p.in[I_NFFN] + l * D, 0, scr, kb, lane); continue; } r -= 2 * J5;
        if (r < 2 * J6) { const int l = r / J6, q = r % J6, kb = q / 32, db = q % 32;
            transpose_item(p.in[I_WDN] + (size_t)l * DFF * D, D, 32 * db, WSP(bf16, WS_WDN) + (size_t)l * D * DFF, DFF, 32 * db, nullptr, 0, scr, kb, lane); continue; } r -= 2 * J6;
        if (r < J7) { const int kb = r / 64, db = r % 64, pn = db >> 3, bj = (db >> 2) & 1, cb = db & 3;
            transpose_item(p.in[I_WIN], 2 * D, bj * D + 128 * pn + 32 * cb, WSP(bf16, WS_WIN), D, 32 * db, p.in[I_NMIX] + D, 0, scr, kb, lane); continue; } r -= J7;
        if (r < J8) { const int kb = r & 1, q = r >> 1, cb = q & 3, bj = (q >> 2) & 1, nb = q >> 3;
            transpose_item((bj ? p.in[I_WI] : p.in[I_WA]) + (size_t)nb * LB * LB, LB, 32 * cb, WSP(bf16, WS_WAI), LB, 256 * nb + 128 * bj + 32 * cb, nullptr, 0, scr, kb, lane); continue; } r -= J8;
        { const int kb = r / 32, db = r % 32; transpose_item(p.in[I_WOUT], D, 32 * db, WSP(bf16, WS_WOUT), D, 32 * db, nullptr, 0, scr, kb, lane); }
    }
    { GAS v4u* z = (GAS v4u*)(WSP(bf16, WS_WD) + (size_t)800 * 1024); const int n16 = 224 * 1024 * 2 / 16;
      for (int i = blockIdx.x * NTHR + threadIdx.x; i < n16; i += gridDim.x * NTHR) z[i] = (v4u){0u, 0u, 0u, 0u}; }
    for (int i = blockIdx.x * NTHR + threadIdx.x; i < NROPE * 16; i += gridDim.x * NTHR) {
        const int rr = i >> 4, fi = i & 15; const double pos = (double)(rr < T ? rr : PAST + (rr - T));
        const double inv = exp(-(double)fi * (9.210340371976184 / 16.0));
        double ang = pos * inv; const double k = rint(ang * 0.15915494309189535); ang = fma(-k, 6.283185307179586, ang); ang = fma(-k, 2.4492935982947064e-16, ang);
        const float a = (float)ang;
        WSP(float, WS_RCOS)[i] = cosf(a); WSP(float, WS_RSIN)[i] = sinf(a);
    }
    for (int i = blockIdx.x * NTHR + threadIdx.x; i < D; i += gridDim.x * NTHR) { const float l = p.in[I_LAM][i]; WSP(float, WS_SP8)[i] = -8.0f * ((l > 15.f) ? expf(-l) : log1pf(expf(-l))); }
    for (int m = gw; m < M; m += NGW) {
        const float* xrow = (m < MP) ? p.in[I_XP] + (size_t)m * D : p.in[I_XS] + (size_t)(m - MP) * D;
        const GAS f32x4* xr = (const GAS f32x4*)xrow + lane; const GAS f32x4* gr = (const GAS f32x4*)p.in[I_NMIX] + lane;
        f32x4 v[4]; float s = 0.f;
#pragma unroll
        for (int j = 0; j < 4; ++j) { v[j] = xr[64 * j]; s += (v[j].x * v[j].x + v[j].y * v[j].y) + (v[j].z * v[j].z + v[j].w * v[j].w); }
        const float rs = __builtin_amdgcn_rsqf(wave_sum(s) * (1.f / D) + EPS);
        GAS unsigned long long* o8 = (GAS unsigned long long*)(WSP(bf16, WS_XN) + (size_t)m * D) + lane;
#pragma unroll
        for (int j = 0; j < 4; ++j) { const f32x4 g = gr[64 * j]; o8[64 * j] = (unsigned long long)pkbf(v[j].x * rs * g.x, v[j].y * rs * g.y) | ((unsigned long long)pkbf(v[j].z * rs * g.z, v[j].w * rs * g.w) << 32); }
    }
    const int* pt = (const int*)p.in[I_PT];
    for (int r2 = gw; r2 < NSEQ * PAST / 2; r2 += NGW) {
        const int row = 2 * r2 + (lane >> 5), bs = row >> 13, key = row & (PAST - 1), pg = pt[bs * NPAGES + (key >> 7)];
        const float* src = p.in[I_CCKV] + ((size_t)pg * PAGE + (key & (PAGE - 1))) * KVL + 8 * (lane & 31);
        const f32x4 a = __builtin_nontemporal_load((const f32x4*)src), b = __builtin_nontemporal_load((const f32x4*)(src + 4));
        v4u o; o.x = pkbf(a.x, a.y); o.y = pkbf(a.z, a.w); o.z = pkbf(b.x, b.y); o.w = pkbf(b.z, b.w);
        *(GAS v4u*)(WSP(bf16, WS_CB16) + (size_t)row * KVL + 8 * (lane & 31)) = o;
    }
    for (int r16 = gw; r16 < NSEQ * PAST / 16; r16 += NGW) {
        const int row = 16 * r16 + (lane >> 2), bs = row >> 13, key = row & (PAST - 1), pg = pt[bs * NPAGES + (key >> 7)];
        const float* src = p.in[I_CKR] + ((size_t)pg * PAGE + (key & (PAGE - 1))) * QKR + 8 * (lane & 3);
        const f32x4 a = __builtin_nontemporal_load((const f32x4*)src), b = __builtin_nontemporal_load((const f32x4*)(src + 4));
        v4u o; o.x = pkbf(a.x, a.y); o.y = pkbf(a.z, a.w); o.z = pkbf(b.x, b.y); o.w = pkbf(b.z, b.w);
        *(GAS v4u*)(WSP(bf16, WS_KRB16) + (size_t)row * QKR + 8 * (lane & 3)) = o;
    }
}

__device__ __forceinline__ void thin_ckv_krope(const Params& p, int wave, int lane) {
    const int gw = blockIdx.x * NWAVES + wave, NGW = gridDim.x * NWAVES;
    const f32x4 gkv = *(const f32x4*)(p.in[I_GKV] + 4 * lane);
    const float gkr = p.in[I_GKR][lane & 31];
    for (int m = gw; m < M; m += NGW) {
        const f32x4 v = *(const f32x4*)(WSP(float, WS_CKVRAW) + (size_t)m * KVL + 4 * lane);
        const float rs = __builtin_amdgcn_rsqf(wave_sum((v.x * v.x + v.y * v.y) + (v.z * v.z + v.w * v.w)) * (1.f / KVL) + EPS);
        const f32x4 o = v * rs * gkv;
        float* oc = (m < MP) ? p.out + OFF_CKVP + (size_t)m * KVL : p.out + OFF_CKVS + (size_t)(m - MP) * KVL;
        *(f32x4*)(oc + 4 * lane) = o;
        unsigned long long w = (unsigned long long)pkbf(o.x, o.y) | ((unsigned long long)pkbf(o.z, o.w) << 32);
        *(unsigned long long*)(WSP(bf16, WS_CKVB) + (size_t)m * KVL + 4 * lane) = w;
        const float kr = WSP(float, WS_KRRAW)[(size_t)m * QKR + (lane & 31)];
        const float ssr = wave_sum(kr * kr) * 0.5f;
        const float n = kr * __builtin_amdgcn_rsqf(ssr * (1.f / QKR) + EPS) * gkr;
        const float other = __shfl_xor(n, 16);
        const int rr = pg8::rope_row(m), fi = lane & 15;
        const float cs = WSP(float, WS_RCOS)[rr * 16 + fi], sn = WSP(float, WS_RSIN)[rr * 16 + fi];
        const float ro = ((lane & 16) == 0) ? (n * cs - other * sn) : (other * sn + n * cs);
        if (lane < 32) {
            float* ok = (m < MP) ? p.out + OFF_KRP + (size_t)m * QKR : p.out + OFF_KRS + (size_t)(m - MP) * QKR;
            ok[lane] = ro;
        }
        const float nb = __shfl_xor(ro, 1);
        if (lane < 32 && (lane & 1) == 0) *(unsigned*)(WSP(bf16, WS_KRB) + (size_t)m * QKR + lane) = pkbf(ro, nb);
    }
}

__device__ __forceinline__ void thin_qabs(const Params& p, int wave, int lane) {
    const int gw = blockIdx.x * NWAVES + wave, NGW = gridDim.x * NWAVES, l15 = lane & 15, fq = lane >> 4;
    for (int it = gw; it < NSEQ * NH; it += NGW) {
        const int bs = it >> 4, h = it & 15;
        bf16x8 af[2];
#pragma unroll
        for (int ks = 0; ks < 2; ++ks) {
            v4u w = (v4u){0u, 0u, 0u, 0u};
            if (l15 < DSEQ) {
                const v4u qv = *(const v4u*)(WSP(bf16, WS_Q) + (size_t)(MP + bs * DSEQ + l15) * (NH * QKD) + h * QKD + 32 * ks + 8 * fq);
                const f32x4 g0 = *(const f32x4*)(p.in[I_GKN] + 32 * ks + 8 * fq), g1 = *(const f32x4*)(p.in[I_GKN] + 32 * ks + 8 * fq + 4);
                w.x = pkbf(bf_lo(qv.x) * g0.x, bf_hi(qv.x) * g0.y); w.y = pkbf(bf_lo(qv.y) * g0.z, bf_hi(qv.y) * g0.w);
                w.z = pkbf(bf_lo(qv.z) * g1.x, bf_hi(qv.z) * g1.y); w.w = pkbf(bf_lo(qv.w) * g1.z, bf_hi(qv.w) * g1.w);
            }
            af[ks] = __builtin_bit_cast(bf16x8, w);
        }
#pragma unroll 4
        for (int nb = 0; nb < 16; ++nb) {
            f32x4 acc = (f32x4){0.f, 0.f, 0.f, 0.f};
#pragma unroll
            for (int ks = 0; ks < 2; ++ks) {
                const float* wp = p.in[I_WUK] + ((size_t)(16 * nb + l15) * NH + h) * QKN + 32 * ks + 8 * fq;
                const f32x4 b0 = *(const f32x4*)wp, b1 = *(const f32x4*)(wp + 4);
                v4u w; w.x = pkbf(b0.x, b0.y); w.y = pkbf(b0.z, b0.w); w.z = pkbf(b1.x, b1.y); w.w = pkbf(b1.z, b1.w);
                acc = __builtin_amdgcn_mfma_f32_16x16x32_bf16(af[ks], __builtin_bit_cast(bf16x8, w), acc, 0, 0, 0);
            }
            if (fq < 2) {
#pragma unroll
                for (int j = 0; j < 4; ++j) WSP(bf16, WS_QABS)[((size_t)bs * 128 + h * 8 + 4 * fq + j) * KVL + 16 * nb + l15] = (bf16)(pkbf(acc[j], 0.f) & 0xffffu);
            }
        }
    }
}

__device__ __forceinline__ void thin_combine_uv(const Params& p, LAS unsigned char* lds, int wave, int lane) {
    const int gw = blockIdx.x * NWAVES + wave, NGW = gridDim.x * NWAVES;
    LAS float* cx = (LAS float*)(lds + wave * 8192);
    for (int it = gw; it < NSEQ * NH; it += NGW) {
        const int bs = it >> 4, h = it & 15;
#pragma unroll
        for (int q = 0; q < DSEQ; ++q) {
            const int col = h * 8 + q; float mx = -INFINITY, ms[NSPLIT], ls[NSPLIT];
#pragma unroll
            for (int s = 0; s < NSPLIT; ++s) { ms[s] = WSP(float, WS_MLM)[((size_t)bs * NSPLIT + s) * 128 + col];
                ls[s] = WSP(float, WS_MLL)[(((size_t)bs * NSPLIT + s) * 2 + 0) * 128 + col] + WSP(float, WS_MLL)[(((size_t)bs * NSPLIT + s) * 2 + 1) * 128 + col]; mx = fmaxf(mx, ms[s]); }
            float L = 0.f, wgt[NSPLIT];
#pragma unroll
            for (int s = 0; s < NSPLIT; ++s) { wgt[s] = __builtin_amdgcn_exp2f(ms[s] - mx); L += ls[s] * wgt[s]; }
            const float il = 1.0f / L; f32x4 a = (f32x4){0.f, 0.f, 0.f, 0.f};
#pragma unroll
            for (int s = 0; s < NSPLIT; ++s) a += *(const f32x4*)(WSP(float, WS_CTXP) + (((size_t)bs * NSPLIT + s) * 128 + col) * KVL + 4 * lane) * (wgt[s] * il);
            *(LAS f32x4*)(cx + q * KVL + 4 * lane) = a;
        }
        LDS_WAIT(); asm volatile("" ::: "memory");
        float o[DSEQ];
#pragma unroll
        for (int q = 0; q < DSEQ; ++q) o[q] = 0.f;
        const float* wv = p.in[I_WUV] + h * VH + lane;
#pragma unroll 4
        for (int c = 0; c < KVL; ++c) { const float w = wv[(size_t)c * (NH * VH)];
#pragma unroll
            for (int q = 0; q < DSEQ; ++q) o[q] += cx[q * KVL + c] * w; }
#pragma unroll
        for (int q = 0; q < DSEQ; ++q) WSP(bf16, WS_O)[(size_t)(MP + bs * DSEQ + q) * D + h * VH + lane] = (bf16)(pkbf(o[q], 0.f) & 0xffffu);
        LDS_WAIT(); asm volatile("" ::: "memory");
    }
}

__device__ __forceinline__ void thin_ffn_conv(const Params& p, int layer) {
    const float* cw = p.in[I_FCW] + (size_t)layer * 3 * DFF; const float* cb = p.in[I_FCB] + (size_t)layer * DFF;
    const float* st = p.in[I_SFC] + (size_t)layer * NSEQ * 2 * DFF;
    const int NIT = (M / 8) * (DFF / 8);
    for (int it = blockIdx.x * NTHR + threadIdx.x; it < NIT; it += gridDim.x * NTHR) {
        const int rg = it / (DFF / 8), ch = (it % (DFF / 8)) * 8, r0 = rg * 8;
        float w0[8], w1[8], w2[8], bb[8], gm2[8], gm1[8];
#pragma unroll
        for (int e = 0; e < 8; ++e) { w0[e] = cw[ch + e]; w1[e] = cw[DFF + ch + e]; w2[e] = cw[2 * DFF + ch + e]; bb[e] = cb[ch + e]; }
        if (r0 >= MP) { const float* s = st + (size_t)((r0 - MP) >> 3) * 2 * DFF + ch;
#pragma unroll
            for (int e = 0; e < 8; ++e) { gm2[e] = s[e]; gm1[e] = s[DFF + e]; }
        } else if ((r0 & (T - 1)) == 0) {
#pragma unroll
            for (int e = 0; e < 8; ++e) { gm2[e] = 0.f; gm1[e] = 0.f; }
        } else { const v4u a = *(const v4u*)(WSP(bf16, WS_G) + (size_t)(r0 - 2) * DFF + ch), b = *(const v4u*)(WSP(bf16, WS_G) + (size_t)(r0 - 1) * DFF + ch);
#pragma unroll
            for (int e = 0; e < 4; ++e) { gm2[2 * e] = bf_lo(a[e]); gm2[2 * e + 1] = bf_hi(a[e]); gm1[2 * e] = bf_lo(b[e]); gm1[2 * e + 1] = bf_hi(b[e]); } }
#pragma unroll
        for (int r = 0; r < 8; ++r) {
            const v4u gw_ = *(const v4u*)(WSP(bf16, WS_G) + (size_t)(r0 + r) * DFF + ch), uw = *(const v4u*)(WSP(bf16, WS_U) + (size_t)(r0 + r) * DFF + ch);
            float hv[8];
#pragma unroll
            for (int e = 0; e < 8; ++e) { const float g = (e & 1) ? bf_hi(gw_[e >> 1]) : bf_lo(gw_[e >> 1]), uu = (e & 1) ? bf_hi(uw[e >> 1]) : bf_lo(uw[e >> 1]);
                const float c = gm2[e] * w0[e] + gm1[e] * w1[e] + g * w2[e] + bb[e];
                hv[e] = c * __builtin_amdgcn_rcpf(1.0f + __builtin_amdgcn_exp2f(-1.4426950408889634f * c)) * uu;
                gm2[e] = gm1[e]; gm1[e] = g; }
            v4u o; o.x = pkbf(hv[0], hv[1]); o.y = pkbf(hv[2], hv[3]); o.z = pkbf(hv[4], hv[5]); o.w = pkbf(hv[6], hv[7]);
            *(v4u*)(WSP(bf16, WS_HB) + (size_t)(r0 + r) * DFF + ch) = o;
        }
    }
}

__device__ __forceinline__ void thin_rec_conv(const Params& p) {
    const float* cw = p.in[I_RCW]; const float* cb = p.in[I_RCB]; const float* st = p.in[I_SLC];
    const int NIT = (M / 8) * (D / 4);
    for (int it = blockIdx.x * NTHR + threadIdx.x; it < NIT; it += gridDim.x * NTHR) {
        const int rg = it / (D / 4), ch = (it % (D / 4)) * 4, r0 = rg * 8;
        const f32x4 w0 = *(const f32x4*)(cw + ch), w1 = *(const f32x4*)(cw + D + ch), w2 = *(const f32x4*)(cw + 2 * D + ch), w3 = *(const f32x4*)(cw + 3 * D + ch), bb = *(const f32x4*)(cb + ch);
        f32x4 x3, x2, x1;
        if (r0 >= MP) { const float* s = st + (size_t)((r0 - MP) >> 3) * 3 * D + ch; x3 = *(const f32x4*)s; x2 = *(const f32x4*)(s + D); x1 = *(const f32x4*)(s + 2 * D); }
        else if ((r0 & (T - 1)) == 0) { x3 = (f32x4){0.f, 0.f, 0.f, 0.f}; x2 = x3; x1 = x3; }
        else { const float* s = WSP(float, WS_XR) + (size_t)(r0 - 3) * D + ch; x3 = *(const f32x4*)s; x2 = *(const f32x4*)(s + D); x1 = *(const f32x4*)(s + 2 * D); }
#pragma unroll
        for (int r = 0; r < 8; ++r) {
            const f32x4 x0 = *(const f32x4*)(WSP(float, WS_XR) + (size_t)(r0 + r) * D + ch);
            const f32x4 y = x3 * w0 + x2 * w1 + x1 * w2 + x0 * w3 + bb;
            *(unsigned long long*)(WSP(bf16, WS_XC) + (size_t)(r0 + r) * D + ch) = (unsigned long long)pkbf(y.x, y.y) | ((unsigned long long)pkbf(y.z, y.w) << 32);
            x3 = x2; x2 = x1; x1 = x0;
        }
    }
}

__device__ __forceinline__ void thin_scan1(const Params& p) {
    const float* LAp = WSP(float, WS_LA); const float* BXp = WSP(float, WS_BX);
    for (int it = blockIdx.x * NTHR + threadIdx.x; it < NBATCH * 16 * D; it += gridDim.x * NTHR) {
        const int ch = it & (D - 1), bc = it >> 10; const size_t r0 = (size_t)bc * 128;
        float h = 0.f, pa = 1.f;
#pragma unroll 8
        for (int r = 0; r < 128; ++r) { const float a = LAp[(r0 + r) * D + ch], b = BXp[(r0 + r) * D + ch]; h = a * h + b; pa *= a; }
        WSP(float, WS_PA)[(size_t)bc * D + ch] = pa; WSP(float, WS_HL)[(size_t)bc * D + ch] = h;
    }
    for (int it = blockIdx.x * NTHR + threadIdx.x; it < NSEQ * D; it += gridDim.x * NTHR) {
        const int ch = it & (D - 1), bs = it >> 10; const size_t r0 = (size_t)MP + bs * DSEQ;
        float h = p.in[I_SLH][(size_t)bs * D + ch];
#pragma unroll
        for (int r = 0; r < DSEQ; ++r) { h = LAp[(r0 + r) * D + ch] * h + BXp[(r0 + r) * D + ch];
            const bf16 g = WSP(bf16, WS_GATE)[(r0 + r) * D + ch];
            WSP(bf16, WS_Y)[(r0 + r) * D + ch] = (bf16)(pkbf(h * __uint_as_float((unsigned)g << 16), 0.f) & 0xffffu); }
        p.out[OFF_LHS + (size_t)bs * D + ch] = h;
    }
}
__device__ __forceinline__ void thin_scan2(const Params& p) {
    const float* LAp = WSP(float, WS_LA); const float* BXp = WSP(float, WS_BX);
    for (int it = blockIdx.x * NTHR + threadIdx.x; it < NBATCH * 16 * D; it += gridDim.x * NTHR) {
        const int ch = it & (D - 1), bc = it >> 10, c = bc & 15; const size_t r0 = (size_t)bc * 128;
        float h = 0.f;
        for (int cc = 0; cc < c; ++cc) h = WSP(float, WS_PA)[(size_t)(bc - c + cc) * D + ch] * h + WSP(float, WS_HL)[(size_t)(bc - c + cc) * D + ch];
#pragma unroll 8
        for (int r = 0; r < 128; ++r) { h = LAp[(r0 + r) * D + ch] * h + BXp[(r0 + r) * D + ch];
            const bf16 g = WSP(bf16, WS_GATE)[(r0 + r) * D + ch];
            WSP(bf16, WS_Y)[(r0 + r) * D + ch] = (bf16)(pkbf(h * __uint_as_float((unsigned)g << 16), 0.f) & 0xffffu); }
        if (c == 15) p.out[OFF_LHP + (size_t)(bc >> 4) * D + ch] = h;
    }
}


typedef float f32x16 __attribute__((ext_vector_type(16)));
typedef short s16x4 __attribute__((ext_vector_type(4)));
#define MFMA32(a, b, c) __builtin_amdgcn_mfma_f32_32x32x16_bf16((a), (b), (c), 0, 0, 0)
#define MFMA16(a, b, c) __builtin_amdgcn_mfma_f32_16x16x32_bf16((a), (b), (c), 0, 0, 0)

constexpr int PA_KP = 208, PA_VP = 144;
constexpr int PA_KB = 64 * PA_KP, PA_VB = 64 * PA_VP, PA_BUF = PA_KB + PA_VB;
__device__ __forceinline__ void pa_unit(const Params& p, LAS unsigned char* lds, int b, int h, int qb) {
    const int tid = threadIdx.x, lane = tid & 63, w = __builtin_amdgcn_readfirstlane(tid >> 6), r32 = lane & 31, hi = lane >> 5;
    const bf16* Kg = WSP(bf16, WS_K96) + (size_t)(b * NH + h) * T * QKD;
    const bf16* Vg = WSP(bf16, WS_VT) + (size_t)(b * NH + h) * VH * T;
    const int NT = 4 * (qb + 1);
    const int qrow = b * T + qb * 256 + w * 32 + r32, qabs = qb * 256 + w * 32 + r32;
    const int kc0 = tid, kc1 = 512 + tid;
    const int kl0 = (kc0 / 12) * PA_KP + (kc0 % 12) * 16, kl1 = (kc1 / 12) * PA_KP + (kc1 % 12) * 16;
    const int vd = tid >> 3, vcc = tid & 7, vl = PA_KB + vd * PA_VP + vcc * 16;
    v4u rk0, rk1 = (v4u){0u, 0u, 0u, 0u}, rv;
#define PA_LOAD(kt) do { const bf16* ks_ = Kg + (size_t)(kt) * 64 * QKD; rk0 = *(const v4u*)(ks_ + kc0 * 8); if (tid < 256) rk1 = *(const v4u*)(ks_ + kc1 * 8); \
        rv = *(const v4u*)(Vg + (size_t)vd * T + (kt) * 64 + vcc * 8); } while (0)
#define PA_STORE(buf) do { LAS unsigned char* b_ = lds + (buf) * PA_BUF; *(LAS v4u*)(b_ + kl0) = rk0; if (tid < 256) *(LAS v4u*)(b_ + kl1) = rk1; *(LAS v4u*)(b_ + vl) = rv; } while (0)
    PA_LOAD(0);
    bf16x8 qf[6];
#pragma unroll
    for (int d0 = 0; d0 < 6; ++d0) qf[d0] = *(const bf16x8*)(WSP(bf16, WS_Q) + (size_t)qrow * (NH * QKD) + h * QKD + 16 * d0 + 8 * hi);
    __syncthreads();
    PA_STORE(0);
    __syncthreads();
    f32x16 o0, o1;
#pragma unroll
    for (int r = 0; r < 16; ++r) { o0[r] = 0.f; o1[r] = 0.f; }
    float m_run = -INFINITY, l_run = 0.f;
    const int pi = (r32 & 0x13) | ((r32 & 4) << 1) | ((r32 & 8) >> 1);
    const int qmax_w = qb * 256 + w * 32 + 31, qmin_w = qb * 256 + w * 32;
    for (int kt = 0; kt < NT; ++kt) {
        if (kt + 1 < NT) PA_LOAD(kt + 1);
        if (kt * 64 <= qmax_w) {
            const LAS unsigned char* Kb = lds + (kt & 1) * PA_BUF; const LAS unsigned char* Vb = Kb + PA_KB;
            f32x16 p0, p1;
#pragma unroll
            for (int r = 0; r < 16; ++r) { p0[r] = 0.f; p1[r] = 0.f; }
#pragma unroll
            for (int d0 = 0; d0 < 6; ++d0) {
                const bf16x8 a0 = *(const LAS bf16x8*)(Kb + pi * PA_KP + (16 * d0 + 8 * hi) * 2);
                const bf16x8 a1 = *(const LAS bf16x8*)(Kb + (32 + pi) * PA_KP + (16 * d0 + 8 * hi) * 2);
                p0 = MFMA32(a0, qf[d0], p0); p1 = MFMA32(a1, qf[d0], p1);
            }
            if (kt * 64 + 63 > qmin_w) {
                const int kb = kt * 64 + 8 * hi;
#pragma unroll
                for (int r = 0; r < 16; ++r) { const int key = kb + 16 * (r >> 3) + (r & 7); if (key > qabs) p0[r] = -INFINITY; if (key + 32 > qabs) p1[r] = -INFINITY; }
            }
            float mx = p0[0];
#pragma unroll
            for (int r = 1; r < 16; ++r) mx = fmaxf(mx, p0[r]);
#pragma unroll
            for (int r = 0; r < 16; ++r) mx = fmaxf(mx, p1[r]);
            mx = fmaxf(mx, __shfl_xor(mx, 32));
            const float mn = fmaxf(m_run, mx), f = __builtin_amdgcn_exp2f(m_run - mn); m_run = mn;
            float ls = 0.f;
#pragma unroll
            for (int r = 0; r < 16; ++r) { p0[r] = __builtin_amdgcn_exp2f(p0[r] - mn); p1[r] = __builtin_amdgcn_exp2f(p1[r] - mn); ls += p0[r] + p1[r]; }
            l_run = l_run * f + ls;
#pragma unroll
            for (int r = 0; r < 16; ++r) { o0[r] *= f; o1[r] *= f; }
            bf16x8 pb[4];
#pragma unroll
            for (int ks = 0; ks < 2; ++ks) {
                v4u w0, w1;
                w0.x = pkbf(p0[8 * ks + 0], p0[8 * ks + 1]); w0.y = pkbf(p0[8 * ks + 2], p0[8 * ks + 3]); w0.z = pkbf(p0[8 * ks + 4], p0[8 * ks + 5]); w0.w = pkbf(p0[8 * ks + 6], p0[8 * ks + 7]);
                w1.x = pkbf(p1[8 * ks + 0], p1[8 * ks + 1]); w1.y = pkbf(p1[8 * ks + 2], p1[8 * ks + 3]); w1.z = pkbf(p1[8 * ks + 4], p1[8 * ks + 5]); w1.w = pkbf(p1[8 * ks + 6], p1[8 * ks + 7]);
                pb[ks] = __builtin_bit_cast(bf16x8, w0); pb[2 + ks] = __builtin_bit_cast(bf16x8, w1);
            }
#pragma unroll
            for (int ks = 0; ks < 4; ++ks) {
                const bf16x8 v0 = *(const LAS bf16x8*)(Vb + r32 * PA_VP + (16 * ks + 8 * hi) * 2);
                const bf16x8 v1 = *(const LAS bf16x8*)(Vb + (32 + r32) * PA_VP + (16 * ks + 8 * hi) * 2);
                o0 = MFMA32(v0, pb[ks], o0); o1 = MFMA32(v1, pb[ks], o1);
            }
        }
        if (kt + 1 < NT) PA_STORE((kt + 1) & 1);
        __syncthreads();
    }
    const float lt = l_run + __shfl_xor(l_run, 32), il = 1.0f / lt;
    bf16* op = WSP(bf16, WS_O) + (size_t)qrow * D + h * VH;
#pragma unroll
    for (int g = 0; g < 4; ++g) {
        unsigned long long w0 = (unsigned long long)pkbf(o0[4 * g] * il, o0[4 * g + 1] * il) | ((unsigned long long)pkbf(o0[4 * g + 2] * il, o0[4 * g + 3] * il) << 32);
        unsigned long long w1 = (unsigned long long)pkbf(o1[4 * g] * il, o1[4 * g + 1] * il) | ((unsigned long long)pkbf(o1[4 * g + 2] * il, o1[4 * g + 3] * il) << 32);
        *(unsigned long long*)(op + 8 * g + 4 * hi) = w0; *(unsigned long long*)(op + 32 + 8 * g + 4 * hi) = w1;
    }
#undef PA_LOAD
#undef PA_STORE
}

constexpr int SA_CP = 528, SA_KP = 80, SA_PP = 144;
constexpr int SA_CB = 64 * SA_CP, SA_KB = 64 * SA_KP, SA_RB = 64 * 64, SA_BUF = SA_CB + SA_KB + SA_RB;
constexpr int SA_PT = 2 * SA_BUF, SA_SMX = SA_PT + 128 * SA_PP, SA_END = SA_SMX + 2 * 128 * 4;
__device__ __forceinline__ void sa_unit(const Params& p, LAS unsigned char* lds, int bs, int sp) {
    const int tid = threadIdx.x, lane = tid & 63, w = __builtin_amdgcn_readfirstlane(tid >> 6), wr = w >> 2, wc = w & 3, l15 = lane & 15, fq = lane >> 4;
    bf16x8 qa[2][8], qrp[2];
#pragma unroll
    for (int n = 0; n < 2; ++n) {
        const int col = 32 * wc + 16 * n + l15;
#pragma unroll
        for (int ks = 0; ks < 8; ++ks) qa[n][ks] = *(const bf16x8*)(WSP(bf16, WS_QABS) + ((size_t)bs * 128 + col) * KVL + 32 * ks + 8 * fq);
        qrp[n] = *(const bf16x8*)(WSP(bf16, WS_Q) + (size_t)(MP + bs * DSEQ + (col & 7)) * (NH * QKD) + (col >> 3) * QKD + QKN + 8 * fq);
    }
    f32x4 ctx[8][2];
#pragma unroll
    for (int cb = 0; cb < 8; ++cb) { ctx[cb][0] = (f32x4){0.f, 0.f, 0.f, 0.f}; ctx[cb][1] = (f32x4){0.f, 0.f, 0.f, 0.f}; }
    float m_run[2] = {-INFINITY, -INFINITY}, l_run[2] = {0.f, 0.f};
    const int NTC = (PAST / NSPLIT) / 64, NT = NTC + ((sp == NSPLIT - 1) ? 1 : 0);
    const size_t row0 = (size_t)bs * PAST + (size_t)sp * (PAST / NSPLIT);
    v4u rc[4], rx;
    const int t5 = tid & 255, r5 = t5 >> 2, c5 = t5 & 3, rC = tid >> 3, cC = tid & 7;
#define SA_LOAD(kt) do { const bool nw_ = (kt) >= NTC; const size_t rb_ = nw_ ? (size_t)MP + bs * DSEQ : row0 + (size_t)(kt) * 64; \
        const bf16* cs_ = (nw_ ? WSP(bf16, WS_CKVB) : WSP(bf16, WS_CB16)) + rb_ * KVL; \
        const unsigned char* xs_ = (tid < 256) ? (const unsigned char*)((nw_ ? WSP(bf16, WS_KRB) : WSP(bf16, WS_KRB16)) + rb_ * QKR) + r5 * 64 + c5 * 16 \
                                               : (const unsigned char*)((nw_ ? WSP(float, WS_RSN) + (size_t)bs * DSEQ * 16 : WSP(float, WS_RS) + rb_ * 16)) + r5 * 64 + c5 * 16; \
        if (!nw_ || rC < DSEQ) { const v4u* s4_ = (const v4u*)(cs_ + rC * KVL + cC * 32); rc[0] = s4_[0]; rc[1] = s4_[1]; rc[2] = s4_[2]; rc[3] = s4_[3]; } \
        else { rc[0] = (v4u){0u, 0u, 0u, 0u}; rc[1] = rc[0]; rc[2] = rc[0]; rc[3] = rc[0]; } \
        if (!nw_ || r5 < DSEQ) rx = *(const v4u*)xs_; else rx = (v4u){0u, 0u, 0u, 0u}; } while (0)
#define SA_STORE(buf) do { LAS unsigned char* b_ = lds + (buf) * SA_BUF; LAS v4u* d4_ = (LAS v4u*)(b_ + rC * SA_CP + cC * 64); d4_[0] = rc[0]; d4_[1] = rc[1]; d4_[2] = rc[2]; d4_[3] = rc[3]; \
        *(LAS v4u*)(b_ + SA_CB + ((tid < 256) ? 0 : SA_KB) + r5 * ((tid < 256) ? SA_KP : 64) + c5 * 16) = rx; } while (0)
    SA_LOAD(0);
    __syncthreads();
    SA_STORE(0);
    __syncthreads();
    LAS unsigned char* Pt = lds + SA_PT; LAS float* SMX = (LAS float*)(lds + SA_SMX);
    for (int kt = 0; kt < NT; ++kt) {
        const LAS unsigned char* Cb = lds + (kt & 1) * SA_BUF; const LAS unsigned char* Kb = Cb + SA_CB; const LAS unsigned char* Rb = Kb + SA_KB;
        f32x4 sn[2][2];
#pragma unroll
        for (int m = 0; m < 2; ++m)
#pragma unroll
            for (int n = 0; n < 2; ++n) sn[m][n] = (f32x4){0.f, 0.f, 0.f, 0.f};
#pragma unroll
        for (int ks = 0; ks < 8; ++ks) {
            bf16x8 a[2];
#pragma unroll
            for (int m = 0; m < 2; ++m) a[m] = *(const LAS bf16x8*)(Cb + (32 * wr + 16 * m + l15) * SA_CP + (32 * ks + 8 * fq) * 2);
#pragma unroll
            for (int m = 0; m < 2; ++m)
#pragma unroll
                for (int n = 0; n < 2; ++n) sn[m][n] = MFMA16(a[m], qa[n][ks], sn[m][n]);
            if (ks & 1) __builtin_amdgcn_sched_barrier(0);
        }
#pragma unroll
        for (int m = 0; m < 2; ++m)
#pragma unroll
            for (int n = 0; n < 2; ++n)
#pragma unroll
                for (int j = 0; j < 4; ++j) sn[m][n][j] *= *(const LAS float*)(Rb + (32 * wr + 16 * m + 4 * fq + j) * 64 + (4 * wc + 2 * n + (l15 >> 3)) * 4);
        {
            bf16x8 a[2];
#pragma unroll
            for (int m = 0; m < 2; ++m) a[m] = *(const LAS bf16x8*)(Kb + (32 * wr + 16 * m + l15) * SA_KP + fq * 16);
#pragma unroll
            for (int m = 0; m < 2; ++m)
#pragma unroll
                for (int n = 0; n < 2; ++n) sn[m][n] = MFMA16(a[m], qrp[n], sn[m][n]);
        }
        const bool newtile = (kt >= NTC);
        float lmax[2] = {-INFINITY, -INFINITY};
#pragma unroll
        for (int m = 0; m < 2; ++m)
#pragma unroll
            for (int n = 0; n < 2; ++n)
#pragma unroll
                for (int j = 0; j < 4; ++j) { const int key = 32 * wr + 16 * m + 4 * fq + j;
                    float s = sn[m][n][j];
                    if (newtile && key > (l15 & 7)) s = -INFINITY;
                    sn[m][n][j] = s; lmax[n] = fmaxf(lmax[n], s); }
#pragma unroll
        for (int n = 0; n < 2; ++n) { lmax[n] = fmaxf(lmax[n], __shfl_xor(lmax[n], 16)); lmax[n] = fmaxf(lmax[n], __shfl_xor(lmax[n], 32)); }
        if (fq == 0) { SMX[wr * 128 + 32 * wc + l15] = lmax[0]; SMX[wr * 128 + 32 * wc + 16 + l15] = lmax[1]; }
        __syncthreads();
        if (kt + 1 < NT) SA_LOAD(kt + 1);
        float f[2];
#pragma unroll
        for (int n = 0; n < 2; ++n) { const int col = 32 * wc + 16 * n + l15;
            const float tm = fmaxf(SMX[col], SMX[128 + col]), mn = fmaxf(m_run[n], tm);
            f[n] = __builtin_amdgcn_exp2f(m_run[n] - mn); m_run[n] = mn; float ls = 0.f;
#pragma unroll
            for (int m = 0; m < 2; ++m) { float e[4];
#pragma unroll
                for (int j = 0; j < 4; ++j) { e[j] = __builtin_amdgcn_exp2f(sn[m][n][j] - mn); ls += e[j]; }
                *(LAS unsigned long long*)(Pt + col * SA_PP + (32 * wr + 16 * m + 4 * fq) * 2) = (unsigned long long)pkbf(e[0], e[1]) | ((unsigned long long)pkbf(e[2], e[3]) << 32); }
            l_run[n] = l_run[n] * f[n] + ls; }
        __syncthreads();
#pragma unroll
        for (int cb = 0; cb < 8; ++cb) { ctx[cb][0] *= f[0]; ctx[cb][1] *= f[1]; }
#pragma unroll
        for (int ks = 0; ks < 2; ++ks) {
            bf16x8 pb[2];
#pragma unroll
            for (int n = 0; n < 2; ++n) pb[n] = *(const LAS bf16x8*)(Pt + (32 * wc + 16 * n + l15) * SA_PP + (32 * ks + 8 * fq) * 2);
            const LAS unsigned char* tb = Cb + (32 * ks + 8 * fq + (l15 >> 2)) * SA_CP + (128 * wr + 4 * (l15 & 3)) * 2;
#pragma unroll
            for (int cb = 0; cb < 8; ++cb) {
                const s16x4 t0 = __builtin_bit_cast(s16x4, __builtin_amdgcn_ds_read_tr16_b64_v4i16((LAS s16x4*)(tb + cb * 32)));
                const s16x4 t1 = __builtin_bit_cast(s16x4, __builtin_amdgcn_ds_read_tr16_b64_v4i16((LAS s16x4*)(tb + 4 * SA_CP + cb * 32)));
                const bf16x8 at = (bf16x8){t0[0], t0[1], t0[2], t0[3], t1[0], t1[1], t1[2], t1[3]};
                ctx[cb][0] = MFMA16(at, pb[0], ctx[cb][0]); ctx[cb][1] = MFMA16(at, pb[1], ctx[cb][1]);
                if (cb & 1) __builtin_amdgcn_sched_barrier(0);
            }
        }
        if (kt + 1 < NT) SA_STORE((kt + 1) & 1);
        __syncthreads();
    }
#pragma unroll
    for (int n = 0; n < 2; ++n) { const int col = 32 * wc + 16 * n + l15; float l = l_run[n]; l += __shfl_xor(l, 16); l += __shfl_xor(l, 32);
        if (fq == 0) { WSP(float, WS_MLL)[(((size_t)bs * NSPLIT + sp) * 2 + wr) * 128 + col] = l; if (wr == 0) WSP(float, WS_MLM)[((size_t)bs * NSPLIT + sp) * 128 + col] = m_run[n]; }
#pragma unroll
        for (int cb = 0; cb < 8; ++cb) *(f32x4*)(WSP(float, WS_CTXP) + (((size_t)bs * NSPLIT + sp) * 128 + col) * KVL + 128 * wr + 16 * cb + 4 * fq) = ctx[cb][n]; }
#undef SA_LOAD
#undef SA_STORE
}

#ifndef MK_PER_PHASE
#define MK_PER_PHASE 0
#endif
constexpr int NPH = 20;
constexpr int RING_BYTES = 131072, MISC_OFF = RING_BYTES + 320, LDS_BYTES = 147456;
constexpr int CW_BAR = 4096;
static_assert((CW_BAR + XCD_BAR_WORDS) * 4 <= (int)CTL_ZERO_BYTES && SA_END <= RING_BYTES && 2 * PA_BUF <= RING_BYTES && pg8::STAGE_BYTES <= RING_BYTES, "LDS / CTL maps");

__global__ void __launch_bounds__(NTHR, 2) fwd_kernel(Params p) {
    extern __shared__ __attribute__((aligned(16))) unsigned char lds_raw[];
    LAS unsigned char* lds = (LAS unsigned char*)lds_raw;
    const int tid = threadIdx.x, lane = tid & 63, wave = __builtin_amdgcn_readfirstlane(tid >> 6);
    volatile LAS unsigned* MISC = (volatile LAS unsigned*)(lds + MISC_OFF);
    for (int u = tid; u < (LDS_BYTES - RING_BYTES) / 4; u += NTHR) ((LAS unsigned*)(lds + RING_BYTES))[u] = 0u;
    __syncthreads();
    const int lo = p.ph_lo, hi = p.ph_hi;
    XcdBarrier bar; bar.bar = (unsigned*)p.ws + CW_BAR; bar.x = 0; bar.st = nullptr;
    if (hi - lo > 1) bar = xcd_barrier_post((unsigned*)p.ws + CW_BAR, MISC + 8);
#ifndef SUBMASK
#define SUBMASK 0xFFu
#endif
#ifndef PH_MASK
#define PH_MASK 0xFFFFFu
#endif
#define IN(k) (((PH_MASK >> (k)) & 1u) && lo <= (k) && (k) < hi)
#define SEAM(k) do { if (IN(k) && IN((k) + 1)) xcd_barrier(bar); } while (0)
    const int G = gridDim.x, bid = blockIdx.x;
    using pg8::Gemm; using pg8::StaticOrder; using pg8::gemm_phase;

    if (IN(0)) { p0_prologue(p, lds, wave, lane); }
    SEAM(0);
    if (IN(1)) { Gemm g{WSP(bf16, WS_XN), WSP(bf16, WS_WD), D, D, D, 0}; StaticOrder S; S.init(M, 1024, G, bid);
        pg8::EpiDown E{WSP(bf16, WS_CQ), WSP(float, WS_CKVRAW), WSP(float, WS_KRRAW), WSP(float, WS_SSQ1)};
        gemm_phase<pg8::EpiDown, StaticOrder, true, true>(lds, g, S, E); }
    SEAM(1);
    if (IN(2)) { thin_ckv_krope(p, wave, lane);
        Gemm g{WSP(bf16, WS_CQ), WSP(bf16, WS_WUQ), QL, QL, QL, 0}; StaticOrder S; S.init(M, NH * QKD, G, bid);
        pg8::EpiQ E{WSP(bf16, WS_Q), WSP(float, WS_SSQ1), p.in[I_GQN], p.in[I_GQR], WSP(float, WS_RCOS), WSP(float, WS_RSIN)};
        gemm_phase<pg8::EpiQ, StaticOrder, true, true>(lds, g, S, E); }
    SEAM(2);
    if (IN(3)) {
        if (SUBMASK & 1u) { Gemm g{WSP(bf16, WS_CKVB), WSP(bf16, WS_WK), KVL, KVL, KVL, 0}; StaticOrder S; S.init(M, NH * QKN, G, bid);
          pg8::EpiK E{WSP(bf16, WS_K96), WSP(bf16, WS_KRB), p.in[I_GKN], WSP(float, WS_RSN)};
          gemm_phase<pg8::EpiK, StaticOrder, true, true>(lds, g, S, E); }
        if (SUBMASK & 2u) { Gemm g{WSP(bf16, WS_WV), WSP(bf16, WS_CKVB), KVL, KVL, KVL, 0}; StaticOrder S; S.init(NH * VH, MP, G, bid);
          pg8::EpiVT E{WSP(bf16, WS_VT)};
          gemm_phase<pg8::EpiVT, StaticOrder, true, true>(lds, g, S, E); }
        if (SUBMASK & 4u) thin_qabs(p, wave, lane);
    }
    SEAM(3);
    if (IN(4)) { Gemm g{WSP(bf16, WS_CB16), WSP(bf16, WS_WK), KVL, KVL, KVL, 0}; StaticOrder S; S.init(NSEQ * PAST, NH * QKN, G, bid);
        pg8::EpiRS E{WSP(float, WS_RS)};
        gemm_phase<pg8::EpiRS, StaticOrder, true, true>(lds, g, S, E); }
    SEAM(4);
    if (IN(5)) {
        if (SUBMASK & 1u) for (int u = bid; u < NSEQ * NSPLIT; u += G) sa_unit(p, lds, u / NSPLIT, u % NSPLIT);
        if (SUBMASK & 2u) for (int pid = bid; pid < NBATCH * NH * 4; pid += G) { const int bh = pid >> 2, s = pid & 3; pa_unit(p, lds, bh >> 4, bh & 15, s); pa_unit(p, lds, bh >> 4, bh & 15, 7 - s); }
    }
    SEAM(5);
    if (IN(6)) { thin_combine_uv(p, lds, wave, lane); }
    SEAM(6);
    if (IN(7)) { Gemm g{WSP(bf16, WS_O), WSP(bf16, WS_WO), D, D, D, 0}; StaticOrder S; S.init(M, D, G, bid);
        pg8::EpiRes E{p.in[I_XP], p.in[I_XS], WSP(float, WS_X1), WSP(float, WS_X1) + (size_t)MP * D, WSP(bf16, WS_X1B), WSP(float, WS_SS1)};
        gemm_phase<pg8::EpiRes, StaticOrder, true, true>(lds, g, S, E); }
    SEAM(7);
    if (IN(8)) { Gemm g{WSP(bf16, WS_X1B), WSP(bf16, WS_WUP), D, D, D, 0}; StaticOrder S; S.init(M, 2 * DFF, G, bid);
        pg8::EpiUp E{WSP(float, WS_SS1), WSP(bf16, WS_G), WSP(bf16, WS_U), p.out + OFF_FCP, p.out + OFF_FCS};
        gemm_phase<pg8::EpiUp, StaticOrder, true, true>(lds, g, S, E); }
    SEAM(8);
    if (IN(9)) { thin_ffn_conv(p, 0); }
    SEAM(9);
    if (IN(10)) { Gemm g{WSP(bf16, WS_HB), WSP(bf16, WS_WDN), DFF, DFF, DFF, 0}; StaticOrder S; S.init(M, D, G, bid);
        pg8::EpiRes E{WSP(float, WS_X1), WSP(float, WS_X1) + (size_t)MP * D, WSP(float, WS_X2), WSP(float, WS_X2) + (size_t)MP * D, WSP(bf16, WS_X2B), WSP(float, WS_SS2)};
        gemm_phase<pg8::EpiRes, StaticOrder, true, true>(lds, g, S, E); }
    SEAM(10);
    if (IN(11)) { Gemm g{WSP(bf16, WS_X2B), WSP(bf16, WS_WIN), D, D, D, 0}; StaticOrder S; S.init(M, 2 * D, G, bid);
        pg8::EpiIn E{WSP(float, WS_SS2), WSP(float, WS_XR), WSP(bf16, WS_GATE), p.out + OFF_LCP, p.out + OFF_LCS};
        gemm_phase<pg8::EpiIn, StaticOrder, true, true>(lds, g, S, E); }
    SEAM(11);
    if (IN(12)) { thin_rec_conv(p); }
    SEAM(12);
    if (IN(13)) { Gemm g{WSP(bf16, WS_XC), WSP(bf16, WS_WAI), D, LB, LB, LB}; StaticOrder S; S.init(M, NLB * 256, G, bid);
        pg8::EpiLru E{WSP(bf16, WS_XC), p.in[I_BA], p.in[I_BI], WSP(float, WS_SP8), WSP(float, WS_LA), WSP(float, WS_BX)};
        gemm_phase<pg8::EpiLru, StaticOrder, true, true>(lds, g, S, E); }
    SEAM(13);
    if (IN(14)) { thin_scan1(p); }
    SEAM(14);
    if (IN(15)) { thin_scan2(p); }
    SEAM(15);
    if (IN(16)) { Gemm g{WSP(bf16, WS_Y), WSP(bf16, WS_WOUT), D, D, D, 0}; StaticOrder S; S.init(M, D, G, bid);
        pg8::EpiRes E{WSP(float, WS_X2), WSP(float, WS_X2) + (size_t)MP * D, WSP(float, WS_X3), WSP(float, WS_X3) + (size_t)MP * D, WSP(bf16, WS_X3B), WSP(float, WS_SS3)};
        gemm_phase<pg8::EpiRes, StaticOrder, true, true>(lds, g, S, E); }
    SEAM(16);
    if (IN(17)) { Gemm g{WSP(bf16, WS_X3B), WSP(bf16, WS_WUP) + (size_t)2 * DFF * D, D, D, D, 0}; StaticOrder S; S.init(M, 2 * DFF, G, bid);
        pg8::EpiUp E{WSP(float, WS_SS3), WSP(bf16, WS_G), WSP(bf16, WS_U), p.out + OFF_FCP + (size_t)NBATCH * 2 * DFF, p.out + OFF_FCS + (size_t)NSEQ * 2 * DFF};
        gemm_phase<pg8::EpiUp, StaticOrder, true, true>(lds, g, S, E); }
    SEAM(17);
    if (IN(18)) { thin_ffn_conv(p, 1); }
    SEAM(18);
    if (IN(19)) { Gemm g{WSP(bf16, WS_HB), WSP(bf16, WS_WDN) + (size_t)D * DFF, DFF, DFF, DFF, 0}; StaticOrder S; S.init(M, D, G, bid);
        pg8::EpiRes E{WSP(float, WS_X3), WSP(float, WS_X3) + (size_t)MP * D, p.out + OFF_YP, p.out + OFF_YS, nullptr, nullptr};
        gemm_phase<pg8::EpiRes, StaticOrder, true, true>(lds, g, S, E); }
#undef IN
#undef SEAM
}

extern "C" void kernel_launch(void* const* d_in, const int* in_sizes, int n_in, void* d_out, int out_size, void* d_ws, size_t ws_size, hipStream_t stream) {
    static int grid = 0;
    if (grid == 0) {
        if (n_in != N_IN || out_size != (int)OUT_TOTAL || ws_size < WS_END) { fprintf(stderr, "kernel_launch: unexpected shapes (n_in %d, out %d, ws %zu < %zu)\n", n_in, out_size, ws_size, (size_t)WS_END); grid = -1; return; }
        int dev = 0, cus = 0;
        if (hipGetDevice(&dev) != hipSuccess || hipDeviceGetAttribute(&cus, hipDeviceAttributeMultiprocessorCount, dev) != hipSuccess) { grid = -1; return; }
        if (hipFuncSetAttribute((const void*)fwd_kernel, hipFuncAttributeMaxDynamicSharedMemorySize, LDS_BYTES) != hipSuccess) { fprintf(stderr, "kernel_launch: hipFuncSetAttribute failed\n"); grid = -1; return; }
        int per_cu = 0;
        if (hipOccupancyMaxActiveBlocksPerMultiprocessor(&per_cu, (const void*)fwd_kernel, NTHR, LDS_BYTES) != hipSuccess || per_cu < 1) fprintf(stderr, "kernel_launch: occupancy query reports %d\n", per_cu);
        (void)hipGetLastError();
        grid = cus;
    }
    if (grid < 0) return;
    (void)in_sizes;
    if (hipMemsetAsync(d_ws, 0, CTL_ZERO_BYTES, stream) != hipSuccess) { fprintf(stderr, "kernel_launch: memset failed\n"); return; }
    Params p{};
    for (int i = 0; i < N_IN; ++i) p.in[i] = (const float*)d_in[i];
    p.out = (float*)d_out; p.ws = (unsigned char*)d_ws;
#if MK_PER_PHASE
#ifndef DBG_LAST_PH
#define DBG_LAST_PH NPH
#endif
    if (DBG_LAST_PH < NPH) (void)hipMemsetAsync(d_out, 0, OUT_TOTAL * sizeof(float), stream);
    for (int ph = 0; ph < DBG_LAST_PH; ++ph) { p.ph_lo = ph; p.ph_hi = ph + 1; hipLaunchKernelGGL(fwd_kernel, dim3(grid), dim3(NTHR), LDS_BYTES, stream, p); }
#ifdef DBG_COPY_OFF
    (void)hipMemcpyAsync(d_out, (char*)d_ws + (DBG_COPY_OFF), (size_t)(DBG_COPY_BYTES), hipMemcpyDeviceToDevice, stream);
#endif
#else
    p.ph_lo = 0; p.ph_hi = NPH; hipLaunchKernelGGL(fwd_kernel, dim3(grid), dim3(NTHR), LDS_BYTES, stream, p);
#endif
    const hipError_t le = hipPeekAtLastError();
    if (le != hipSuccess) fprintf(stderr, "kernel_launch: launch failed: %s\n", hipGetErrorName(le));
}
```

```cpp
#include <hip/hip_runtime.h>
#include <cstdio>
#include <cstdint>

constexpr int D = 1024, MP = 16384, MS = 1024, M = MP + MS, T = 2048, NBATCH = 8, NSEQ = 128, DSEQ = 8, PAST = 8192, PAGE = 128, NPAGES = 64;
constexpr int NH = 16, QKN = 64, QKR = 32, QKD = 96, VH = 64, QL = 512, KVL = 256, DFF = 3072, NLB = 8, LB = 128;
constexpr float EPS = 1e-6f;
constexpr float QSCALE = 0.10206207261596577f * 1.4426950408889634f;
constexpr int NSPLIT = 2;
constexpr int NROPE = T + DSEQ;

constexpr size_t OFF_YP = 0, OFF_YS = OFF_YP + (size_t)MP * D, OFF_CKVP = OFF_YS + (size_t)MS * D, OFF_KRP = OFF_CKVP + (size_t)MP * KVL,
                 OFF_CKVS = OFF_KRP + (size_t)MP * QKR, OFF_KRS = OFF_CKVS + (size_t)MS * KVL, OFF_LHP = OFF_KRS + (size_t)MS * QKR,
                 OFF_LHS = OFF_LHP + (size_t)NBATCH * D, OFF_LCP = OFF_LHS + (size_t)NSEQ * D, OFF_LCS = OFF_LCP + (size_t)NBATCH * 3 * D,
                 OFF_FCP = OFF_LCS + (size_t)NSEQ * 3 * D, OFF_FCS = OFF_FCP + (size_t)2 * NBATCH * 2 * DFF, OUT_TOTAL = OFF_FCS + (size_t)2 * NSEQ * 2 * DFF;
static_assert(OUT_TOTAL == 25067520, "output size");

enum { I_XP = 0, I_XS, I_CCKV, I_CKR, I_PT, I_SLH, I_SLC, I_SFC, I_NMIX, I_NFFN, I_WD, I_GQL, I_WUQ, I_GKV, I_GQN, I_GQR, I_GKN, I_GKR, I_WUK, I_WUV, I_WO,
       I_WIN, I_RCW, I_RCB, I_WA, I_BA, I_WI, I_BI, I_LAM, I_WOUT, I_WUP, I_FCW, I_FCB, I_WDN, N_IN };
static_assert(N_IN == 34, "34 inputs");

constexpr size_t al256(size_t x) { return (x + 255) & ~(size_t)255; }
constexpr size_t WS_CTL = 0, CTL_ZERO_BYTES = 1u << 20;
constexpr size_t WS_WD = CTL_ZERO_BYTES;
constexpr size_t WS_WUQ = WS_WD + (size_t)1024 * 1024 * 2;
constexpr size_t WS_WK = WS_WUQ + (size_t)1536 * 512 * 2;
constexpr size_t WS_WV = WS_WK + (size_t)1024 * 256 * 2;
constexpr size_t WS_WO = WS_WV + (size_t)1024 * 256 * 2;
constexpr size_t WS_WUP = WS_WO + (size_t)1024 * 1024 * 2;
constexpr size_t WS_WDN = WS_WUP + (size_t)2 * 6144 * 1024 * 2;
constexpr size_t WS_WIN = WS_WDN + (size_t)2 * 1024 * 3072 * 2;
constexpr size_t WS_WAI = WS_WIN + (size_t)2048 * 1024 * 2;
constexpr size_t WS_WOUT = WS_WAI + (size_t)8 * 256 * 128 * 2;
constexpr size_t WS_RCOS = WS_WOUT + (size_t)1024 * 1024 * 2;
constexpr size_t WS_RSIN = WS_RCOS + al256((size_t)NROPE * 16 * 4);
constexpr size_t WS_SP8 = WS_RSIN + al256((size_t)NROPE * 16 * 4);
constexpr size_t WS_XN = WS_SP8 + 4096;
constexpr size_t WS_CQ = WS_XN + (size_t)M * D * 2;
constexpr size_t WS_SSQ1 = WS_CQ + (size_t)M * QL * 2;
constexpr size_t WS_CKVRAW = WS_SSQ1 + (size_t)M * 16 * 4;
constexpr size_t WS_KRRAW = WS_CKVRAW + (size_t)M * KVL * 4;
constexpr size_t WS_CKVB = WS_KRRAW + (size_t)M * QKR * 4;
constexpr size_t WS_KRB = WS_CKVB + (size_t)M * KVL * 2;
constexpr size_t WS_Q = WS_KRB + (size_t)M * QKR * 2;
constexpr size_t WS_K96 = WS_Q + (size_t)M * NH * QKD * 2;
constexpr size_t WS_VT = WS_K96 + (size_t)MP * NH * QKD * 2;
constexpr size_t WS_RSN = WS_VT + (size_t)MP * NH * VH * 2;
constexpr size_t WS_QABS = WS_RSN + (size_t)MS * 16 * 4;
constexpr size_t WS_CB16 = WS_QABS + (size_t)NSEQ * 128 * KVL * 2;
constexpr size_t WS_KRB16 = WS_CB16 + (size_t)NSEQ * PAST * KVL * 2;
constexpr size_t WS_RS = WS_KRB16 + (size_t)NSEQ * PAST * QKR * 2;
constexpr size_t WS_CTXP = WS_RS + (size_t)NSEQ * PAST * 16 * 4;
constexpr size_t WS_MLM = WS_CTXP + (size_t)NSEQ * NSPLIT * 128 * KVL * 4;
constexpr size_t WS_MLL = WS_MLM + (size_t)NSEQ * NSPLIT * 128 * 4;
constexpr size_t WS_O = WS_MLL + (size_t)NSEQ * NSPLIT * 2 * 128 * 4;
constexpr size_t WS_X1 = WS_O + (size_t)M * D * 2;
constexpr size_t WS_X1B = WS_X1 + (size_t)M * D * 4;
constexpr size_t WS_SS1 = WS_X1B + (size_t)M * D * 2;
constexpr size_t WS_G = WS_SS1 + (size_t)M * 32 * 4;
constexpr size_t WS_U = WS_G + (size_t)M * DFF * 2;
constexpr size_t WS_HB = WS_U + (size_t)M * DFF * 2;
constexpr size_t WS_X2 = WS_HB + (size_t)M * DFF * 2;
constexpr size_t WS_X2B = WS_X2 + (size_t)M * D * 4;
constexpr size_t WS_SS2 = WS_X2B + (size_t)M * D * 2;
constexpr size_t WS_XR = WS_SS2 + (size_t)M * 32 * 4;
constexpr size_t WS_GATE = WS_XR + (size_t)M * D * 4;
constexpr size_t WS_XC = WS_GATE + (size_t)M * D * 2;
constexpr size_t WS_LA = WS_XC + (size_t)M * D * 2;
constexpr size_t WS_BX = WS_LA + (size_t)M * D * 4;
constexpr size_t WS_PA = WS_BX + (size_t)M * D * 4;
constexpr size_t WS_HL = WS_PA + (size_t)NBATCH * 16 * D * 4;
constexpr size_t WS_Y = WS_HL + (size_t)NBATCH * 16 * D * 4;
constexpr size_t WS_X3 = WS_Y + (size_t)M * D * 2;
constexpr size_t WS_X3B = WS_X3 + (size_t)M * D * 4;
constexpr size_t WS_SS3 = WS_X3B + (size_t)M * D * 2;
constexpr size_t WS_HEADG = WS_SS3 + (size_t)M * 32 * 4;
constexpr size_t WS_HEADU = WS_HEADG + (size_t)256 * 2 * DFF * 4;
constexpr size_t WS_TAILG = WS_HEADU + (size_t)256 * 2 * DFF * 4;
constexpr size_t WS_HEADX = WS_TAILG + (size_t)256 * 2 * DFF * 4;
constexpr size_t WS_TAILX = WS_HEADX + (size_t)256 * 3 * D * 4;
constexpr size_t WS_WK8 = WS_TAILX + (size_t)256 * 3 * D * 4;
constexpr size_t WS_CB8 = WS_WK8 + (size_t)1024 * 256;
constexpr size_t WS_RS8 = WS_CB8 + (size_t)NSEQ * PAST * KVL;
constexpr size_t WS_END = WS_RS8 + (size_t)NSEQ * PAST * 16 * 4;

namespace pg8 {
#define PG8_LAS __attribute__((address_space(3)))
typedef unsigned short bf16_t;
typedef short bf16x8 __attribute__((ext_vector_type(8)));
typedef float f32x4 __attribute__((ext_vector_type(4)));
typedef unsigned u32x4 __attribute__((ext_vector_type(4)));
typedef short bf16x16 __attribute__((ext_vector_type(16)));
typedef int v8i32 __attribute__((ext_vector_type(8)));
typedef int i32x4 __attribute__((ext_vector_type(4)));
constexpr int BM = 256, BK = 64, HALF = 128, HTB = HALF * BK * 2  , STAGE_BYTES = 8 * HTB, NXCD = 8, WGM = 8;

__host__ __device__ __forceinline__ int lds_byte(int r, int c) { const int st = (r >> 4) * 2 + (c >> 5), rr = r & 15, cc = c & 31, ob = rr * 64 + cc * 2; return st * 1024 + (ob ^ (((ob >> 9) & 1) << 5)); }
__host__ __device__ __forceinline__ void stage_rc(int b, int& R, int& C) { const int st = b / 1024, sb = b % 1024, swz = sb ^ (((sb >> 9) & 1) << 5); R = (st >> 1) * 16 + swz / 64; C = (st & 1) * 32 + (swz % 64) / 2; }
__host__ __device__ __forceinline__ int perm32(int rho) { const int n = rho >> 4, i = rho & 15; return 8 * (i >> 2) + 4 * n + (i & 3); }

struct Unit { int pm, pn; };
struct Gemm { const bf16_t* A; const bf16_t* Bt; int lda, ldb, K, a_pn_off; };

struct StaticOrder {
    int nM, nN, nwg, G, c;
    __host__ __device__ __forceinline__ void init(int M, int N, int G_, int c_) { nM = M / BM; nN = N / BM; nwg = nM * nN; G = G_; c = c_; }
    __host__ __device__ __forceinline__ bool next(int i, Unit& u) const {
        const long L = (long)i * G + c; if (L >= nwg) return false;
        int wgid = (int)L; { const int q = nwg / NXCD, r = nwg % NXCD, xcd = wgid % NXCD, off = wgid / NXCD; wgid = (xcd < r ? xcd * (q + 1) : r * (q + 1) + (xcd - r) * q) + off; }
        const int nig = WGM * nN, gid = wgid / nig, fm = gid * WGM, gsz = (nM - fm) < WGM ? (nM - fm) : WGM;
        u.pm = fm + ((wgid % nig) % gsz); u.pn = (wgid % nig) / gsz; return true;
    }
    __device__ __forceinline__ void a_ready(const Unit&) const {}
    __device__ __forceinline__ void done(const Unit&) const {}
};

struct LocalOrder {
    int pm0, nN, n;
    __host__ __device__ __forceinline__ bool next(int i, Unit& u) const { if (i >= n) return false; u.pm = pm0 + i / nN; u.pn = i % nN; return true; }
    __device__ __forceinline__ void a_ready(const Unit&) const {}
    __device__ __forceinline__ void done(const Unit&) const {}
};

typedef float f32x2_t __attribute__((ext_vector_type(2))); typedef __bf16 bf16x2_t __attribute__((ext_vector_type(2)));
__device__ __forceinline__ unsigned cvt_pk_bf16(float lo, float hi) { f32x2_t v = {lo, hi}; bf16x2_t b = __builtin_convertvector(v, bf16x2_t); return __builtin_bit_cast(unsigned, b); }
typedef float f32x2 __attribute__((ext_vector_type(2)));
typedef unsigned u32x2 __attribute__((ext_vector_type(2)));
__device__ __forceinline__ u32x4 pack8(const f32x4& a, const f32x4& b) { u32x4 w; w.x = cvt_pk_bf16(a[0], a[1]); w.y = cvt_pk_bf16(a[2], a[3]); w.z = cvt_pk_bf16(b[0], b[1]); w.w = cvt_pk_bf16(b[2], b[3]); return w; }
__device__ __forceinline__ float dot4(const f32x4& a) { return (a[0] * a[0] + a[1] * a[1]) + (a[2] * a[2] + a[3] * a[3]); }
__device__ __forceinline__ float quad_sum(float s) {
    const auto r1 = __builtin_amdgcn_permlane16_swap(__float_as_uint(s), __float_as_uint(s), false, false); s = __uint_as_float(r1[0]) + __uint_as_float(r1[1]);
    const auto r2 = __builtin_amdgcn_permlane32_swap(__float_as_uint(s), __float_as_uint(s), false, false); return __uint_as_float(r2[0]) + __uint_as_float(r2[1]);
}
__device__ __forceinline__ float sum_parts(const float* p, int n) { float s = 0.f; for (int i = 0; i < n; i += 4) { const f32x4 v = *(const f32x4*)(p + i); s += (v[0] + v[1]) + (v[2] + v[3]); } return s; }
__device__ __forceinline__ int rope_row(int row) { return row < MP ? (row & (T - 1)) : T + (row & (DSEQ - 1)); }

struct EpiDown {
    static constexpr bool PERM = true, AFTER_DRAIN = false;
    bf16_t* CQ; float* CKVRAW; float* KRRAW; float* SSQ;
    __device__ __forceinline__ void operator()(const f32x4 (&acc)[2][2][4][2], const Unit& u, int wr, int wc, int fr, int fq) const {
        const int row0 = u.pm * BM + wr * 64 + fr;
        if (u.pn < 2) {
#pragma unroll
            for (int ai = 0; ai < 2; ++ai)
#pragma unroll
                for (int m = 0; m < 4; ++m) { const int row = row0 + ai * HALF + m * 16; float ss = 0.f;
#pragma unroll
                    for (int bj = 0; bj < 2; ++bj) { ss += dot4(acc[ai][bj][m][0]) + dot4(acc[ai][bj][m][1]);
                        *(u32x4*)(CQ + (size_t)row * QL + u.pn * BM + bj * HALF + wc * 32 + 8 * fq) = pack8(acc[ai][bj][m][0], acc[ai][bj][m][1]); }
                    ss = quad_sum(ss);
                    if (fq == 0) SSQ[(size_t)row * 16 + u.pn * 4 + wc] = ss; asm volatile("" ::: "memory"); }
        } else if (u.pn == 2) {
#pragma unroll
            for (int ai = 0; ai < 2; ++ai)
#pragma unroll
                for (int m = 0; m < 4; ++m) { const int row = row0 + ai * HALF + m * 16;
#pragma unroll
                    for (int bj = 0; bj < 2; ++bj) { float* o = CKVRAW + (size_t)row * KVL + bj * HALF + wc * 32 + 8 * fq; *(f32x4*)o = acc[ai][bj][m][0]; *(f32x4*)(o + 4) = acc[ai][bj][m][1]; } }
        } else if (wc == 0) {
#pragma unroll
            for (int ai = 0; ai < 2; ++ai)
#pragma unroll
                for (int m = 0; m < 4; ++m) { const int row = row0 + ai * HALF + m * 16; float* o = KRRAW + (size_t)row * QKR + 8 * fq; *(f32x4*)o = acc[ai][0][m][0]; *(f32x4*)(o + 4) = acc[ai][0][m][1]; }
        }
    }
    __device__ __forceinline__ void strip(const f32x4 (&acc)[2], int row, int pn, int wr, int wc, int fq) const {
        const int c0 = 32 * wc + 8 * fq + 4 * wr;
        if (pn < 2) { float ss = dot4(acc[0]) + dot4(acc[1]);
#pragma unroll
            for (int bj = 0; bj < 2; ++bj) { u32x2 w; w.x = cvt_pk_bf16(acc[bj][0], acc[bj][1]); w.y = cvt_pk_bf16(acc[bj][2], acc[bj][3]); *(u32x2*)(CQ + (size_t)row * QL + pn * BM + bj * HALF + c0) = w; }
            ss = quad_sum(ss); if (fq == 0) SSQ[(size_t)row * 16 + (pn * 4 + wc) * 2 + wr] = ss;
        } else if (pn == 2) { *(f32x4*)(CKVRAW + (size_t)row * KVL + c0) = acc[0]; *(f32x4*)(CKVRAW + (size_t)row * KVL + HALF + c0) = acc[1]; }
        else if (wc == 0) *(f32x4*)(KRRAW + (size_t)row * QKR + c0) = acc[0];
    }
};

struct EpiQ {
    static constexpr bool PERM = true, AFTER_DRAIN = false;
    bf16_t* Q; const float* SSQ; const float* g_qn; const float* g_qr; const float* rcos; const float* rsin;
    __device__ __forceinline__ void operator()(const f32x4 (&acc)[2][2][4][2], const Unit& u, int wr, int wc, int fr, int fq) const {
        const int row0 = u.pm * BM + wr * 64 + fr;
        if (u.pn < 4) {
            const int h = u.pn * 4 + wc;
            f32x4 gq[2][2];
#pragma unroll
            for (int bj = 0; bj < 2; ++bj)
#pragma unroll
                for (int n = 0; n < 2; ++n) gq[bj][n] = *(const f32x4*)(g_qn + 32 * bj + 8 * fq + 4 * n);
#pragma unroll
            for (int ai = 0; ai < 2; ++ai)
#pragma unroll
                for (int m = 0; m < 4; ++m) { const int row = row0 + ai * HALF + m * 16;
                    const float rq = __builtin_amdgcn_rsqf(sum_parts(SSQ + (size_t)row * 16, row < MP ? 8 : 16) * (1.0f / QL) + EPS);
                    f32x4 v[2][2]; float ss = 0.f;
#pragma unroll
                    for (int bj = 0; bj < 2; ++bj)
#pragma unroll
                        for (int n = 0; n < 2; ++n) { v[bj][n] = acc[ai][bj][m][n] * rq; ss += dot4(v[bj][n]); }
                    ss = quad_sum(ss);
                    const float r = __builtin_amdgcn_rsqf(ss * (1.0f / QKN) + EPS) * QSCALE;
#pragma unroll
                    for (int bj = 0; bj < 2; ++bj)
                        *(u32x4*)(Q + (size_t)row * (NH * QKD) + h * QKD + 32 * bj + 8 * fq) = pack8(v[bj][0] * gq[bj][0] * r, v[bj][1] * gq[bj][1] * r); }
        } else {
            const f32x4 g1 = *(const f32x4*)(g_qr + 4 * fq), g2 = *(const f32x4*)(g_qr + 16 + 4 * fq);
#pragma unroll
            for (int ai = 0; ai < 2; ++ai)
#pragma unroll
                for (int m = 0; m < 4; ++m) { const int row = row0 + ai * HALF + m * 16;
                    const float rq = __builtin_amdgcn_rsqf(sum_parts(SSQ + (size_t)row * 16, row < MP ? 8 : 16) * (1.0f / QL) + EPS);
                    const int rr = rope_row(row);
                    const f32x4 cs = *(const f32x4*)(rcos + rr * 16 + 4 * fq), sn = *(const f32x4*)(rsin + rr * 16 + 4 * fq);
#pragma unroll
                    for (int bj = 0; bj < 2; ++bj) { const int h = (u.pn - 4) * 8 + bj * 4 + wc;
                        const f32x4 x1 = acc[ai][bj][m][0] * rq, x2 = acc[ai][bj][m][1] * rq;
                        const float ss = quad_sum(dot4(x1) + dot4(x2));
                        const float r = __builtin_amdgcn_rsqf(ss * (1.0f / QKR) + EPS);
                        const f32x4 a1 = x1 * g1 * r, a2 = x2 * g2 * r;
                        const f32x4 o1 = (a1 * cs - a2 * sn) * QSCALE, o2 = (a1 * sn + a2 * cs) * QSCALE;
                        bf16_t* qp = Q + (size_t)row * (NH * QKD) + h * QKD + QKN + 4 * fq;
                        u32x2 w1, w2; w1.x = cvt_pk_bf16(o1[0], o1[1]); w1.y = cvt_pk_bf16(o1[2], o1[3]); w2.x = cvt_pk_bf16(o2[0], o2[1]); w2.y = cvt_pk_bf16(o2[2], o2[3]);
                        *(u32x2*)qp = w1; *(u32x2*)(qp + 16) = w2; } }
        }
    }
};

struct EpiK {
    static constexpr bool PERM = true, AFTER_DRAIN = false;
    bf16_t* K96; const bf16_t* KRB; const float* g_kn; float* RSN;
    __device__ __forceinline__ void operator()(const f32x4 (&acc)[2][2][4][2], const Unit& u, int wr, int wc, int fr, int fq) const {
        const int row0 = u.pm * BM + wr * 64 + fr, h = u.pn * 4 + wc;
        if (u.pm < MP / BM) {
            const unsigned kbase = (unsigned)(((row0 >> 11) * NH + h) * T + (row0 & (T - 1))) * QKD + 8 * fq;
#pragma unroll
            for (int ai = 0; ai < 2; ++ai)
#pragma unroll
                for (int m = 0; m < 4; ++m) { float ss = 0.f;
#pragma unroll
                    for (int bj = 0; bj < 2; ++bj) ss += dot4(acc[ai][bj][m][0]) + dot4(acc[ai][bj][m][1]);
                    ss = quad_sum(ss);
                    const float r = __builtin_amdgcn_rsqf(ss * (1.0f / QKN) + EPS);
                    bf16_t* kp = K96 + kbase + (unsigned)((ai * HALF + m * 16) * QKD);
#pragma unroll
                    for (int bj = 0; bj < 2; ++bj) { const f32x4 g0 = *(const f32x4*)(g_kn + 32 * bj + 8 * fq) * r, g1 = *(const f32x4*)(g_kn + 32 * bj + 8 * fq + 4) * r;
                        *(u32x4*)(kp + 32 * bj) = pack8(acc[ai][bj][m][0] * g0, acc[ai][bj][m][1] * g1); }
                    *(u32x4*)(kp + QKN) = *(const u32x4*)(KRB + (size_t)(row0 + ai * HALF + m * 16) * QKR + 8 * fq);
                    asm volatile("" ::: "memory"); }
        } else {
#pragma unroll
            for (int ai = 0; ai < 2; ++ai)
#pragma unroll
                for (int m = 0; m < 4; ++m) { float ss = 0.f;
#pragma unroll
                    for (int bj = 0; bj < 2; ++bj) ss += dot4(acc[ai][bj][m][0]) + dot4(acc[ai][bj][m][1]);
                    ss = quad_sum(ss);
                    if (fq == 0) RSN[(size_t)(row0 + ai * HALF + m * 16 - MP) * 16 + h] = __builtin_amdgcn_rsqf(ss * (1.0f / QKN) + EPS); }
        }
    }
};

struct EpiVT {
    static constexpr bool PERM = true, AFTER_DRAIN = false;
    bf16_t* VT;
    __device__ __forceinline__ void operator()(const f32x4 (&acc)[2][2][4][2], const Unit& u, int wr, int wc, int fr, int fq) const {
        const int row0 = u.pm * BM + wr * 64 + fr;
#pragma unroll
        for (int ai = 0; ai < 2; ++ai)
#pragma unroll
            for (int m = 0; m < 4; ++m) { const int hd = row0 + ai * HALF + m * 16;
#pragma unroll
                for (int bj = 0; bj < 2; ++bj) { const int tok = u.pn * BM + bj * HALF + wc * 32 + 8 * fq;
                    *(u32x4*)(VT + ((size_t)(tok >> 11) * (NH * VH) + hd) * T + (tok & (T - 1))) = pack8(acc[ai][bj][m][0], acc[ai][bj][m][1]); } }
    }
};

struct EpiRS {
    static constexpr bool PERM = true, AFTER_DRAIN = false;
    float* RS; float inv;
    __device__ __forceinline__ void operator()(const f32x4 (&acc)[2][2][4][2], const Unit& u, int wr, int wc, int fr, int fq) const {
        const int row0 = u.pm * BM + wr * 64 + fr, h = u.pn * 4 + wc;
#pragma unroll
        for (int ai = 0; ai < 2; ++ai)
#pragma unroll
            for (int m = 0; m < 4; ++m) {
                f32x2 s2 = (f32x2){0.f, 0.f};
#pragma unroll
                for (int bj = 0; bj < 2; ++bj)
#pragma unroll
                    for (int n = 0; n < 2; ++n) { const f32x4 v = acc[ai][bj][m][n]; const f32x2 lo = (f32x2){v[0], v[1]}, hi = (f32x2){v[2], v[3]};
                        s2 = __builtin_elementwise_fma(lo, lo, s2); s2 = __builtin_elementwise_fma(hi, hi, s2); }
                const float ss = quad_sum(s2[0] + s2[1]);
                if (fq == 0) RS[(size_t)(row0 + ai * HALF + m * 16) * 16 + h] = __builtin_amdgcn_rsqf(ss * inv + EPS); }
    }
};

template <bool BASE_BF16, bool OUT_F32> struct EpiRes {
    static constexpr bool PERM = true, AFTER_DRAIN = false;
    const void* baseP; const void* baseS; float* outP; float* outS; bf16_t* outB; float* ssq;
    __device__ __forceinline__ void operator()(const f32x4 (&acc)[2][2][4][2], const Unit& u, int wr, int wc, int fr, int fq) const {
        const int row0 = u.pm * BM + wr * 64 + fr; const size_t col = (size_t)u.pn * BM + wc * 32 + 8 * fq;
        constexpr int MB = BASE_BF16 ? 4 : 2;
#pragma unroll
        for (int ai = 0; ai < 2; ++ai)
#pragma unroll
            for (int m0 = 0; m0 < 4; m0 += MB) {
                u32x4 braw[MB][2]; f32x4 bf[BASE_BF16 ? 1 : MB][2][2];
#pragma unroll
                for (int mm = 0; mm < MB; ++mm)
#pragma unroll
                    for (int bj = 0; bj < 2; ++bj) { const size_t off = (size_t)(row0 + ai * HALF + (m0 + mm) * 16) * D + col + bj * HALF;
                        if constexpr (BASE_BF16) braw[mm][bj] = *(const u32x4*)((const bf16_t*)baseP + off);
                        else { bf[mm][bj][0] = *(const f32x4*)((const float*)baseP + off); bf[mm][bj][1] = *(const f32x4*)((const float*)baseP + off + 4); } }
#pragma unroll
                for (int mm = 0; mm < MB; ++mm) { const int m = m0 + mm, row = row0 + ai * HALF + m * 16; float ss = 0.f;
#pragma unroll
                    for (int bj = 0; bj < 2; ++bj) { const size_t off = (size_t)row * D + col + bj * HALF;
                        f32x4 b0, b1;
                        if constexpr (BASE_BF16) { const u32x4 w = braw[mm][bj];
                            b0 = (f32x4){__uint_as_float(w.x << 16), __uint_as_float(w.x & 0xffff0000u), __uint_as_float(w.y << 16), __uint_as_float(w.y & 0xffff0000u)};
                            b1 = (f32x4){__uint_as_float(w.z << 16), __uint_as_float(w.z & 0xffff0000u), __uint_as_float(w.w << 16), __uint_as_float(w.w & 0xffff0000u)}; }
                        else { b0 = bf[mm][bj][0]; b1 = bf[mm][bj][1]; }
                        const f32x4 v0 = b0 + acc[ai][bj][m][0], v1 = b1 + acc[ai][bj][m][1];
                        if constexpr (OUT_F32) { *(f32x4*)(outP + off) = v0; *(f32x4*)(outP + off + 4) = v1; }
                        else { *(u32x4*)(outB + off) = pack8(v0, v1); ss += dot4(v0) + dot4(v1); } }
                    if constexpr (!OUT_F32) { ss = quad_sum(ss); if (fq == 0) ssq[(size_t)row * 32 + u.pn * 4 + wc] = ss; } }
                asm volatile("" ::: "memory"); }
    }
    __device__ __forceinline__ void strip(const f32x4 (&acc)[2], int row, int pn, int wr, int wc, int fq) const {
        float ss = 0.f;
#pragma unroll
        for (int bj = 0; bj < 2; ++bj) { const size_t col = (size_t)pn * BM + bj * HALF + wc * 32 + 8 * fq + 4 * wr, off = (size_t)row * D + col, offs = (size_t)(row - MP) * D + col;
            f32x4 b;
            if constexpr (BASE_BF16) { const u32x2 w = *(const u32x2*)((const bf16_t*)baseS + offs); b = (f32x4){__uint_as_float(w.x << 16), __uint_as_float(w.x & 0xffff0000u), __uint_as_float(w.y << 16), __uint_as_float(w.y & 0xffff0000u)}; }
            else b = *(const f32x4*)((const float*)baseS + offs);
            const f32x4 v = b + acc[bj];
            if constexpr (OUT_F32) *(f32x4*)(outS + offs) = v;
            else { u32x2 w; w.x = cvt_pk_bf16(v[0], v[1]); w.y = cvt_pk_bf16(v[2], v[3]); *(u32x2*)(outB + off) = w; ss += dot4(v); } }
        if constexpr (!OUT_F32) { ss = quad_sum(ss); if (fq == 0) ssq[(size_t)row * 32 + (pn * 4 + wc) * 2 + wr] = ss; }
    }
};

__device__ __forceinline__ float dpp_ror1(float v) { return __int_as_float(__builtin_amdgcn_update_dpp(0, __float_as_int(v), 0x121, 0xf, 0xf, false)); }
__device__ __forceinline__ float dpp_ror2(float v) { return __int_as_float(__builtin_amdgcn_update_dpp(0, __float_as_int(v), 0x122, 0xf, 0xf, false)); }
__device__ __forceinline__ float dpp_shr1(float old, float v) { return __int_as_float(__builtin_amdgcn_update_dpp(__float_as_int(old), __float_as_int(v), 0x111, 0xf, 0xf, false)); }
__device__ __forceinline__ float dpp_shr2(float old, float v) { return __int_as_float(__builtin_amdgcn_update_dpp(__float_as_int(old), __float_as_int(v), 0x112, 0xf, 0xf, false)); }
__device__ __forceinline__ float dpp_ror3(float v) { return __int_as_float(__builtin_amdgcn_update_dpp(0, __float_as_int(v), 0x123, 0xf, 0xf, false)); }
__device__ __forceinline__ float dpp_shr3(float old, float v) { return __int_as_float(__builtin_amdgcn_update_dpp(__float_as_int(old), __float_as_int(v), 0x113, 0xf, 0xf, false)); }
__device__ __forceinline__ float silu_f(float c) { return c * __builtin_amdgcn_rcpf(1.0f + __builtin_amdgcn_exp2f(-1.4426950408889634f * c)); }
struct EpiUp {
    static constexpr bool PERM = true, AFTER_DRAIN = false;
    const float* ssq; bf16_t* HB; float* HEADG; float* HEADU; float* TAILG; const float* cw; const float* cb; const float* st; float* convP; float* convS;
    __device__ __forceinline__ void operator()(const f32x4 (&acc)[2][2][4][2], const Unit& u, int wr, int wc, int fr, int fq) const {
        const int row0 = u.pm * BM + wr * 64 + fr, ch = u.pn * HALF + wc * 32 + 8 * fq;
        f32x4 w0[2], w1[2], w2[2], bb[2];
#pragma unroll
        for (int n = 0; n < 2; ++n) { w0[n] = *(const f32x4*)(cw + ch + 4 * n); w1[n] = *(const f32x4*)(cw + DFF + ch + 4 * n); w2[n] = *(const f32x4*)(cw + 2 * DFF + ch + 4 * n); bb[n] = *(const f32x4*)(cb + ch + 4 * n); }
        float rsv[8];
#pragma unroll
        for (int r = 0; r < 8; ++r) { const f32x4 pv = *(const f32x4*)(ssq + (size_t)(row0 + (r >> 2) * HALF + (r & 3) * 16) * 32 + 4 * fq);
            rsv[r] = __builtin_amdgcn_rsqf(quad_sum((pv[0] + pv[1]) + (pv[2] + pv[3])) * (1.0f / D) + EPS); }
#pragma unroll
        for (int ai = 0; ai < 2; ++ai) {
            f32x4 gp[2]; gp[0] = (f32x4){0.f, 0.f, 0.f, 0.f}; gp[1] = gp[0];
            const int blk = u.pm * 4 + ai * 2 + wr;
#pragma unroll
            for (int m = 0; m < 4; ++m) { const int row = row0 + ai * HALF + m * 16;
                const float rs = rsv[ai * 4 + m];
                f32x4 g[2], hv[2];
#pragma unroll
                for (int n = 0; n < 2; ++n) { g[n] = acc[ai][0][m][n] * rs; const f32x4 uu = acc[ai][1][m][n] * rs;
#pragma unroll
                    for (int j = 0; j < 4; ++j) { const float gm1 = dpp_shr1(dpp_ror1(gp[n][j]), g[n][j]), gm2 = dpp_shr2(dpp_ror2(gp[n][j]), g[n][j]);
                        hv[n][j] = silu_f(gm2 * w0[n][j] + gm1 * w1[n][j] + g[n][j] * w2[n][j] + bb[n][j]) * uu[j]; }
                    if (m == 0 && fr < 2) *(f32x4*)(HEADU + ((size_t)blk * 2 + fr) * DFF + ch + 4 * n) = uu; }
                *(u32x4*)(HB + (size_t)row * DFF + ch) = pack8(hv[0], hv[1]);
                if (m == 0 && fr < 2) { float* hp = HEADG + ((size_t)blk * 2 + fr) * DFF + ch; *(f32x4*)hp = g[0]; *(f32x4*)(hp + 4) = g[1]; }
                if (m == 3 && fr >= 14) { float* tp = TAILG + ((size_t)blk * 2 + (fr - 14)) * DFF + ch; *(f32x4*)tp = g[0]; *(f32x4*)(tp + 4) = g[1]; }
                const int t = row & (T - 1);
                if (t >= T - 2) { float* cp = convP + ((size_t)(row >> 11) * 2 + (t - (T - 2))) * DFF + ch; *(f32x4*)cp = g[0]; *(f32x4*)(cp + 4) = g[1]; }
                gp[0] = g[0]; gp[1] = g[1];
                asm volatile("" ::: "memory"); }
        }
    }
    __device__ __forceinline__ void strip(const f32x4 (&acc)[2], int row, int pn, int wr, int wc, int fq) const {
        const int ch = pn * HALF + wc * 32 + 8 * fq + 4 * wr, s = row & (DSEQ - 1), bs = (row - MP) >> 3;
        const float rs = __builtin_amdgcn_rsqf(sum_parts(ssq + (size_t)row * 32, 32) * (1.0f / D) + EPS);
        const f32x4 g = acc[0] * rs, uu = acc[1] * rs;
        const f32x4 s0 = *(const f32x4*)(st + ((size_t)bs * 2 + 0) * DFF + ch), s1 = *(const f32x4*)(st + ((size_t)bs * 2 + 1) * DFF + ch);
        const f32x4 w0 = *(const f32x4*)(cw + ch), w1 = *(const f32x4*)(cw + DFF + ch), w2 = *(const f32x4*)(cw + 2 * DFF + ch), bb = *(const f32x4*)(cb + ch);
        f32x4 hv;
#pragma unroll
        for (int j = 0; j < 4; ++j) { const float a1 = dpp_shr1(0.f, g[j]), a2 = dpp_shr2(0.f, g[j]);
            const float gm1 = (s == 0) ? s1[j] : a1, gm2 = (s == 0) ? s0[j] : ((s == 1) ? s1[j] : a2);
            hv[j] = silu_f(gm2 * w0[j] + gm1 * w1[j] + g[j] * w2[j] + bb[j]) * uu[j]; }
        u32x2 w; w.x = cvt_pk_bf16(hv[0], hv[1]); w.y = cvt_pk_bf16(hv[2], hv[3]); *(u32x2*)(HB + (size_t)row * DFF + ch) = w;
        if (s >= DSEQ - 2) *(f32x4*)(convS + ((size_t)bs * 2 + (s - (DSEQ - 2))) * DFF + ch) = g;
    }
};

__device__ __forceinline__ float gelu_tanh(float x) { const float t = 1.5957691216057308f * (x + 0.044715f * x * x * x); return x * __builtin_amdgcn_rcpf(1.0f + __builtin_amdgcn_exp2f(-1.4426950408889634f * t)); }
struct EpiIn {
    static constexpr bool PERM = true, AFTER_DRAIN = false;
    const float* ssq; bf16_t* XC; bf16_t* GATE; float* HEADX; float* TAILX; const float* cw; const float* cb; const float* st; float* convP; float* convS;
    __device__ __forceinline__ void operator()(const f32x4 (&acc)[2][2][4][2], const Unit& u, int wr, int wc, int fr, int fq) const {
        const int row0 = u.pm * BM + wr * 64 + fr, ch = u.pn * HALF + wc * 32 + 8 * fq;
        float rsv[8];
#pragma unroll
        for (int r = 0; r < 8; ++r) { const f32x4 pv = *(const f32x4*)(ssq + (size_t)(row0 + (r >> 2) * HALF + (r & 3) * 16) * 32 + 4 * fq);
            rsv[r] = __builtin_amdgcn_rsqf(quad_sum((pv[0] + pv[1]) + (pv[2] + pv[3])) * (1.0f / D) + EPS); }
#pragma unroll
        for (int n = 0; n < 2; ++n) {
            const f32x4 w0 = *(const f32x4*)(cw + ch + 4 * n), w1 = *(const f32x4*)(cw + D + ch + 4 * n), w2 = *(const f32x4*)(cw + 2 * D + ch + 4 * n), w3 = *(const f32x4*)(cw + 3 * D + ch + 4 * n), bb = *(const f32x4*)(cb + ch + 4 * n);
#pragma unroll
            for (int ai = 0; ai < 2; ++ai) {
                f32x4 xp = (f32x4){0.f, 0.f, 0.f, 0.f};
                const int blk = u.pm * 4 + ai * 2 + wr;
#pragma unroll
                for (int m = 0; m < 4; ++m) { const int row = row0 + ai * HALF + m * 16;
                    const float rs = rsv[ai * 4 + m];
                    const f32x4 x = acc[ai][0][m][n] * rs; f32x4 y;
#pragma unroll
                    for (int j = 0; j < 4; ++j) { const float x1 = dpp_shr1(dpp_ror1(xp[j]), x[j]), x2 = dpp_shr2(dpp_ror2(xp[j]), x[j]), x3 = dpp_shr3(dpp_ror3(xp[j]), x[j]);
                        y[j] = x3 * w0[j] + x2 * w1[j] + x1 * w2[j] + x[j] * w3[j] + bb[j]; }
                    u32x2 w; w.x = cvt_pk_bf16(y[0], y[1]); w.y = cvt_pk_bf16(y[2], y[3]); *(u32x2*)(XC + (size_t)row * D + ch + 4 * n) = w;
                    f32x4 t0 = acc[ai][1][m][n] * rs;
#pragma unroll
                    for (int j = 0; j < 4; ++j) t0[j] = gelu_tanh(t0[j]);
                    w.x = cvt_pk_bf16(t0[0], t0[1]); w.y = cvt_pk_bf16(t0[2], t0[3]); *(u32x2*)(GATE + (size_t)row * D + ch + 4 * n) = w;
                    if (m == 0 && fr < 3) *(f32x4*)(HEADX + ((size_t)blk * 3 + fr) * D + ch + 4 * n) = x;
                    if (m == 3 && fr >= 13) *(f32x4*)(TAILX + ((size_t)blk * 3 + (fr - 13)) * D + ch + 4 * n) = x;
                    const int t = row & (T - 1);
                    if (t >= T - 3) *(f32x4*)(convP + ((size_t)(row >> 11) * 3 + (t - (T - 3))) * D + ch + 4 * n) = x;
                    xp = x;
                    asm volatile("" ::: "memory"); }
            }
        }
    }
    __device__ __forceinline__ void strip(const f32x4 (&acc)[2], int row, int pn, int wr, int wc, int fq) const {
        const int ch = pn * HALF + wc * 32 + 8 * fq + 4 * wr, s = row & (DSEQ - 1), bs = (row - MP) >> 3;
        const float rs = __builtin_amdgcn_rsqf(sum_parts(ssq + (size_t)row * 32, 32) * (1.0f / D) + EPS);
        const f32x4 x = acc[0] * rs; f32x4 t0 = acc[1] * rs;
        const f32x4 s0 = *(const f32x4*)(st + ((size_t)bs * 3 + 0) * D + ch), s1 = *(const f32x4*)(st + ((size_t)bs * 3 + 1) * D + ch), s2 = *(const f32x4*)(st + ((size_t)bs * 3 + 2) * D + ch);
        const f32x4 w0 = *(const f32x4*)(cw + ch), w1 = *(const f32x4*)(cw + D + ch), w2 = *(const f32x4*)(cw + 2 * D + ch), w3 = *(const f32x4*)(cw + 3 * D + ch), bb = *(const f32x4*)(cb + ch);
        f32x4 y;
#pragma unroll
        for (int j = 0; j < 4; ++j) { const float a1 = dpp_shr1(0.f, x[j]), a2 = dpp_shr2(0.f, x[j]), a3 = dpp_shr3(0.f, x[j]);
            const float x1 = (s == 0) ? s2[j] : a1, x2 = (s == 0) ? s1[j] : ((s == 1) ? s2[j] : a2), x3 = (s == 0) ? s0[j] : ((s == 1) ? s1[j] : ((s == 2) ? s2[j] : a3));
            y[j] = x3 * w0[j] + x2 * w1[j] + x1 * w2[j] + x[j] * w3[j] + bb[j]; }
        u32x2 w; w.x = cvt_pk_bf16(y[0], y[1]); w.y = cvt_pk_bf16(y[2], y[3]); *(u32x2*)(XC + (size_t)row * D + ch) = w;
#pragma unroll
        for (int j = 0; j < 4; ++j) t0[j] = gelu_tanh(t0[j]);
        w.x = cvt_pk_bf16(t0[0], t0[1]); w.y = cvt_pk_bf16(t0[2], t0[3]); *(u32x2*)(GATE + (size_t)row * D + ch) = w;
        if (s >= DSEQ - 3) *(f32x4*)(convS + ((size_t)bs * 3 + (s - (DSEQ - 3))) * D + ch) = x;
    }
};

struct EpiLru {
    static constexpr bool PERM = true, AFTER_DRAIN = false;
    const bf16_t* XC; const float* b_a; const float* b_i; const float* sp8; float* LA; float* BX;
    __device__ __forceinline__ void operator()(const f32x4 (&acc)[2][2][4][2], const Unit& u, int wr, int wc, int fr, int fq) const {
        const int row0 = u.pm * BM + wr * 64 + fr, ch = u.pn * HALF + wc * 32 + 8 * fq;
#pragma unroll
        for (int ai = 0; ai < 2; ++ai)
#pragma unroll
            for (int m = 0; m < 4; ++m) { const int row = row0 + ai * HALF + m * 16;
                const u32x4 xw = *(const u32x4*)(XC + (size_t)row * D + ch);
                float* lp = LA + (size_t)row * D + ch; float* bp = BX + (size_t)row * D + ch;
#pragma unroll
                for (int n = 0; n < 2; ++n) {
                    const f32x4 ba = *(const f32x4*)(b_a + ch + 4 * n), bi = *(const f32x4*)(b_i + ch + 4 * n), sp = *(const f32x4*)(sp8 + ch + 4 * n);
                    f32x4 av, bv;
#pragma unroll
                    for (int j = 0; j < 4; ++j) { const float ra = acc[ai][0][m][n][j] + ba[j], ia = acc[ai][1][m][n][j] + bi[j];
                        const float r = __builtin_amdgcn_rcpf(1.0f + __expf(-ra)), gi = __builtin_amdgcn_rcpf(1.0f + __expf(-ia));
                        const float la = r * sp[j], a = __expf(la), x2 = 2.0f * la;
                        const float om = (x2 > -0.05f) ? -x2 * (1.0f + x2 * (0.5f + x2 * (0.16666667f + x2 * 0.041666668f))) : 1.0f - a * a;
                        const unsigned wv = xw[2 * n + (j >> 1)]; const float xc = __uint_as_float((j & 1) ? (wv & 0xffff0000u) : (wv << 16));
                        av[j] = a; bv[j] = __builtin_sqrtf(om) * gi * xc; }
                    *(f32x4*)(lp + 4 * n) = av; *(f32x4*)(bp + 4 * n) = bv; }
                asm volatile("" ::: "memory"); }
    }
    __device__ __forceinline__ void strip(const f32x4 (&acc)[2], int row, int pn, int wr, int wc, int fq) const {
        const int ch = pn * HALF + wc * 32 + 8 * fq + 4 * wr;
        const u32x2 xw = *(const u32x2*)(XC + (size_t)row * D + ch);
        const f32x4 ba = *(const f32x4*)(b_a + ch), bi = *(const f32x4*)(b_i + ch), sp = *(const f32x4*)(sp8 + ch);
        f32x4 av, bv;
#pragma unroll
        for (int j = 0; j < 4; ++j) { const float ra = acc[0][j] + ba[j], ia = acc[1][j] + bi[j];
            const float r = __builtin_amdgcn_rcpf(1.0f + __expf(-ra)), gi = __builtin_amdgcn_rcpf(1.0f + __expf(-ia));
            const float la = r * sp[j], a = __expf(la), x2 = 2.0f * la;
            const float om = (x2 > -0.05f) ? -x2 * (1.0f + x2 * (0.5f + x2 * (0.16666667f + x2 * 0.041666668f))) : 1.0f - a * a;
            const unsigned wv = xw[j >> 1]; const float xc = __uint_as_float((j & 1) ? (wv & 0xffff0000u) : (wv << 16));
            av[j] = a; bv[j] = __builtin_sqrtf(om) * gi * xc; }
        *(f32x4*)(LA + (size_t)row * D + ch) = av; *(f32x4*)(BX + (size_t)row * D + ch) = bv;
    }
};

__device__ __forceinline__ void glds16s(const void* sbase, unsigned voff, unsigned lds_dst) {
    unsigned keep;
    asm volatile("s_mov_b32 %0, m0\n\ts_mov_b32 m0, %3\n\ts_nop 0\n\tglobal_load_lds_dwordx4 %1, %2\n\ts_mov_b32 m0, %0" : "=&s"(keep) : "v"(voff), "s"(sbase), "s"(lds_dst) : "memory");
}
template <class Epi, class Sched, bool ALIGN_EPI = false, bool SP2 = false, bool STRIP = false, bool F8 = false, bool OPQK = false>
__device__ __forceinline__ void gemm_phase(PG8_LAS unsigned char* lds, const Gemm g, const Sched& S, const Epi& E, PG8_LAS unsigned char* xlds = nullptr, int strip_row0 = 0) {
    static_assert(!STRIP || SP2, "STRIP needs the SP2 loop"); static_assert(!F8 || (SP2 && !STRIP), "F8 is the SP2 loop without strips");
    int tid_ = threadIdx.x; asm volatile("" : "+v"(tid_));
    const int tid = tid_, wid = __builtin_amdgcn_readfirstlane(tid >> 6), lane = tid & 63, wr = wid >> 2, wc = wid & 3, fr = lane & 15, fq = lane >> 4;
    int K = g.K; if constexpr (OPQK) asm volatile("" : "+s"(K));
    const int nt = K / BK;
    unsigned voffA[2], voffB[2];
#pragma unroll
    for (int i = 0; i < 2; ++i) { int R, C; stage_rc(tid * 16 + i * 8192, R, C); const int Rb = Epi::PERM ? ((R & ~31) + perm32(R & 31)) : R;
        voffA[i] = (unsigned)(R * g.lda + C) * 2u; voffB[i] = (unsigned)(Rb * g.ldb + C) * 2u; }
    unsigned voffX = 0u; { int R, C; stage_rc((tid & 127) * 16, R, C); voffX = (unsigned)(R * g.lda + C) * 2u; }
    const int xoff = lds_byte(fr, fq * 8);
    const bool xw = STRIP && (wid < 2);
    const size_t kstep = (size_t)(BK * 2);
    const size_t hstepA = (size_t)HALF * g.lda * 2, hstepB = (size_t)HALF * g.ldb * 2;
    const size_t tstepA = 2 * hstepA, tstepB = 2 * hstepB;
    const size_t pnoffA = (size_t)g.a_pn_off * 2;
    const unsigned ldsw = (unsigned)wid * 1024u;
    const int fcol = fq * 8, fkst = 1024;
    const int aoff = lds_byte(wr * 64 + fr, fcol), boff = lds_byte(wc * 32 + fr, fcol);
#define PG8_SA(b, h) (((b) * 2 + (h)) * HTB)
#define PG8_SB(b, h) ((4 + (b) * 2 + (h)) * HTB)
#define PG8_STAGE(bufoff, gbase, voff) do { if constexpr (F8) { _Pragma("unroll") for (int _i = 0; _i < 2; ++_i) glds16s((const void*)(gbase), (voff)[_i], (unsigned)(unsigned long long)(lds + (bufoff) + ldsw + _i * 8192)); } \
        else { _Pragma("unroll") for (int _i = 0; _i < 2; ++_i) \
        __builtin_amdgcn_global_load_lds((const unsigned*)((const char*)(gbase) + (voff)[_i]), (PG8_LAS unsigned*)(lds + (bufoff) + ldsw + _i * 8192), 16, 0, 0); } } while (0)
#define PG8_LD8(base_) __builtin_shufflevector(*(const PG8_LAS i32x4*)(base_), *(const PG8_LAS i32x4*)((base_) + 1024), 0, 1, 2, 3, 4, 5, 6, 7)
#define PG8_LDA(dst, b, h) do { if constexpr (F8) { _Pragma("unroll") for (int m = 0; m < 4; ++m) A8[m] = PG8_LD8(lds + PG8_SA(b, h) + aoff + m * 2048); } \
        else { _Pragma("unroll") for (int m = 0; m < 4; ++m) _Pragma("unroll") for (int k = 0; k < 2; ++k) dst[m][k] = *(const PG8_LAS bf16x8*)(lds + PG8_SA(b, h) + aoff + m * 2048 + k * 1024); } } while (0)
#define PG8_LDB(dst, b, h) do { if constexpr (F8) { _Pragma("unroll") for (int n = 0; n < 2; ++n) dst##8[n] = PG8_LD8(lds + PG8_SB(b, h) + boff + n * 2048); } \
        else { _Pragma("unroll") for (int n = 0; n < 2; ++n) _Pragma("unroll") for (int k = 0; k < 2; ++k) dst[n][k] = *(const PG8_LAS bf16x8*)(lds + PG8_SB(b, h) + boff + n * 2048 + k * 1024); } } while (0)
#define PG8_MMA(ai, bj, At, Bt) do { __builtin_amdgcn_s_setprio(1); if constexpr (F8) { _Pragma("unroll") for (int m = 0; m < 4; ++m) _Pragma("unroll") for (int n = 0; n < 2; ++n) \
        acc[ai][bj][m][n] = __builtin_amdgcn_mfma_scale_f32_16x16x128_f8f6f4(Bt##8[n], A8[m], acc[ai][bj][m][n], 0, 0, 0, 0x7f7f7f7f, 0, 0x7f7f7f7f); } \
        else { _Pragma("unroll") for (int m = 0; m < 4; ++m) _Pragma("unroll") for (int n = 0; n < 2; ++n) _Pragma("unroll") for (int k = 0; k < 2; ++k) \
        acc[ai][bj][m][n] = __builtin_amdgcn_mfma_f32_16x16x32_bf16(Bt[n][k], At[m][k], acc[ai][bj][m][n], 0, 0, 0); } \
        __builtin_amdgcn_s_setprio(0); } while (0)
#define PG8_WAIT_V(n) asm volatile("s_waitcnt vmcnt(" #n ")" ::: "memory")
#define PG8_WAIT_V8X do { if (xw) PG8_WAIT_V(9); else PG8_WAIT_V(8); } while (0)
#define PG8_STAGE_X(b, gbase) do { if (xw) __builtin_amdgcn_global_load_lds((const unsigned*)((const char*)(gbase) + voffX), (PG8_LAS unsigned*)(xlds + (b) * 2048 + ldsw), 16, 0, 0); } while (0)
#define PG8_LDX(b) do { _Pragma("unroll") for (int k = 0; k < 2; ++k) Xf[k] = *(const PG8_LAS bf16x8*)(xlds + (b) * 2048 + xoff + k * 1024); } while (0)
#define PG8_MMX do { if (wr == 0) { _Pragma("unroll") for (int k = 0; k < 2; ++k) { acc17[0] = __builtin_amdgcn_mfma_f32_16x16x32_bf16(B0[0][k], Xf[k], acc17[0], 0, 0, 0); acc17[1] = __builtin_amdgcn_mfma_f32_16x16x32_bf16(B1[0][k], Xf[k], acc17[1], 0, 0, 0); } } \
        else { _Pragma("unroll") for (int k = 0; k < 2; ++k) { acc17[0] = __builtin_amdgcn_mfma_f32_16x16x32_bf16(B0[1][k], Xf[k], acc17[0], 0, 0, 0); acc17[1] = __builtin_amdgcn_mfma_f32_16x16x32_bf16(B1[1][k], Xf[k], acc17[1], 0, 0, 0); } } } while (0)
#define PG8_WAIT_L(n) asm volatile("s_waitcnt lgkmcnt(" #n ")" ::: "memory")
#define PG8_BAR __builtin_amdgcn_s_barrier()
#define PG8_SCHED __builtin_amdgcn_sched_barrier(0)
    Unit cur, nxt; int ui = 0;
    if (!S.next(0, cur)) return;
    f32x4 acc[2][2][4][2];
#pragma unroll
    for (int a = 0; a < 2; ++a)
#pragma unroll
        for (int b = 0; b < 2; ++b)
#pragma unroll
            for (int m = 0; m < 4; ++m)
#pragma unroll
                for (int n = 0; n < 2; ++n) acc[a][b][m][n] = (f32x4){0.f, 0.f, 0.f, 0.f};
    bf16x8 At[4][2], B0[2][2], B1[2][2];
    v8i32 A8[4], B08[2], B18[2];
    bf16x8 Xf[2]; f32x4 acc17[2]; acc17[0] = (f32x4){0.f, 0.f, 0.f, 0.f}; acc17[1] = acc17[0];
    const size_t xstep = (size_t)16 * g.lda * 2;
    const char* cA = (const char*)g.A + (size_t)cur.pm * tstepA + (size_t)cur.pn * pnoffA; const char* cB = (const char*)g.Bt + (size_t)cur.pn * tstepB;
    const char* cX = (const char*)g.A + (size_t)strip_row0 * g.lda * 2 + (size_t)cur.pm * xstep + (size_t)cur.pn * pnoffA;
    S.a_ready(cur);
    if constexpr (SP2) {
        if constexpr (STRIP) PG8_STAGE_X(0, cX);
        PG8_STAGE(PG8_SB(0, 0), cB, voffB); PG8_STAGE(PG8_SB(0, 1), cB + hstepB, voffB); PG8_STAGE(PG8_SA(0, 0), cA, voffA); PG8_STAGE(PG8_SA(0, 1), cA + hstepA, voffA);
        if (wr == 1) PG8_BAR;
        PG8_WAIT_V(2); PG8_BAR;
        PG8_STAGE(PG8_SB(1, 0), cB + kstep, voffB); PG8_STAGE(PG8_SA(1, 0), cA + kstep, voffA); PG8_STAGE(PG8_SB(1, 1), cB + hstepB + kstep, voffB);
        if constexpr (STRIP) { PG8_STAGE_X(1, cX + kstep); if (xw) PG8_WAIT_V(7); else PG8_WAIT_V(6); } else PG8_WAIT_V(6);
        PG8_BAR;
    } else {
        PG8_STAGE(PG8_SB(0, 0), cB, voffB); PG8_STAGE(PG8_SA(0, 0), cA, voffA); PG8_STAGE(PG8_SB(0, 1), cB + hstepB, voffB); PG8_STAGE(PG8_SA(0, 1), cA + hstepA, voffA);
        if (wr == 1) PG8_BAR;
        PG8_WAIT_V(4); PG8_BAR;
        PG8_STAGE(PG8_SB(1, 0), cB + kstep, voffB); PG8_STAGE(PG8_SA(1, 0), cA + kstep, voffA); PG8_STAGE(PG8_SB(1, 1), cB + hstepB + kstep, voffB);
        PG8_WAIT_V(6); PG8_BAR;
    }
    for (;;) {
        const bool has_next = S.next(ui + 1, nxt);
        const char* nA = has_next ? (const char*)g.A + (size_t)nxt.pm * tstepA + (size_t)nxt.pn * pnoffA : cA; const char* nB = has_next ? (const char*)g.Bt + (size_t)nxt.pn * tstepB : cB;
        const char* nX = has_next ? (const char*)g.A + (size_t)strip_row0 * g.lda * 2 + (size_t)nxt.pm * xstep + (size_t)nxt.pn * pnoffA : cX;
#pragma nounroll
        for (int t = 0; t < nt; t += 2) {
            const bool last = (t == nt - 2);
            const char* a1 = cA + (size_t)(t + 1) * kstep;
            const char* a2 = last ? nA : cA + (size_t)(t + 2) * kstep; const char* b2 = last ? nB : cB + (size_t)(t + 2) * kstep;
            const char* a3 = a2 + kstep; const char* b3 = b2 + kstep;
            const char* x2 = last ? nX : cX + (size_t)(t + 2) * kstep; const char* x3 = x2 + kstep;
            if (last && has_next) S.a_ready(nxt);
            if constexpr (SP2) {
            PG8_LDB(B0, 0, 0); PG8_LDB(B1, 0, 1); PG8_SCHED; PG8_LDA(At, 0, 0); if constexpr (STRIP) PG8_LDX(0); PG8_STAGE(PG8_SA(1, 1), a1 + hstepA, voffA);
            PG8_WAIT_V8X; PG8_WAIT_L(0); PG8_BAR; PG8_MMA(0, 0, At, B0); PG8_MMA(0, 1, At, B1); if constexpr (STRIP) PG8_MMX; PG8_BAR; PG8_SCHED;
            PG8_LDA(At, 0, 1); PG8_STAGE(PG8_SB(0, 0), b2, voffB); PG8_STAGE(PG8_SB(0, 1), b2 + hstepB, voffB); PG8_STAGE(PG8_SA(0, 0), a2, voffA); if constexpr (STRIP) PG8_STAGE_X(0, x2);
            PG8_WAIT_V8X; PG8_WAIT_L(0); PG8_BAR; PG8_MMA(1, 0, At, B0); PG8_MMA(1, 1, At, B1); PG8_BAR; PG8_SCHED;
            PG8_LDB(B0, 1, 0); PG8_LDB(B1, 1, 1); PG8_SCHED; PG8_LDA(At, 1, 0); if constexpr (STRIP) PG8_LDX(1); PG8_STAGE(PG8_SA(0, 1), a2 + hstepA, voffA);
            PG8_WAIT_V8X; PG8_WAIT_L(0); PG8_BAR; PG8_MMA(0, 0, At, B0); PG8_MMA(0, 1, At, B1); if constexpr (STRIP) PG8_MMX; PG8_BAR; PG8_SCHED;
            PG8_LDA(At, 1, 1); PG8_STAGE(PG8_SB(1, 0), b3, voffB); PG8_STAGE(PG8_SB(1, 1), b3 + hstepB, voffB); PG8_STAGE(PG8_SA(1, 0), a3, voffA); if constexpr (STRIP) PG8_STAGE_X(1, x3);
            PG8_WAIT_V8X; PG8_WAIT_L(0); PG8_BAR; PG8_MMA(1, 0, At, B0); PG8_MMA(1, 1, At, B1); PG8_BAR; PG8_SCHED;
            } else {
            PG8_LDB(B0, 0, 0); PG8_SCHED; PG8_LDA(At, 0, 0); PG8_STAGE(PG8_SA(1, 1), a1 + hstepA, voffA);
            PG8_WAIT_L(8); PG8_BAR; PG8_WAIT_L(0); PG8_MMA(0, 0, At, B0); PG8_BAR; PG8_SCHED;
            PG8_LDB(B1, 0, 1); PG8_STAGE(PG8_SB(0, 0), b2, voffB);
            PG8_BAR; PG8_WAIT_L(0); PG8_MMA(0, 1, At, B1); PG8_BAR;
            PG8_LDA(At, 0, 1); PG8_STAGE(PG8_SA(0, 0), a2, voffA);
            PG8_BAR; PG8_WAIT_L(0); PG8_MMA(1, 0, At, B0); PG8_BAR; PG8_SCHED;
            PG8_STAGE(PG8_SB(0, 1), b2 + hstepB, voffB);
            PG8_WAIT_V(6); PG8_BAR; PG8_MMA(1, 1, At, B1); PG8_BAR;
            PG8_LDB(B0, 1, 0); PG8_SCHED; PG8_LDA(At, 1, 0); PG8_STAGE(PG8_SA(0, 1), a2 + hstepA, voffA);
            PG8_WAIT_L(8); PG8_BAR; PG8_WAIT_L(0); PG8_MMA(0, 0, At, B0); PG8_BAR; PG8_SCHED;
            PG8_LDB(B1, 1, 1); PG8_STAGE(PG8_SB(1, 0), b3, voffB);
            PG8_BAR; PG8_WAIT_L(0); PG8_MMA(0, 1, At, B1); PG8_BAR;
            PG8_LDA(At, 1, 1); PG8_STAGE(PG8_SA(1, 0), a3, voffA);
            PG8_BAR; PG8_WAIT_L(0); PG8_MMA(1, 0, At, B0); PG8_BAR; PG8_SCHED;
            PG8_STAGE(PG8_SB(1, 1), b3 + hstepB, voffB);
            PG8_WAIT_V(6); PG8_BAR; PG8_MMA(1, 1, At, B1); PG8_BAR;
            }
        }
        if constexpr (ALIGN_EPI) { if (wr == 0) PG8_BAR; }
        if constexpr (!Epi::AFTER_DRAIN) { int fr_e = fr, fq_e = fq; asm volatile("" : "+v"(fr_e), "+v"(fq_e));
            E(acc, cur, wr, wc, fr_e, fq_e); if constexpr (STRIP) E.strip(acc17, strip_row0 + 16 * cur.pm + fr_e, cur.pn, wr, wc, fq_e); S.done(cur); }
        if (!has_next) break;
#pragma unroll
        for (int a = 0; a < 2; ++a)
#pragma unroll
            for (int b = 0; b < 2; ++b)
#pragma unroll
                for (int m = 0; m < 4; ++m)
#pragma unroll
                    for (int n = 0; n < 2; ++n) acc[a][b][m][n] = (f32x4){0.f, 0.f, 0.f, 0.f};
        cur = nxt; cA = nA; cB = nB; cX = nX; ++ui; acc17[0] = (f32x4){0.f, 0.f, 0.f, 0.f}; acc17[1] = acc17[0];
        if constexpr (ALIGN_EPI) { if (wr == 1) PG8_BAR; }
    }
    PG8_WAIT_V(0);
    if constexpr (!ALIGN_EPI) { if (wr == 0) PG8_BAR; }
    PG8_BAR;
    if constexpr (Epi::AFTER_DRAIN) { E.fused(acc, cur, wr, wc, fr, fq, lds, wid, lane); S.done(cur); }
#undef PG8_SA
#undef PG8_SB
#undef PG8_STAGE
#undef PG8_LDA
#undef PG8_LD8
#undef PG8_LDB
#undef PG8_MMA
#undef PG8_WAIT_V
#undef PG8_WAIT_V8X
#undef PG8_STAGE_X
#undef PG8_LDX
#undef PG8_MMX
#undef PG8_WAIT_L
#undef PG8_BAR
#undef PG8_SCHED
}

}

#define GAS __attribute__((address_space(1)))
#define LAS __attribute__((address_space(3)))
typedef unsigned short bf16;
typedef unsigned v4u __attribute__((ext_vector_type(4)));
typedef float f32x4 __attribute__((ext_vector_type(4)));
typedef short bf16x8 __attribute__((ext_vector_type(8)));
typedef GAS unsigned gu32;
typedef GAS unsigned long long gu64;
#define RLX_AGENT __ATOMIC_RELAXED, __HIP_MEMORY_SCOPE_AGENT
#define LDS_WAIT() asm volatile("s_waitcnt lgkmcnt(0)" ::: "memory")
#define VM_WAIT() asm volatile("s_waitcnt vmcnt(0)" ::: "memory")
__device__ __forceinline__ unsigned long long rt() { return __builtin_amdgcn_s_memrealtime(); }
__device__ __forceinline__ unsigned f2bf(float f) { unsigned u = __builtin_bit_cast(unsigned, f); return (u + 0x7fffu + ((u >> 16) & 1u)) >> 16; }
__device__ __forceinline__ unsigned pk2(float lo, float hi) { return f2bf(lo) | (f2bf(hi) << 16); }
#define XB_TMO      128
#define XB_XCNT(j)  (256  + 64 * (j))
#define XB_XSUB(j)  (1280 + 64 * (j))
#define XB_XGEN(j)  (2304 + 64 * (j))
#define XB_TOP      3328
#define XB_TOPGEN   3392
#define XCD_BAR_WORDS 3456
#define XB_SPIN_CAP (1u << 18)

__device__ __forceinline__ unsigned xb_ld(unsigned* p)              { return __hip_atomic_load(p, __ATOMIC_RELAXED, __HIP_MEMORY_SCOPE_AGENT); }
__device__ __forceinline__ unsigned xb_add(unsigned* p, unsigned v) { return __hip_atomic_fetch_add(p, v, __ATOMIC_RELAXED, __HIP_MEMORY_SCOPE_AGENT); }
__device__ __forceinline__ unsigned xb_xcc_id() { return (unsigned)__builtin_amdgcn_s_getreg((3 << 11) | 20) & 0xFu; }
#define XB_SPIN(cond, bar) do { unsigned _sp = 0; while (cond) { __builtin_amdgcn_s_sleep(1); \
    if ((++_sp & 255u) == 0u) { if (xb_ld(&(bar)[XB_TMO])) break; if (_sp > XB_SPIN_CAP) { atomicAdd(&(bar)[XB_TMO], 1u); break; } } } } while (0)

struct XcdBarrier {
    unsigned* bar; unsigned x;
    volatile LAS unsigned* st;
};

__device__ __forceinline__ XcdBarrier xcd_barrier_post(unsigned* bar, volatile LAS unsigned* st) {
    XcdBarrier b; b.bar = bar; b.x = xb_xcc_id(); b.st = st;
    if (threadIdx.x == 0) (void)xb_add(&bar[XB_XCNT(b.x)], 1u);
    return b;
}
__device__ __forceinline__ void xcd_barrier_complete(unsigned* bar, unsigned x, unsigned& nloc, unsigned& nx) {
    const unsigned G = gridDim.x * gridDim.y * gridDim.z;
    unsigned sum, cnt, mine, sp = 0u;
    for (;;) {
        sum = 0u; cnt = 0u; mine = 0u;
#pragma unroll
        for (unsigned j = 0; j < 16; ++j) { const unsigned c = xb_ld(&bar[XB_XCNT(j)]); sum += c; cnt += (c > 0u) ? 1u : 0u; mine = (j == x) ? c : mine; }
        if (sum == G) break;
        __builtin_amdgcn_s_sleep(1);
        if ((++sp & 255u) == 0u) { if (xb_ld(&bar[XB_TMO])) break; if (sp > XB_SPIN_CAP) { atomicAdd(&bar[XB_TMO], 1u); break; } }
    }
    nloc = mine > 0u ? mine : 1u; nx = cnt > 0u ? cnt : 1u;
}

__device__ __forceinline__ void xcd_barrier(const XcdBarrier& b) {
    asm volatile("s_waitcnt vmcnt(0)" ::: "memory");
    __syncthreads();
    if (threadIdx.x == 0) {
        unsigned* bar = b.bar;
        __builtin_amdgcn_s_waitcnt(0);
        unsigned nloc = b.st[0], nx = b.st[1];
        if (nloc == 0u) { xcd_barrier_complete(bar, b.x, nloc, nx); b.st[0] = nloc; b.st[1] = nx; }
        const unsigned old = xb_add(&bar[XB_XSUB(b.x)], 1u);
        const unsigned gen = old / nloc;
        if (old + 1u == (gen + 1u) * nloc) {
            __builtin_amdgcn_fence(__ATOMIC_RELEASE, "agent");
            asm volatile("s_waitcnt vmcnt(0)" ::: "memory");
            const unsigned og = xb_add(&bar[XB_TOP], 1u);
            const unsigned tg = og / nx;
            if (og + 1u == (tg + 1u) * nx) xb_add(&bar[XB_TOPGEN], 1u);
            else XB_SPIN(xb_ld(&bar[XB_TOPGEN]) == tg, bar);
            __builtin_amdgcn_fence(__ATOMIC_ACQUIRE, "agent");
            xb_add(&bar[XB_XGEN(b.x)], 1u);
            asm volatile("s_waitcnt vmcnt(0)" ::: "memory");
        } else {
            XB_SPIN(xb_ld(&bar[XB_XGEN(b.x)]) == gen, bar);
            __builtin_amdgcn_fence(__ATOMIC_ACQUIRE, "agent");
            asm volatile("s_waitcnt vmcnt(0)" ::: "memory");
        }
    }
    __syncthreads();
}

struct Params { const float* in[N_IN]; float* out; unsigned char* ws; int ph_lo, ph_hi; };
static_assert(sizeof(Params) == N_IN * 8 + 8 + 8 + 8, "Params has no padding bytes");
constexpr int NWAVES = 8, NTHR = NWAVES * 64;
#define WSP(T_, off) ((T_*)(p.ws + (off)))

__device__ __forceinline__ float wave_sum(float v) {
#pragma unroll
    for (int o = 1; o < 64; o <<= 1) v += __shfl_xor(v, o);
    return v;
}
__device__ __forceinline__ unsigned pkbf(float lo, float hi) { return pg8::cvt_pk_bf16(lo, hi); }
__device__ __forceinline__ float bf_lo(unsigned w) { return __uint_as_float(w << 16); }
__device__ __forceinline__ float bf_hi(unsigned w) { return __uint_as_float(w & 0xffff0000u); }

__device__ __forceinline__ void transpose_item(const float* W, int ldw, int src_col0, bf16* WT, int K, int dst_row0, const float* gain, int mode, LAS float* scr, int kb, int lane) {
    const int k0 = 64 * kb;
    { const int ks = lane >> 3, n4 = (lane & 7) * 4; f32x4 v[8];
#pragma unroll
      for (int i = 0; i < 8; ++i) v[i] = *(const f32x4*)(W + (size_t)(k0 + 8 * i + ks) * ldw + src_col0 + n4);
#pragma unroll
      for (int i = 0; i < 8; ++i) { const int kk = 8 * i + ks; const float g = gain ? gain[k0 + kk] : 1.0f; LAS float* d = scr + kk * 33 + n4; d[0] = v[i].x * g; d[1] = v[i].y * g; d[2] = v[i].z * g; d[3] = v[i].w * g; } }
    LDS_WAIT(); asm volatile("" ::: "memory");
    const int c = lane & 7;
#pragma unroll
    for (int j = 0; j < 4; ++j) { const int n = (lane >> 3) + 8 * j; const LAS float* s = scr + (8 * c) * 33 + n;
        const int dn = mode ? (8 * ((n >> 2) & 3) + 4 * (n >> 4) + (n & 3)) : n;
        v4u o; o.x = pkbf(s[0 * 33], s[1 * 33]); o.y = pkbf(s[2 * 33], s[3 * 33]); o.z = pkbf(s[4 * 33], s[5 * 33]); o.w = pkbf(s[6 * 33], s[7 * 33]);
        *(GAS v4u*)(WT + (size_t)(dst_row0 + dn) * K + k0 + 8 * c) = o; }
    LDS_WAIT(); asm volatile("" ::: "memory");
}

__device__ __forceinline__ void p0_prologue(const Params& p, LAS unsigned char* lds, int wave, int lane) {
    LAS float* scr = (LAS float*)(lds + wave * 16384);
    const int gw = blockIdx.x * NWAVES + wave, NGW = gridDim.x * NWAVES;
    constexpr int J0 = 16 * 25, J1 = 8 * 48, J2 = 4 * 32, J3 = 4 * 32, J4 = 16 * 32, J5 = 16 * 192, J6 = 48 * 32, J7 = 16 * 64, J8 = 128, J9 = 16 * 32;
    constexpr int NITEMS = J0 + J1 + J2 + J3 + J4 + 2 * J5 + 2 * J6 + J7 + J8 + J9;
    for (int it = gw; it < NITEMS; it += NGW) {
        int r = it;
        if (r < J0) { const int kb = r / 25, nb = r % 25; transpose_item(p.in[I_WD], 800, 32 * nb, WSP(bf16, WS_WD), 1024, 32 * nb, nullptr, 0, scr, kb, lane); continue; } r -= J0;
        if (r < J1) { const int kb = r / 48, db = r % 48; int src, mode;
            if (db < 32) { const int pn = db >> 3, bj = (db >> 2) & 1, wc = db & 3; src = (4 * pn + wc) * QKD + 32 * bj; mode = 0; }
            else { const int rb = db - 32, pr = rb >> 3, bj = (rb >> 2) & 1, wc = rb & 3; src = (8 * pr + 4 * bj + wc) * QKD + QKN; mode = 1; }
            transpose_item(p.in[I_WUQ], NH * QKD, src, WSP(bf16, WS_WUQ), QL, 32 * db, p.in[I_GQL], mode, scr, kb, lane); continue; } r -= J1;
        if (r < J2) { const int kb = r / 32, db = r % 32, pn = db >> 3, bj = (db >> 2) & 1, wc = db & 3;
            transpose_item(p.in[I_WUK], NH * QKN, (4 * pn + wc) * QKN + 32 * bj, WSP(bf16, WS_WK), KVL, 32 * db, nullptr, 0, scr, kb, lane); continue; } r -= J2;
        if (r < J3) { const int kb = r / 32, db = r % 32; transpose_item(p.in[I_WUV], NH * VH, 32 * db, WSP(bf16, WS_WV), KVL, 32 * db, nullptr, 0, scr, kb, lane); continue; } r -= J3;
        if (r < J4) { const int kb = r / 32, db = r % 32; transpose_item(p.in[I_WO], D, 32 * db, WSP(bf16, WS_WO), D, 32 * db, nullptr, 0, scr, kb, lane); continue; } r -= J4;
        if (r < 2 * J5) { const int l = r / J5, q = r % J5, kb = q / 192, db = q % 192, pn = db >> 3, bj = (db >> 2) & 1, cb = db & 3;
            transpose_item(p.in[I_WUP] + (size_t)l * D * 2 * DFF, 2 * DFF, bj * DFF + 128 * pn + 32 * cb, WSP(bf16, WS_WUP) + (size_t)l * 2 * DFF * D, D, 32 * db, p.in[I_NFFN] + l * D, 0, scr, kb, lane); continue; } r -= 2 * J5;
        if (r < 2 * J6) { const int l = r / J6, q = r % J6, kb = q / 32, db = q % 32;
            transpose_item(p.in[I_WDN] + (size_t)l * DFF * D, D, 32 * db, WSP(bf16, WS_WDN) + (size_t)l * D * DFF, DFF, 32 * db, nullptr, 0, scr, kb, lane); continue; } r -= 2 * J6;
        if (r < J7) { const int kb = r / 64, db = r % 64, pn = db >> 3, bj = (db >> 2) & 1, cb = db & 3;
            transpose_item(p.in[I_WIN], 2 * D, bj * D + 128 * pn + 32 * cb, WSP(bf16, WS_WIN), D, 32 * db, p.in[I_NMIX] + D, 0, scr, kb, lane); continue; } r -= J7;
        if (r < J8) { const int kb = r & 1, q = r >> 1, cb = q & 3, bj = (q >> 2) & 1, nb = q >> 3;
            transpose_item((bj ? p.in[I_WI] : p.in[I_WA]) + (size_t)nb * LB * LB, LB, 32 * cb, WSP(bf16, WS_WAI), LB, 256 * nb + 128 * bj + 32 * cb, nullptr, 0, scr, kb, lane); continue; } r -= J8;
        { const int kb = r / 32, db = r % 32; transpose_item(p.in[I_WOUT], D, 32 * db, WSP(bf16, WS_WOUT), D, 32 * db, nullptr, 0, scr, kb, lane); }
    }
    { GAS v4u* z = (GAS v4u*)(WSP(bf16, WS_WD) + (size_t)800 * 1024); const int n16 = 224 * 1024 * 2 / 16;
      for (int i = blockIdx.x * NTHR + threadIdx.x; i < n16; i += gridDim.x * NTHR) z[i] = (v4u){0u, 0u, 0u, 0u}; }
    for (int i = blockIdx.x * NTHR + threadIdx.x; i < NROPE * 16; i += gridDim.x * NTHR) {
        const int rr = i >> 4, fi = i & 15; const double pos = (double)(rr < T ? rr : PAST + (rr - T));
        const double inv = exp(-(double)fi * (9.210340371976184 / 16.0));
        double ang = pos * inv; const double k = rint(ang * 0.15915494309189535); ang = fma(-k, 6.283185307179586, ang); ang = fma(-k, 2.4492935982947064e-16, ang);
        const float a = (float)ang;
        WSP(float, WS_RCOS)[i] = cosf(a); WSP(float, WS_RSIN)[i] = sinf(a);
    }
    for (int i = blockIdx.x * NTHR + threadIdx.x; i < D; i += gridDim.x * NTHR) { const float l = p.in[I_LAM][i]; WSP(float, WS_SP8)[i] = -8.0f * ((l > 15.f) ? expf(-l) : log1pf(expf(-l))); }
    for (int i = blockIdx.x * NTHR + threadIdx.x; i < 1024 * 64; i += gridDim.x * NTHR) {
        const int n = i >> 6, c0 = (i & 63) * 4, pn = n >> 8, bj = (n >> 7) & 1, wc = (n >> 5) & 3, pp = n & 31, col = (4 * pn + wc) * QKN + 32 * bj + pp;
        const float* w = p.in[I_WUK] + (size_t)c0 * (NH * QKN) + col;
        int v = __builtin_amdgcn_cvt_pk_fp8_f32(16.f * w[0], 16.f * w[NH * QKN], 0, false); v = __builtin_amdgcn_cvt_pk_fp8_f32(16.f * w[2 * NH * QKN], 16.f * w[3 * NH * QKN], v, true);
        *(int*)(p.ws + WS_WK8 + (size_t)n * KVL + c0) = v;
    }
    {
        const GAS f32x4* gr = (const GAS f32x4*)p.in[I_NMIX] + lane;
        f32x4 v[4], nv[4];
#define XN_LOAD(dst, mm) do { const float* xrow_ = ((mm) < MP) ? p.in[I_XP] + (size_t)(mm) * D : p.in[I_XS] + (size_t)((mm) - MP) * D; const GAS f32x4* xr_ = (const GAS f32x4*)xrow_ + lane; \
            _Pragma("unroll") for (int j = 0; j < 4; ++j) dst[j] = xr_[64 * j]; } while (0)
        if (gw < M) XN_LOAD(v, gw);
        for (int m = gw; m < M; m += NGW) {
            if (m + NGW < M) XN_LOAD(nv, m + NGW);
            float s = 0.f;
#pragma unroll
            for (int j = 0; j < 4; ++j) s += (v[j].x * v[j].x + v[j].y * v[j].y) + (v[j].z * v[j].z + v[j].w * v[j].w);
            const float rs = __builtin_amdgcn_rsqf(wave_sum(s) * (1.f / D) + EPS);
            GAS unsigned long long* o8 = (GAS unsigned long long*)(WSP(bf16, WS_XN) + (size_t)m * D) + lane;
#pragma unroll
            for (int j = 0; j < 4; ++j) { const f32x4 g = gr[64 * j]; o8[64 * j] = (unsigned long long)pkbf(v[j].x * rs * g.x, v[j].y * rs * g.y) | ((unsigned long long)pkbf(v[j].z * rs * g.z, v[j].w * rs * g.w) << 32); }
#pragma unroll
            for (int j = 0; j < 4; ++j) v[j] = nv[j];
        }
#undef XN_LOAD
    }
}

__device__ __forceinline__ void thin_gather(const Params& p, int gw, int NGW, int lane) {
    const int* pt = (const int*)p.in[I_PT];
    f32x4 a[16];
#define GATHER_LOAD(src_) do { _Pragma("unroll") for (int i = 0; i < 16; ++i) a[i] = __builtin_nontemporal_load((const f32x4*)((src_) + (size_t)i * KVL)); } while (0)
    for (int pgi = gw; pgi < NSEQ * NPAGES; pgi += NGW) {
        const float* src = p.in[I_CCKV] + (size_t)pt[pgi] * PAGE * KVL + 4 * lane;
        unsigned char* dst8 = p.ws + WS_CB8 + (size_t)pgi * PAGE * KVL + 4 * lane;
        GATHER_LOAD(src);
#pragma unroll 1
        for (int st = 0; st < 8; ++st) {
            int o8[16];
#pragma unroll
            for (int i = 0; i < 16; ++i) { int w = __builtin_amdgcn_cvt_pk_fp8_f32(a[i].x, a[i].y, 0, false); o8[i] = __builtin_amdgcn_cvt_pk_fp8_f32(a[i].z, a[i].w, w, true); }
            if (st < 7) GATHER_LOAD(src + (size_t)(st + 1) * 16 * KVL);
#pragma unroll
            for (int i = 0; i < 16; ++i) *(GAS int*)(dst8 + ((size_t)st * 16 + i) * KVL) = o8[i];
        }
    }
#undef GATHER_LOAD
    for (int r32 = gw; r32 < NSEQ * PAST / 32; r32 += NGW) {
        const int row0 = 32 * r32, bs = row0 >> 13, key0 = row0 & (PAST - 1), pg = pt[bs * NPAGES + (key0 >> 7)];
        const float* src = p.in[I_CKR] + ((size_t)pg * PAGE + (key0 & (PAGE - 1))) * QKR + 4 * lane;
        f32x4 v[4];
#pragma unroll
        for (int i = 0; i < 4; ++i) v[i] = __builtin_nontemporal_load((const f32x4*)(src + (size_t)i * 8 * QKR));
        bf16* dst = WSP(bf16, WS_KRB16) + (size_t)row0 * QKR + 4 * lane;
#pragma unroll
        for (int i = 0; i < 4; ++i) *(GAS unsigned long long*)(dst + (size_t)i * 8 * QKR) = (unsigned long long)pkbf(v[i].x, v[i].y) | ((unsigned long long)pkbf(v[i].z, v[i].w) << 32);
    }
}

__device__ __forceinline__ void thin_ckv_krope(const Params& p, int wave, int lane) {
    const int gw = blockIdx.x * NWAVES + wave, NGW = gridDim.x * NWAVES;
    const f32x4 gkv = *(const f32x4*)(p.in[I_GKV] + 4 * lane);
    const float gkr = p.in[I_GKR][lane & 31];
    f32x4 v = (f32x4){0.f, 0.f, 0.f, 0.f}, nv = v; float kr = 0.f, nkr = 0.f;
    if (gw < M) { v = *(const f32x4*)(WSP(float, WS_CKVRAW) + (size_t)gw * KVL + 4 * lane); kr = WSP(float, WS_KRRAW)[(size_t)gw * QKR + (lane & 31)]; }
    for (int m = gw; m < M; m += NGW) {
        if (m + NGW < M) { nv = *(const f32x4*)(WSP(float, WS_CKVRAW) + (size_t)(m + NGW) * KVL + 4 * lane); nkr = WSP(float, WS_KRRAW)[(size_t)(m + NGW) * QKR + (lane & 31)]; }
        const int rr = pg8::rope_row(m), fi = lane & 15;
        const float cs = WSP(float, WS_RCOS)[rr * 16 + fi], sn = WSP(float, WS_RSIN)[rr * 16 + fi];
        const float rs = __builtin_amdgcn_rsqf(wave_sum((v.x * v.x + v.y * v.y) + (v.z * v.z + v.w * v.w)) * (1.f / KVL) + EPS);
        const f32x4 o = v * rs * gkv;
        float* oc = (m < MP) ? p.out + OFF_CKVP + (size_t)m * KVL : p.out + OFF_CKVS + (size_t)(m - MP) * KVL;
        *(f32x4*)(oc + 4 * lane) = o;
        unsigned long long w = (unsigned long long)pkbf(o.x, o.y) | ((unsigned long long)pkbf(o.z, o.w) << 32);
        *(unsigned long long*)(WSP(bf16, WS_CKVB) + (size_t)m * KVL + 4 * lane) = w;
        const float ssr = wave_sum(kr * kr) * 0.5f;
        const float n = kr * __builtin_amdgcn_rsqf(ssr * (1.f / QKR) + EPS) * gkr;
        const float other = __shfl_xor(n, 16);
        const float ro = ((lane & 16) == 0) ? (n * cs - other * sn) : (other * sn + n * cs);
        if (lane < 32) {
            float* ok = (m < MP) ? p.out + OFF_KRP + (size_t)m * QKR : p.out + OFF_KRS + (size_t)(m - MP) * QKR;
            ok[lane] = ro;
        }
        const float nb = __shfl_xor(ro, 1);
        if (lane < 32 && (lane & 1) == 0) *(unsigned*)(WSP(bf16, WS_KRB) + (size_t)m * QKR + lane) = pkbf(ro, nb);
        v = nv; kr = nkr;
    }
}

__device__ __forceinline__ void thin_qabs(const Params& p, int wave, int lane) {
    const int gw = blockIdx.x * NWAVES + wave, NGW = gridDim.x * NWAVES, l15 = lane & 15, fq = lane >> 4;
    for (int it = gw; it < NSEQ * NH; it += NGW) {
        const int bs = it >> 4, h = it & 15;
        bf16x8 af[2];
#pragma unroll
        for (int ks = 0; ks < 2; ++ks) {
            v4u w = (v4u){0u, 0u, 0u, 0u};
            if (l15 < DSEQ) {
                const v4u qv = *(const v4u*)(WSP(bf16, WS_Q) + (size_t)(MP + bs * DSEQ + l15) * (NH * QKD) + h * QKD + 32 * ks + 8 * fq);
                const f32x4 g0 = *(const f32x4*)(p.in[I_GKN] + 32 * ks + 8 * fq), g1 = *(const f32x4*)(p.in[I_GKN] + 32 * ks + 8 * fq + 4);
                w.x = pkbf(bf_lo(qv.x) * g0.x, bf_hi(qv.x) * g0.y); w.y = pkbf(bf_lo(qv.y) * g0.z, bf_hi(qv.y) * g0.w);
                w.z = pkbf(bf_lo(qv.z) * g1.x, bf_hi(qv.z) * g1.y); w.w = pkbf(bf_lo(qv.w) * g1.z, bf_hi(qv.w) * g1.w);
            }
            af[ks] = __builtin_bit_cast(bf16x8, w);
        }
#pragma unroll 4
        for (int nb = 0; nb < 16; ++nb) {
            f32x4 acc = (f32x4){0.f, 0.f, 0.f, 0.f};
#pragma unroll
            for (int ks = 0; ks < 2; ++ks) {
                const float* wp = p.in[I_WUK] + ((size_t)(16 * nb + l15) * NH + h) * QKN + 32 * ks + 8 * fq;
                const f32x4 b0 = *(const f32x4*)wp, b1 = *(const f32x4*)(wp + 4);
                v4u w; w.x = pkbf(b0.x, b0.y); w.y = pkbf(b0.z, b0.w); w.z = pkbf(b1.x, b1.y); w.w = pkbf(b1.z, b1.w);
                acc = __builtin_amdgcn_mfma_f32_16x16x32_bf16(af[ks], __builtin_bit_cast(bf16x8, w), acc, 0, 0, 0);
            }
            if (fq < 2) {
#pragma unroll
                for (int j = 0; j < 4; ++j) WSP(bf16, WS_QABS)[((size_t)bs * 128 + h * 8 + 4 * fq + j) * KVL + 16 * nb + l15] = (bf16)(pkbf(acc[j], 0.f) & 0xffffu);
            }
        }
    }
}

__device__ __forceinline__ void thin_combine_uv(const Params& p, LAS unsigned char* lds, int wave, int lane) {
    const int gw = blockIdx.x * NWAVES + wave, NGW = gridDim.x * NWAVES;
    LAS float* cx = (LAS float*)(lds + wave * 8192);
    for (int it = gw; it < NSEQ * NH; it += NGW) {
        const int bs = it >> 4, h = it & 15;
#pragma unroll
        for (int q = 0; q < DSEQ; ++q) {
            const int col = h * 8 + q; float mx = -INFINITY, ms[NSPLIT], ls[NSPLIT];
#pragma unroll
            for (int s = 0; s < NSPLIT; ++s) { ms[s] = WSP(float, WS_MLM)[((size_t)bs * NSPLIT + s) * 128 + col];
                ls[s] = WSP(float, WS_MLL)[(((size_t)bs * NSPLIT + s) * 2 + 0) * 128 + col] + WSP(float, WS_MLL)[(((size_t)bs * NSPLIT + s) * 2 + 1) * 128 + col]; mx = fmaxf(mx, ms[s]); }
            float L = 0.f, wgt[NSPLIT];
#pragma unroll
            for (int s = 0; s < NSPLIT; ++s) { wgt[s] = __builtin_amdgcn_exp2f(ms[s] - mx); L += ls[s] * wgt[s]; }
            const float il = 1.0f / L; f32x4 a = (f32x4){0.f, 0.f, 0.f, 0.f};
#pragma unroll
            for (int s = 0; s < NSPLIT; ++s) a += *(const f32x4*)(WSP(float, WS_CTXP) + (((size_t)bs * NSPLIT + s) * 128 + col) * KVL + 4 * lane) * (wgt[s] * il);
            *(LAS f32x4*)(cx + q * KVL + 4 * lane) = a;
        }
        LDS_WAIT(); asm volatile("" ::: "memory");
        float o[DSEQ];
#pragma unroll
        for (int q = 0; q < DSEQ; ++q) o[q] = 0.f;
        const float* wv = p.in[I_WUV] + h * VH + lane;
#pragma unroll 4
        for (int c = 0; c < KVL; ++c) { const float w = wv[(size_t)c * (NH * VH)];
#pragma unroll
            for (int q = 0; q < DSEQ; ++q) o[q] += cx[q * KVL + c] * w; }
#pragma unroll
        for (int q = 0; q < DSEQ; ++q) WSP(bf16, WS_O)[(size_t)(MP + bs * DSEQ + q) * D + h * VH + lane] = (bf16)(pkbf(o[q], 0.f) & 0xffffu);
        LDS_WAIT(); asm volatile("" ::: "memory");
    }
}

__device__ __forceinline__ void thin_ffn_fix(const Params& p, int layer, int blk0, int nblk) {
    const float* cw = p.in[I_FCW] + (size_t)layer * 3 * DFF; const float* cb = p.in[I_FCB] + (size_t)layer * DFF;
    const float* HG = WSP(float, WS_HEADG); const float* HU = WSP(float, WS_HEADU); const float* TG = WSP(float, WS_TAILG);
    const int NIT = nblk * (DFF / 4);
    for (int it = threadIdx.x; it < NIT; it += NTHR) {
        const int blk = blk0 + it / (DFF / 4), ch = (it % (DFF / 4)) * 4;
        const f32x4 w0 = *(const f32x4*)(cw + ch), w1 = *(const f32x4*)(cw + DFF + ch), w2 = *(const f32x4*)(cw + 2 * DFF + ch), bb = *(const f32x4*)(cb + ch);
        f32x4 gm2 = (f32x4){0.f, 0.f, 0.f, 0.f}, gm1 = gm2;
        if ((blk & 31) != 0) { gm2 = *(const f32x4*)(TG + ((size_t)(blk - 1) * 2 + 0) * DFF + ch); gm1 = *(const f32x4*)(TG + ((size_t)(blk - 1) * 2 + 1) * DFF + ch); }
        const f32x4 g0 = *(const f32x4*)(HG + ((size_t)blk * 2 + 0) * DFF + ch), g1 = *(const f32x4*)(HG + ((size_t)blk * 2 + 1) * DFF + ch);
        const f32x4 u0 = *(const f32x4*)(HU + ((size_t)blk * 2 + 0) * DFF + ch), u1 = *(const f32x4*)(HU + ((size_t)blk * 2 + 1) * DFF + ch);
        f32x4 h0, h1;
#pragma unroll
        for (int j = 0; j < 4; ++j) { h0[j] = pg8::silu_f(gm2[j] * w0[j] + gm1[j] * w1[j] + g0[j] * w2[j] + bb[j]) * u0[j];
            h1[j] = pg8::silu_f(gm1[j] * w0[j] + g0[j] * w1[j] + g1[j] * w2[j] + bb[j]) * u1[j]; }
        bf16* hb = WSP(bf16, WS_HB) + (size_t)blk * 64 * DFF + ch;
        *(unsigned long long*)hb = (unsigned long long)pkbf(h0[0], h0[1]) | ((unsigned long long)pkbf(h0[2], h0[3]) << 32);
        *(unsigned long long*)(hb + DFF) = (unsigned long long)pkbf(h1[0], h1[1]) | ((unsigned long long)pkbf(h1[2], h1[3]) << 32);
    }
}

__device__ __forceinline__ void thin_rec_fix(const Params& p, int blk0, int nblk, int ch0) {
    const float* cw = p.in[I_RCW]; const float* cb = p.in[I_RCB]; const float* HX = WSP(float, WS_HEADX); const float* TX = WSP(float, WS_TAILX);
    for (int it = threadIdx.x; it < nblk * 32; it += NTHR) {
        const int blk = blk0 + (it >> 5), ch = ch0 + (it & 31) * 4;
        const f32x4 w0 = *(const f32x4*)(cw + ch), w1 = *(const f32x4*)(cw + D + ch), w2 = *(const f32x4*)(cw + 2 * D + ch), w3 = *(const f32x4*)(cw + 3 * D + ch), bb = *(const f32x4*)(cb + ch);
        f32x4 x3 = (f32x4){0.f, 0.f, 0.f, 0.f}, x2 = x3, x1 = x3;
        if ((blk & 31) != 0) { const float* t = TX + (size_t)(blk - 1) * 3 * D + ch; x3 = *(const f32x4*)t; x2 = *(const f32x4*)(t + D); x1 = *(const f32x4*)(t + 2 * D); }
#pragma unroll
        for (int r = 0; r < 3; ++r) { const f32x4 x0 = *(const f32x4*)(HX + ((size_t)blk * 3 + r) * D + ch);
            const f32x4 y = x3 * w0 + x2 * w1 + x1 * w2 + x0 * w3 + bb;
            *(unsigned long long*)(WSP(bf16, WS_XC) + ((size_t)blk * 64 + r) * D + ch) = (unsigned long long)pkbf(y.x, y.y) | ((unsigned long long)pkbf(y.z, y.w) << 32);
            x3 = x2; x2 = x1; x1 = x0; }
    }
}

__device__ __forceinline__ void thin_scan1(const Params& p) {
    const float* LAp = WSP(float, WS_LA); const float* BXp = WSP(float, WS_BX);
    for (int it = blockIdx.x * NTHR + threadIdx.x; it < NBATCH * 16 * D; it += gridDim.x * NTHR) {
        const int ch = it & (D - 1), bc = it >> 10; const size_t r0 = (size_t)bc * 128;
        float h = 0.f, pa = 1.f;
#pragma unroll 8
        for (int r = 0; r < 128; ++r) { const float a = LAp[(r0 + r) * D + ch], b = BXp[(r0 + r) * D + ch]; h = a * h + b; pa *= a; }
        WSP(float, WS_PA)[(size_t)bc * D + ch] = pa; WSP(float, WS_HL)[(size_t)bc * D + ch] = h;
    }
    for (int it = blockIdx.x * NTHR + threadIdx.x; it < NSEQ * D; it += gridDim.x * NTHR) {
        const int ch = it & (D - 1), bs = it >> 10; const size_t r0 = (size_t)MP + bs * DSEQ;
        float h = p.in[I_SLH][(size_t)bs * D + ch];
#pragma unroll
        for (int r = 0; r < DSEQ; ++r) { h = LAp[(r0 + r) * D + ch] * h + BXp[(r0 + r) * D + ch];
            const bf16 g = WSP(bf16, WS_GATE)[(r0 + r) * D + ch];
            WSP(bf16, WS_Y)[(r0 + r) * D + ch] = (bf16)(pkbf(h * __uint_as_float((unsigned)g << 16), 0.f) & 0xffffu); }
        p.out[OFF_LHS + (size_t)bs * D + ch] = h;
    }
}
__device__ __forceinline__ void thin_scan2(const Params& p) {
    const float* LAp = WSP(float, WS_LA); const float* BXp = WSP(float, WS_BX);
    for (int it = blockIdx.x * NTHR + threadIdx.x; it < NBATCH * 16 * D; it += gridDim.x * NTHR) {
        const int ch = it & (D - 1), bc = it >> 10, c = bc & 15; const size_t r0 = (size_t)bc * 128;
        float h = 0.f;
        for (int cc = 0; cc < c; ++cc) h = WSP(float, WS_PA)[(size_t)(bc - c + cc) * D + ch] * h + WSP(float, WS_HL)[(size_t)(bc - c + cc) * D + ch];
#pragma unroll 8
        for (int r = 0; r < 128; ++r) { h = LAp[(r0 + r) * D + ch] * h + BXp[(r0 + r) * D + ch];
            const bf16 g = WSP(bf16, WS_GATE)[(r0 + r) * D + ch];
            WSP(bf16, WS_Y)[(r0 + r) * D + ch] = (bf16)(pkbf(h * __uint_as_float((unsigned)g << 16), 0.f) & 0xffffu); }
        if (c == 15) p.out[OFF_LHP + (size_t)(bc >> 4) * D + ch] = h;
    }
}


typedef float f32x16 __attribute__((ext_vector_type(16)));
typedef short s16x4 __attribute__((ext_vector_type(4)));
#define MFMA32(a, b, c) __builtin_amdgcn_mfma_f32_32x32x16_bf16((a), (b), (c), 0, 0, 0)
#define MFMA16(a, b, c) __builtin_amdgcn_mfma_f32_16x16x32_bf16((a), (b), (c), 0, 0, 0)

struct GatherBg { f32x4 a[8]; f32x4 k; int it, n, pst; bool pend; };
__device__ __forceinline__ void bg_init(GatherBg& g, int n) { g.it = 0; g.n = n; g.pst = 0; g.pend = false; }
__device__ __forceinline__ void bg_step(const Params& p, GatherBg& g, int pg0, int tid) {
    const int lane = tid & 63, w = __builtin_amdgcn_readfirstlane(tid >> 6);
    const int* pt = (const int*)p.in[I_PT];
    if (g.pend) {
        const int pgi = pg0 + (g.pst >> 1); const size_t r0 = (size_t)pgi * PAGE + 64 * (g.pst & 1);
        unsigned char* d8 = p.ws + WS_CB8 + (r0 + 8 * w) * KVL + 4 * lane;
#pragma unroll
        for (int i = 0; i < 8; ++i) { int v = __builtin_amdgcn_cvt_pk_fp8_f32(g.a[i].x, g.a[i].y, 0, false); v = __builtin_amdgcn_cvt_pk_fp8_f32(g.a[i].z, g.a[i].w, v, true); *(GAS int*)(d8 + (size_t)i * KVL) = v; }
        *(GAS unsigned long long*)(WSP(bf16, WS_KRB16) + r0 * QKR + 4 * tid) = (unsigned long long)pkbf(g.k.x, g.k.y) | ((unsigned long long)pkbf(g.k.z, g.k.w) << 32);
        g.pend = false;
    }
    if (g.it < g.n) {
        const int pgi = pg0 + (g.it >> 1);
        if (pgi < NSEQ * NPAGES) {
            const size_t s0 = (size_t)pt[pgi] * PAGE + 64 * (g.it & 1);
            const float* src = p.in[I_CCKV] + (s0 + 8 * w) * KVL + 4 * lane;
#pragma unroll
            for (int i = 0; i < 8; ++i) g.a[i] = __builtin_nontemporal_load((const f32x4*)(src + (size_t)i * KVL));
            g.k = __builtin_nontemporal_load((const f32x4*)(p.in[I_CKR] + s0 * QKR + 4 * tid));
            g.pst = g.it; g.pend = true;
        }
        ++g.it;
    }
}

constexpr int PA_KP = 208, PA_VP = 144;
constexpr int PA_KB = 64 * PA_KP, PA_VB = 64 * PA_VP, PA_BUF = PA_KB + PA_VB;
__device__ __forceinline__ void pa_unit(const Params& p, LAS unsigned char* lds, int b, int h, int qb, GatherBg& bg, int pg0) {
    int tid_ = threadIdx.x; asm volatile("" : "+v"(tid_));
    const int tid = tid_, lane = tid & 63, w = __builtin_amdgcn_readfirstlane(tid >> 6), r32 = lane & 31, hi = lane >> 5;
    const bf16* Kg = WSP(bf16, WS_K96) + (size_t)(b * NH + h) * T * QKD;
    const bf16* Vg = WSP(bf16, WS_VT) + (size_t)(b * NH + h) * VH * T;
    const int NT = 4 * (qb + 1);
    const int qrow = b * T + qb * 256 + w * 32 + r32, qabs = qb * 256 + w * 32 + r32;
    const int kc0 = tid, kc1 = 512 + tid;
    const int kl0 = (kc0 / 12) * PA_KP + (kc0 % 12) * 16, kl1 = (kc1 / 12) * PA_KP + (kc1 % 12) * 16;
    const int vd = tid >> 3, vcc = tid & 7, vl = PA_KB + vd * PA_VP + vcc * 16;
    v4u rk0, rk1 = (v4u){0u, 0u, 0u, 0u}, rv;
#define PA_LOAD(kt) do { const bf16* ks_ = Kg + (size_t)(kt) * 64 * QKD; rk0 = *(const v4u*)(ks_ + kc0 * 8); if (tid < 256) rk1 = *(const v4u*)(ks_ + kc1 * 8); \
        rv = *(const v4u*)(Vg + (size_t)vd * T + (kt) * 64 + vcc * 8); } while (0)
#define PA_STORE(buf) do { LAS unsigned char* b_ = lds + (buf) * PA_BUF; *(LAS v4u*)(b_ + kl0) = rk0; if (tid < 256) *(LAS v4u*)(b_ + kl1) = rk1; *(LAS v4u*)(b_ + vl) = rv; } while (0)
    PA_LOAD(0);
    bf16x8 qf[6];
#pragma unroll
    for (int d0 = 0; d0 < 6; ++d0) qf[d0] = *(const bf16x8*)(WSP(bf16, WS_Q) + (size_t)qrow * (NH * QKD) + h * QKD + 16 * d0 + 8 * hi);
    __syncthreads();
    PA_STORE(0);
    __syncthreads();
    f32x16 o0, o1;
#pragma unroll
    for (int r = 0; r < 16; ++r) { o0[r] = 0.f; o1[r] = 0.f; }
    float l_run = 0.f;
    const int pi = (r32 & 0x13) | ((r32 & 4) << 1) | ((r32 & 8) >> 1);
    const int qmax_w = qb * 256 + w * 32 + 31, qmin_w = qb * 256 + w * 32;
    for (int kt = 0; kt < NT; ++kt) {
        if (kt + 1 < NT) PA_LOAD(kt + 1);
        if (kt * 64 <= qmax_w) {
            const LAS unsigned char* Kb = lds + (kt & 1) * PA_BUF; const LAS unsigned char* Vb = Kb + PA_KB;
            f32x16 p0, p1;
#pragma unroll
            for (int r = 0; r < 16; ++r) { p0[r] = 0.f; p1[r] = 0.f; }
#pragma unroll
            for (int d0 = 0; d0 < 6; ++d0) {
                const bf16x8 a0 = *(const LAS bf16x8*)(Kb + pi * PA_KP + (16 * d0 + 8 * hi) * 2);
                const bf16x8 a1 = *(const LAS bf16x8*)(Kb + (32 + pi) * PA_KP + (16 * d0 + 8 * hi) * 2);
                p0 = MFMA32(a0, qf[d0], p0); p1 = MFMA32(a1, qf[d0], p1);
            }
            if (kt * 64 + 63 > qmin_w) {
                const int kb = kt * 64 + 8 * hi;
#pragma unroll
                for (int r = 0; r < 16; ++r) { const int key = kb + 16 * (r >> 3) + (r & 7); if (key > qabs) p0[r] = -INFINITY; if (key + 32 > qabs) p1[r] = -INFINITY; }
            }
            float ls = 0.f;
#pragma unroll
            for (int r = 0; r < 16; ++r) { p0[r] = __builtin_amdgcn_exp2f(p0[r]); p1[r] = __builtin_amdgcn_exp2f(p1[r]); ls += p0[r] + p1[r]; }
            l_run += ls;
            bf16x8 pb[4];
#pragma unroll
            for (int ks = 0; ks < 2; ++ks) {
                v4u w0, w1;
                w0.x = pkbf(p0[8 * ks + 0], p0[8 * ks + 1]); w0.y = pkbf(p0[8 * ks + 2], p0[8 * ks + 3]); w0.z = pkbf(p0[8 * ks + 4], p0[8 * ks + 5]); w0.w = pkbf(p0[8 * ks + 6], p0[8 * ks + 7]);
                w1.x = pkbf(p1[8 * ks + 0], p1[8 * ks + 1]); w1.y = pkbf(p1[8 * ks + 2], p1[8 * ks + 3]); w1.z = pkbf(p1[8 * ks + 4], p1[8 * ks + 5]); w1.w = pkbf(p1[8 * ks + 6], p1[8 * ks + 7]);
                pb[ks] = __builtin_bit_cast(bf16x8, w0); pb[2 + ks] = __builtin_bit_cast(bf16x8, w1);
            }
#pragma unroll
            for (int ks = 0; ks < 4; ++ks) {
                const bf16x8 v0 = *(const LAS bf16x8*)(Vb + r32 * PA_VP + (16 * ks + 8 * hi) * 2);
                const bf16x8 v1 = *(const LAS bf16x8*)(Vb + (32 + r32) * PA_VP + (16 * ks + 8 * hi) * 2);
                o0 = MFMA32(v0, pb[ks], o0); o1 = MFMA32(v1, pb[ks], o1);
            }
        }
        if (kt + 1 < NT) PA_STORE((kt + 1) & 1);
        bg_step(p, bg, pg0, tid);
        __syncthreads();
    }
    const float lt = l_run + __shfl_xor(l_run, 32), il = 1.0f / lt;
    bf16* op = WSP(bf16, WS_O) + (size_t)qrow * D + h * VH;
#pragma unroll
    for (int g = 0; g < 4; ++g) {
        unsigned long long w0 = (unsigned long long)pkbf(o0[4 * g] * il, o0[4 * g + 1] * il) | ((unsigned long long)pkbf(o0[4 * g + 2] * il, o0[4 * g + 3] * il) << 32);
        unsigned long long w1 = (unsigned long long)pkbf(o1[4 * g] * il, o1[4 * g + 1] * il) | ((unsigned long long)pkbf(o1[4 * g + 2] * il, o1[4 * g + 3] * il) << 32);
        *(unsigned long long*)(op + 8 * g + 4 * hi) = w0; *(unsigned long long*)(op + 32 + 8 * g + 4 * hi) = w1;
    }
#undef PA_LOAD
#undef PA_STORE
}

constexpr int SA_CP = 528, SA_KP = 80, SA_PP = 144;
constexpr int SA_CB = 64 * SA_CP, SA_KB = 64 * SA_KP, SA_RB = 64 * 64, SA_BUF = SA_CB + SA_KB + SA_RB;
constexpr int SA_PT = 2 * SA_BUF, SA_SMX = SA_PT + 128 * SA_PP, SA_END = SA_SMX + 2 * 128 * 4;
__device__ __forceinline__ void sa_unit(const Params& p, LAS unsigned char* lds, int bs, int sp) {
    int tid_ = threadIdx.x; asm volatile("" : "+v"(tid_));
    const int tid = tid_, lane = tid & 63, w = __builtin_amdgcn_readfirstlane(tid >> 6), wr = w >> 2, wc = w & 3, l15 = lane & 15, fq = lane >> 4;
    bf16x8 qa[2][8], qrp[2];
#pragma unroll
    for (int n = 0; n < 2; ++n) {
        const int col = 32 * wc + 16 * n + l15;
#pragma unroll
        for (int ks = 0; ks < 8; ++ks) qa[n][ks] = *(const bf16x8*)(WSP(bf16, WS_QABS) + ((size_t)bs * 128 + col) * KVL + 32 * ks + 8 * fq);
        qrp[n] = *(const bf16x8*)(WSP(bf16, WS_Q) + (size_t)(MP + bs * DSEQ + (col & 7)) * (NH * QKD) + (col >> 3) * QKD + QKN + 8 * fq);
    }
    f32x4 ctx[8][2];
#pragma unroll
    for (int cb = 0; cb < 8; ++cb) { ctx[cb][0] = (f32x4){0.f, 0.f, 0.f, 0.f}; ctx[cb][1] = (f32x4){0.f, 0.f, 0.f, 0.f}; }
    float m_run[2] = {0.f, 0.f}, l_run[2] = {0.f, 0.f};
    const int NTC = (PAST / NSPLIT) / 64, NT = NTC + ((sp == NSPLIT - 1) ? 1 : 0);
    const size_t row0 = (size_t)bs * PAST + (size_t)sp * (PAST / NSPLIT);
    v4u rc[4], rx; bool ld8 = false;
    const int t5 = tid & 255, r5 = t5 >> 2, c5 = t5 & 3, rC = tid >> 3, cC = tid & 7;
    const int r8a = tid >> 4, c8 = tid & 15;
#define SA_LOAD(kt) do { const bool nw_ = (kt) >= NTC; const size_t rb_ = nw_ ? (size_t)MP + bs * DSEQ : row0 + (size_t)(kt) * 64; ld8 = !nw_; \
        const unsigned char* xs_ = (tid < 256) ? (const unsigned char*)((nw_ ? WSP(bf16, WS_KRB) : WSP(bf16, WS_KRB16)) + rb_ * QKR) + r5 * 64 + c5 * 16 \
                                               : (const unsigned char*)((nw_ ? WSP(float, WS_RSN) + (size_t)bs * DSEQ * 16 : WSP(float, WS_RS) + rb_ * 16)) + r5 * 64 + c5 * 16; \
        if (!nw_) { const unsigned char* s8_ = p.ws + WS_CB8 + rb_ * KVL + (size_t)tid * 16; rc[0] = *(const v4u*)s8_; rc[1] = *(const v4u*)(s8_ + 8192); } \
        else if (rC < DSEQ) { const v4u* s4_ = (const v4u*)(WSP(bf16, WS_CKVB) + (rb_ + rC) * KVL + cC * 32); rc[0] = s4_[0]; rc[1] = s4_[1]; rc[2] = s4_[2]; rc[3] = s4_[3]; } \
        else { rc[0] = (v4u){0u, 0u, 0u, 0u}; rc[1] = rc[0]; rc[2] = rc[0]; rc[3] = rc[0]; } \
        if (!nw_ || r5 < DSEQ) rx = *(const v4u*)xs_; else rx = (v4u){0u, 0u, 0u, 0u}; } while (0)
#define SA_CVT8(w_) (pkbf(__builtin_amdgcn_cvt_pk_f32_fp8((int)(w_), false)[0], __builtin_amdgcn_cvt_pk_f32_fp8((int)(w_), false)[1]))
#define SA_CVT8H(w_) (pkbf(__builtin_amdgcn_cvt_pk_f32_fp8((int)(w_), true)[0], __builtin_amdgcn_cvt_pk_f32_fp8((int)(w_), true)[1]))
#define SA_STORE(buf) do { LAS unsigned char* b_ = lds + (buf) * SA_BUF; \
        if (ld8) { const v4u a_ = rc[0], c_ = rc[1]; LAS v4u* da_ = (LAS v4u*)(b_ + r8a * SA_CP + c8 * 32); LAS v4u* dc_ = (LAS v4u*)(b_ + (32 + r8a) * SA_CP + c8 * 32); \
            da_[0] = (v4u){SA_CVT8(a_.x), SA_CVT8H(a_.x), SA_CVT8(a_.y), SA_CVT8H(a_.y)}; da_[1] = (v4u){SA_CVT8(a_.z), SA_CVT8H(a_.z), SA_CVT8(a_.w), SA_CVT8H(a_.w)}; \
            dc_[0] = (v4u){SA_CVT8(c_.x), SA_CVT8H(c_.x), SA_CVT8(c_.y), SA_CVT8H(c_.y)}; dc_[1] = (v4u){SA_CVT8(c_.z), SA_CVT8H(c_.z), SA_CVT8(c_.w), SA_CVT8H(c_.w)}; } \
        else { LAS v4u* d4_ = (LAS v4u*)(b_ + rC * SA_CP + cC * 64); d4_[0] = rc[0]; d4_[1] = rc[1]; d4_[2] = rc[2]; d4_[3] = rc[3]; } \
        *(LAS v4u*)(b_ + SA_CB + ((tid < 256) ? 0 : SA_KB) + r5 * ((tid < 256) ? SA_KP : 64) + c5 * 16) = rx; } while (0)
    SA_LOAD(0);
    __syncthreads();
    SA_STORE(0);
    __syncthreads();
    LAS unsigned char* Pt = lds + SA_PT; LAS float* SMX = (LAS float*)(lds + SA_SMX);
    for (int kt = 0; kt < NT; ++kt) {
        if (kt + 1 < NT) SA_LOAD(kt + 1);
        const LAS unsigned char* Cb = lds + (kt & 1) * SA_BUF; const LAS unsigned char* Kb = Cb + SA_CB; const LAS unsigned char* Rb = Kb + SA_KB;
        f32x4 sn[2][2];
#pragma unroll
        for (int m = 0; m < 2; ++m)
#pragma unroll
            for (int n = 0; n < 2; ++n) sn[m][n] = (f32x4){0.f, 0.f, 0.f, 0.f};
#pragma unroll
        for (int ks = 0; ks < 8; ++ks) {
            bf16x8 a[2];
#pragma unroll
            for (int m = 0; m < 2; ++m) a[m] = *(const LAS bf16x8*)(Cb + (32 * wr + 16 * m + l15) * SA_CP + (32 * ks + 8 * fq) * 2);
#pragma unroll
            for (int m = 0; m < 2; ++m)
#pragma unroll
                for (int n = 0; n < 2; ++n) sn[m][n] = MFMA16(a[m], qa[n][ks], sn[m][n]);
            if (ks & 1) __builtin_amdgcn_sched_barrier(0);
        }
#pragma unroll
        for (int m = 0; m < 2; ++m)
#pragma unroll
            for (int n = 0; n < 2; ++n)
#pragma unroll
                for (int j = 0; j < 4; ++j) sn[m][n][j] *= *(const LAS float*)(Rb + (32 * wr + 16 * m + 4 * fq + j) * 64 + (4 * wc + 2 * n + (l15 >> 3)) * 4);
        {
            bf16x8 a[2];
#pragma unroll
            for (int m = 0; m < 2; ++m) a[m] = *(const LAS bf16x8*)(Kb + (32 * wr + 16 * m + l15) * SA_KP + fq * 16);
#pragma unroll
            for (int m = 0; m < 2; ++m)
#pragma unroll
                for (int n = 0; n < 2; ++n) sn[m][n] = MFMA16(a[m], qrp[n], sn[m][n]);
        }
        const bool newtile = (kt >= NTC);
#pragma unroll
        for (int n = 0; n < 2; ++n) { const int col = 32 * wc + 16 * n + l15; float ls = 0.f;
#pragma unroll
            for (int m = 0; m < 2; ++m) { float e[4];
#pragma unroll
                for (int j = 0; j < 4; ++j) { const int key = 32 * wr + 16 * m + 4 * fq + j; float sv = sn[m][n][j];
                    if (newtile && key > (l15 & 7)) sv = -INFINITY;
                    e[j] = __builtin_amdgcn_exp2f(sv); ls += e[j]; }
                *(LAS unsigned long long*)(Pt + col * SA_PP + (32 * wr + 16 * m + 4 * fq) * 2) = (unsigned long long)pkbf(e[0], e[1]) | ((unsigned long long)pkbf(e[2], e[3]) << 32); }
            l_run[n] += ls; }
        __syncthreads();
#pragma unroll
        for (int ks = 0; ks < 2; ++ks) {
            bf16x8 pb[2];
#pragma unroll
            for (int n = 0; n < 2; ++n) pb[n] = *(const LAS bf16x8*)(Pt + (32 * wc + 16 * n + l15) * SA_PP + (32 * ks + 8 * fq) * 2);
            const LAS unsigned char* tb = Cb + (32 * ks + 8 * fq + (l15 >> 2)) * SA_CP + (128 * wr + 4 * (l15 & 3)) * 2;
#pragma unroll
            for (int cb = 0; cb < 8; ++cb) {
                const s16x4 t0 = __builtin_bit_cast(s16x4, __builtin_amdgcn_ds_read_tr16_b64_v4i16((LAS s16x4*)(tb + cb * 32)));
                const s16x4 t1 = __builtin_bit_cast(s16x4, __builtin_amdgcn_ds_read_tr16_b64_v4i16((LAS s16x4*)(tb + 4 * SA_CP + cb * 32)));
                const bf16x8 at = (bf16x8){t0[0], t0[1], t0[2], t0[3], t1[0], t1[1], t1[2], t1[3]};
                ctx[cb][0] = MFMA16(at, pb[0], ctx[cb][0]); ctx[cb][1] = MFMA16(at, pb[1], ctx[cb][1]);
                if (cb & 1) __builtin_amdgcn_sched_barrier(0);
            }
        }
        if (kt + 1 < NT) SA_STORE((kt + 1) & 1);
        __syncthreads();
    }
#pragma unroll
    for (int n = 0; n < 2; ++n) { const int col = 32 * wc + 16 * n + l15; float l = l_run[n]; l += __shfl_xor(l, 16); l += __shfl_xor(l, 32);
        if (fq == 0) { WSP(float, WS_MLL)[(((size_t)bs * NSPLIT + sp) * 2 + wr) * 128 + col] = l; if (wr == 0) WSP(float, WS_MLM)[((size_t)bs * NSPLIT + sp) * 128 + col] = m_run[n]; }
#pragma unroll
        for (int cb = 0; cb < 8; ++cb) *(f32x4*)(WSP(float, WS_CTXP) + (((size_t)bs * NSPLIT + sp) * 128 + col) * KVL + 128 * wr + 16 * cb + 4 * fq) = ctx[cb][n]; }
#undef SA_LOAD
#undef SA_STORE
#undef SA_CVT8
#undef SA_CVT8H
}

#ifndef DBG_SA_ORACLE
#define DBG_SA_ORACLE 0
#endif
#ifndef DBG_SA_TOL
#define DBG_SA_TOL 0.10f
#endif
#if DBG_SA_ORACLE
__device__ __forceinline__ void dbg_sa_oracle(const Params& p, LAS unsigned char* lds) {
    const int tid = threadIdx.x;
    LAS float* red = (LAS float*)lds;
    const int seqs[3] = {0, 77, 127};
    for (int it2 = blockIdx.x; it2 < 3 * NH * 2 * 2; it2 += gridDim.x) {
        const int it = it2 >> 1, half = it2 & 1;
        const int bs = (it / (NH * 2)) == 0 ? 0 : ((it / (NH * 2)) == 1 ? 77 : 127), h = (it / 2) % NH, q = (it & 1) ? 7 : 0;
        (void)seqs;
        const bf16* qrow = WSP(bf16, WS_Q) + (size_t)(MP + bs * DSEQ + q) * (NH * QKD) + h * QKD;
        LAS float* qs = red + 512 * 65;
        __syncthreads();
        if (tid < 96) qs[tid] = __uint_as_float((unsigned)qrow[tid] << 16) * (tid < 64 ? p.in[I_GKN][tid] : 1.0f);
        __syncthreads();
        float acc[32]; float lsum = 0.f;
#pragma unroll
        for (int d = 0; d < 32; ++d) acc[d] = 0.f;
        const int L = PAST + q + 1;
        for (int l = tid; l < L; l += NTHR) {
            const float* crow; const float* krrow;
            if (l < PAST) { const int pg = ((const int*)p.in[I_PT])[bs * NPAGES + (l >> 7)]; crow = p.in[I_CCKV] + ((size_t)pg * PAGE + (l & 127)) * KVL; krrow = p.in[I_CKR] + ((size_t)pg * PAGE + (l & 127)) * QKR; }
            else { crow = p.out + OFF_CKVS + (size_t)(bs * DSEQ + (l - PAST)) * KVL; krrow = p.out + OFF_KRS + (size_t)(bs * DSEQ + (l - PAST)) * QKR; }
            float ss = 0.f, sn = 0.f;
#pragma nounroll
            for (int dh = 0; dh < 2; ++dh) {
                float kraw[32];
#pragma unroll
                for (int d = 0; d < 32; ++d) kraw[d] = 0.f;
#pragma nounroll
                for (int c = 0; c < KVL; ++c) { const float cv = crow[c]; const float* w = p.in[I_WUK] + ((size_t)c * NH + h) * QKN + dh * 32;
#pragma unroll
                    for (int d = 0; d < 32; ++d) kraw[d] += cv * w[d]; }
#pragma unroll
                for (int d = 0; d < 32; ++d) { ss += kraw[d] * kraw[d]; sn += qs[dh * 32 + d] * kraw[d]; }
            }
            const float rs = 1.0f / sqrtf(ss * (1.0f / 64.0f) + EPS);
            float s = sn * rs;
#pragma nounroll
            for (int r = 0; r < QKR; ++r) s += qs[QKN + r] * krrow[r];
            const float pw = exp2f(s); lsum += pw;
#pragma nounroll
            for (int c = 0; c < KVL; ++c) { const float cv = crow[c] * pw; const float* w = p.in[I_WUV] + ((size_t)c * NH + h) * VH + half * 32;
#pragma unroll
                for (int d = 0; d < 32; ++d) acc[d] += cv * w[d]; }
        }
        __syncthreads();
#pragma unroll
        for (int d = 0; d < 32; ++d) red[tid * 65 + d] = acc[d];
        red[tid * 65 + 64] = lsum;
        __syncthreads();
        float tsum = 0.f;
        if (tid < 32 || tid == 64) { for (int k = 0; k < NTHR; ++k) tsum += red[k * 65 + tid]; }
        __syncthreads();
        if (tid < 32 || tid == 64) red[tid] = tsum;
        __syncthreads();
        if (tid == 0) { const float lt = red[64]; float e2 = 0.f, r2 = 0.f;
            for (int d = 0; d < 32; ++d) { const float ref = red[d] / lt; const float got = __uint_as_float((unsigned)WSP(bf16, WS_O)[(size_t)(MP + bs * DSEQ + q) * D + h * VH + half * 32 + d] << 16); e2 += (got - ref) * (got - ref); r2 += ref * ref; }
            if (!(e2 <= DBG_SA_TOL * DBG_SA_TOL * r2)) p.out[OFF_YS + it2] = __builtin_nanf(""); }
        __syncthreads();
    }
}
#endif

#ifndef G1S_PRIO
#define G1S_PRIO 1
#endif
__device__ __forceinline__ void g1_stream(const Params& p, LAS unsigned char* lds, int bid, int wave, int lane) {
#ifndef G1S_SROWS
#define G1S_SROWS 128
#endif
    constexpr int SROWS = G1S_SROWS, SBYTES = SROWS * KVL, ROWS = PAST / NSPLIT, NST = ROWS / SROWS, NSLOT = 131072 / SBYTES, LOOK = NSLOT - 1, NPC = SROWS / 32, NRB = SROWS / 16;
    static_assert((NSLOT & (NSLOT - 1)) == 0 && NSLOT >= 2 && NST > LOOK && (NPC % 4 == 0 || NPC == 4), "g1_stream ring");
    constexpr int VMW = LOOK * NRB + (LOOK - 1) * NPC;
    const unsigned char* A = p.ws + WS_CB8 + (size_t)bid * ROWS * KVL;
    float* RS = WSP(float, WS_RS) + (size_t)bid * ROWS * 16 + 2 * wave + ((lane >> 4) & 1);
    const int l15 = lane & 15, kq = lane >> 4;
    pg8::v8i32 Bf[8][2];
#pragma unroll
    for (int cb = 0; cb < 8; ++cb) { const int h = 2 * wave + (cb >> 2), nrow = 256 * (h >> 2) + 128 * ((cb >> 1) & 1) + 32 * (h & 3) + 16 * (cb & 1) + l15;
#pragma unroll
        for (int kb = 0; kb < 2; ++kb) Bf[cb][kb] = *(const pg8::v8i32*)(p.ws + WS_WK8 + (size_t)nrow * KVL + kb * 128 + kq * 32); }
    unsigned voff[4];
#pragma unroll
    for (int t = 0; t < 4; ++t) { const int r15 = 4 * t + (lane >> 4); voff[t] = (unsigned)(((SROWS / 8) * wave + r15) * KVL + (((lane & 15) ^ r15) << 4)); }
    const unsigned ldsb = (unsigned)(unsigned long long)lds + (unsigned)(wave * (SROWS / 8) * KVL);
#define G1S_STAGE(st_, slot_) do { _Pragma("unroll") for (int t_ = 0; t_ < NPC; ++t_) pg8::glds16s((const void*)(A + (t_ >> 2) * 16 * KVL), voff[t_ & 3] + (unsigned)(st_) * SBYTES, ldsb + (unsigned)(slot_) * SBYTES + t_ * 4 * KVL); } while (0)
#pragma unroll
    for (int s0 = 0; s0 < LOOK; ++s0) G1S_STAGE(s0, s0);
    const unsigned fo = (unsigned)(l15 * KVL + (((2 * kq) ^ l15) << 4));
    asm volatile("s_waitcnt vmcnt(0)" ::: "memory");
#if G1S_PRIO
    if (wave < 4) __builtin_amdgcn_s_setprio(1);
#endif
#ifndef G1S_SC
#define G1S_SC 0
#endif
#ifndef G1S_XMFMA
#define G1S_XMFMA 0
#endif
    f32x4 dum[4] = {{0.f, 0.f, 0.f, 0.f}, {0.f, 0.f, 0.f, 0.f}, {0.f, 0.f, 0.f, 0.f}, {0.f, 0.f, 0.f, 0.f}};
    f32x4 accA[8], accB[8];
#pragma unroll
    for (int cb = 0; cb < 8; ++cb) accB[cb] = (f32x4){0.f, 0.f, 0.f, 0.f};
#define G1S_RD1(dst_, rb_, kb_, hf_) do { const unsigned o_ = ((fo ^ (unsigned)((kb_) * 128)) ^ (unsigned)((hf_) * 16)) + (rb_) * 16 * KVL; const pg8::i32x4 t_ = *(LAS const pg8::i32x4*)(sb + o_); \
        dst_[kb_][(hf_) * 4 + 0] = t_[0]; dst_[kb_][(hf_) * 4 + 1] = t_[1]; dst_[kb_][(hf_) * 4 + 2] = t_[2]; dst_[kb_][(hf_) * 4 + 3] = t_[3]; } while (0)
#define G1S_SQ(s2_, v_) do { const pg8::f32x2 lo_ = (pg8::f32x2){v_[0], v_[1]}, hi_ = (pg8::f32x2){v_[2], v_[3]}; s2_ = __builtin_elementwise_fma(lo_, lo_, s2_); s2_ = __builtin_elementwise_fma(hi_, hi_, s2_); } while (0)
#define G1S_BLK(accN, aN, accP, prow_, RDN, aX, rbx_) do { pg8::f32x2 sa_ = (pg8::f32x2){0.f, 0.f}, sb2_ = (pg8::f32x2){0.f, 0.f}; float r0_ = 0.f, r1_ = 0.f; \
        _Pragma("unroll") for (int cb_ = 0; cb_ < 8; ++cb_) { \
            accN[cb_] = __builtin_amdgcn_mfma_scale_f32_16x16x128_f8f6f4(Bf[cb_][0], aN[0], (f32x4){0.f, 0.f, 0.f, 0.f}, 0, 0, 0, G1S_SC, 0, G1S_SC); \
            if (G1S_XMFMA) dum[cb_ & 3] = __builtin_amdgcn_mfma_scale_f32_16x16x128_f8f6f4(Bf[cb_][1], aN[0], dum[cb_ & 3], 0, 0, 0, G1S_SC, 0, G1S_SC); \
            if (cb_ < 4) G1S_SQ(sa_, accP[cb_]); else G1S_SQ(sb2_, accP[cb_]); \
            if (RDN && cb_ < 4) G1S_RD1(aX, rbx_, cb_ >> 1, cb_ & 1); \
            __builtin_amdgcn_sched_barrier(0); } \
        _Pragma("unroll") for (int cb_ = 0; cb_ < 8; ++cb_) { \
            accN[cb_] = __builtin_amdgcn_mfma_scale_f32_16x16x128_f8f6f4(Bf[cb_][1], aN[1], accN[cb_], 0, 0, 0, G1S_SC, 0, G1S_SC); \
            if (cb_ == 0) { const auto x_ = __builtin_amdgcn_permlane16_swap(__float_as_uint(sa_[0] + sa_[1]), __float_as_uint(sb2_[0] + sb2_[1]), false, false); r0_ = __uint_as_float(x_[0]) + __uint_as_float(x_[1]); } \
            if (cb_ == 1) { const auto y_ = __builtin_amdgcn_permlane32_swap(__float_as_uint(r0_), __float_as_uint(r0_), false, false); r1_ = __uint_as_float(y_[0]) + __uint_as_float(y_[1]); } \
            if (cb_ == 2) r1_ = __builtin_amdgcn_rsqf(r1_ * (1.0f / (QKN * 256.0f)) + EPS); \
            if (cb_ == 3) RS[(size_t)(prow_) * 16] = r1_; \
            __builtin_amdgcn_sched_barrier(0); } } while (0)
#pragma nounroll
    for (int st = 0; st < NST; ++st) {
        if (st) asm volatile("s_waitcnt vmcnt(%0)" :: "n"(VMW) : "memory");
        asm volatile("s_waitcnt lgkmcnt(0)" ::: "memory");
        __builtin_amdgcn_s_barrier();
        { const int nx = st + LOOK < NST ? st + LOOK : NST - 1; G1S_STAGE(nx, (st + LOOK) & (NSLOT - 1)); }
        LAS const unsigned char* sb = lds + (st & (NSLOT - 1)) * SBYTES;
        const int prow = ((st * SROWS - 16) & (ROWS - 1)) + l15;
        pg8::v8i32 Ac[2], An[2];
        G1S_RD1(Ac, 0, 0, 0); G1S_RD1(Ac, 0, 0, 1); G1S_RD1(Ac, 0, 1, 0); G1S_RD1(Ac, 0, 1, 1);
        __builtin_amdgcn_sched_barrier(0);
#pragma unroll
        for (int rb = 0; rb < NRB; rb += 2) {
            G1S_BLK(accA, Ac, accB, (rb ? st * SROWS + (rb - 1) * 16 + l15 : prow), true, An, rb + 1);
            G1S_BLK(accB, An, accA, (st * SROWS + rb * 16 + l15), (rb + 2 < NRB), Ac, rb + 2);
        }
    }
    { pg8::f32x2 sa = (pg8::f32x2){0.f, 0.f}, sb2 = (pg8::f32x2){0.f, 0.f};
#pragma unroll
      for (int cb = 0; cb < 4; ++cb) { G1S_SQ(sa, accB[cb]); G1S_SQ(sb2, accB[4 + cb]); }
      const auto x = __builtin_amdgcn_permlane16_swap(__float_as_uint(sa[0] + sa[1]), __float_as_uint(sb2[0] + sb2[1]), false, false); const float w = __uint_as_float(x[0]) + __uint_as_float(x[1]);
      const auto y = __builtin_amdgcn_permlane32_swap(__float_as_uint(w), __float_as_uint(w), false, false);
      RS[(size_t)(ROWS - 16 + l15) * 16] = __builtin_amdgcn_rsqf((__uint_as_float(y[0]) + __uint_as_float(y[1])) * (1.0f / (QKN * 256.0f)) + EPS); }
    if (G1S_XMFMA) asm volatile("" :: "v"(dum[0]), "v"(dum[1]), "v"(dum[2]), "v"(dum[3]));
#undef G1S_RD1
#undef G1S_SQ
#undef G1S_BLK
#undef G1S_STAGE
#if G1S_PRIO
    __builtin_amdgcn_s_setprio(0);
#endif
}

#ifndef DBG_F8_ORACLE
#define DBG_F8_ORACLE 0
#endif
#ifndef DBG_SA_ORACLE
#define DBG_SA_ORACLE 0
#endif
#ifndef DBG_SA_TOL
#define DBG_SA_TOL 0.10f
#endif
#ifndef DBG_TWICE
#define DBG_TWICE 0
#endif
#ifndef DBG_NANPOISON
#define DBG_NANPOISON 0
#endif
#ifndef MK_PER_PHASE
#define MK_PER_PHASE 0
#endif
constexpr int NPH = 21;
constexpr int NPA = 128;
constexpr int RING_BYTES = 131072, MISC_OFF = RING_BYTES + 320, XLDS_OFF = RING_BYTES + 4096, LDS_BYTES = 147456;
constexpr int CW_BAR = 4096;
static_assert((CW_BAR + XCD_BAR_WORDS) * 4 <= (int)CTL_ZERO_BYTES && SA_END <= RING_BYTES && 2 * PA_BUF <= RING_BYTES && pg8::STAGE_BYTES <= RING_BYTES, "LDS / CTL maps");

__global__ void __launch_bounds__(NTHR, 2) fwd_kernel(Params p) {
    extern __shared__ __attribute__((aligned(16))) unsigned char lds_raw[];
    LAS unsigned char* lds = (LAS unsigned char*)lds_raw;
    const int tid = threadIdx.x, lane = tid & 63, wave = __builtin_amdgcn_readfirstlane(tid >> 6);
    volatile LAS unsigned* MISC = (volatile LAS unsigned*)(lds + MISC_OFF);
    for (int u = tid; u < (LDS_BYTES - RING_BYTES) / 4; u += NTHR) ((LAS unsigned*)(lds + RING_BYTES))[u] = 0u;
    __syncthreads();
    const int lo = p.ph_lo, hi = p.ph_hi;
    XcdBarrier bar; bar.bar = (unsigned*)p.ws + CW_BAR; bar.x = 0; bar.st = nullptr;
    if (hi - lo > 1) bar = xcd_barrier_post((unsigned*)p.ws + CW_BAR, MISC + 8);
#ifndef SUBMASK
#define SUBMASK 0xFFu
#endif
#ifndef PH_MASK
#define PH_MASK 0x1FFFFFu
#endif
#define IN(k) (((PH_MASK >> (k)) & 1u) && lo <= (k) && (k) < hi)
#define SEAM(k) do { if (IN(k) && IN((k) + 1)) xcd_barrier(bar); } while (0)
    const int G = gridDim.x, bid = blockIdx.x;
#if DBG_NANPOISON
    if (lo == 0) { const uint4 ff = {0xFFFFFFFFu, 0xFFFFFFFFu, 0xFFFFFFFFu, 0xFFFFFFFFu};
        const size_t r0[4] = {WS_QABS, WS_KRB16, WS_CB8, WS_RSN}, r1[4] = {WS_CB16, WS_O, WS_RS8, WS_QABS};
        for (int r = 0; r < 4; ++r) { uint4* d = (uint4*)(p.ws + r0[r]); const size_t n = (r1[r] - r0[r]) / 16; for (size_t i = (size_t)bid * NTHR + tid; i < n; i += (size_t)G * NTHR) d[i] = ff; } }
#endif
    using pg8::Gemm; using pg8::StaticOrder; using pg8::gemm_phase;

    if (IN(0)) { p0_prologue(p, lds, wave, lane); }
    SEAM(0);
    if (IN(1)) { Gemm g{WSP(bf16, WS_XN), WSP(bf16, WS_WD), D, D, D, 0}; StaticOrder S; S.init(MP, 1024, G, bid);
        pg8::EpiDown E{WSP(bf16, WS_CQ), WSP(float, WS_CKVRAW), WSP(float, WS_KRRAW), WSP(float, WS_SSQ1)};
        gemm_phase<pg8::EpiDown, StaticOrder, true, true, true>(lds, g, S, E, lds + XLDS_OFF, MP); }
    SEAM(1);
    if (IN(2)) { thin_ckv_krope(p, wave, lane);
        Gemm g{WSP(bf16, WS_CQ), WSP(bf16, WS_WUQ), QL, QL, QL, 0}; StaticOrder S; S.init(M, NH * QKD, G, bid);
        pg8::EpiQ E{WSP(bf16, WS_Q), WSP(float, WS_SSQ1), p.in[I_GQN], p.in[I_GQR], WSP(float, WS_RCOS), WSP(float, WS_RSIN)};
        gemm_phase<pg8::EpiQ, StaticOrder, true, true>(lds, g, S, E); }
    SEAM(2);
    if (IN(3)) {
        if (SUBMASK & 1u) { Gemm g{WSP(bf16, WS_CKVB), WSP(bf16, WS_WK), KVL, KVL, KVL, 0}; StaticOrder S; S.init(M, NH * QKN, G, bid);
          pg8::EpiK E{WSP(bf16, WS_K96), WSP(bf16, WS_KRB), p.in[I_GKN], WSP(float, WS_RSN)};
          gemm_phase<pg8::EpiK, StaticOrder, true, true>(lds, g, S, E); }
        if (SUBMASK & 2u) { Gemm g{WSP(bf16, WS_WV), WSP(bf16, WS_CKVB), KVL, KVL, KVL, 0}; StaticOrder S; S.init(NH * VH, MP, G, bid);
          pg8::EpiVT E{WSP(bf16, WS_VT)};
          gemm_phase<pg8::EpiVT, StaticOrder, true, true>(lds, g, S, E); }
        if (SUBMASK & 4u) thin_qabs(p, wave, lane);
    }
    SEAM(3);
    if (IN(4)) {
        const int PPW = (NSEQ * NPAGES + G - 1) / G, pg0 = bid * PPW;
        GatherBg bg; bg_init(bg, 2 * PPW);
        for (int pid = bid; pid < NBATCH * NH * 4; pid += G) { const int bh = pid >> 2, s = pid & 3; pa_unit(p, lds, bh >> 4, bh & 15, s, bg, pg0); pa_unit(p, lds, bh >> 4, bh & 15, 7 - s, bg, pg0); }
        while (bg.pend || bg.it < bg.n) bg_step(p, bg, pg0, (int)threadIdx.x);
    }
    const bool chain = (G == NSEQ * NSPLIT) && (MK_PER_PHASE ? true : (IN(4) && IN(5) && IN(6)));
    if (chain) { VM_WAIT(); __syncthreads(); } else SEAM(4);
    if (IN(5)) {
        Gemm g{(const bf16*)(p.ws + WS_CB8), (const bf16*)(p.ws + WS_WK8), KVL / 2, KVL / 2, KVL / 2, 0};
        pg8::EpiRS E{WSP(float, WS_RS), 1.0f / (QKN * 256.0f)};
#ifndef G1_STREAM
#define G1_STREAM 1
#endif
        if (chain) {
#if G1_STREAM
            g1_stream(p, lds, bid, wave, lane);
#else
            pg8::LocalOrder S{bid * (PAST / NSPLIT / 256), (NH * QKN) / 256, (PAST / NSPLIT / 256) * ((NH * QKN) / 256)};
            gemm_phase<pg8::EpiRS, pg8::LocalOrder, true, true, false, true, true>(lds, g, S, E);
#endif
        }
        else { StaticOrder S; S.init(NSEQ * PAST, NH * QKN, G, bid);
            gemm_phase<pg8::EpiRS, StaticOrder, true, true, false, true, true>(lds, g, S, E); } }
    if (chain) { VM_WAIT(); __syncthreads(); } else SEAM(5);
    if (IN(6)) { for (int u = bid; u < NSEQ * NSPLIT; u += G) sa_unit(p, lds, u / NSPLIT, u % NSPLIT); }
    SEAM(6);
    if (IN(7)) { thin_combine_uv(p, lds, wave, lane); }
    SEAM(7);
    if (IN(8)) { Gemm g{WSP(bf16, WS_O), WSP(bf16, WS_WO), D, D, D, 0}; StaticOrder S; S.init(MP, D, G, bid);
        pg8::EpiRes<false, false> E{p.in[I_XP], p.in[I_XS], nullptr, nullptr, WSP(bf16, WS_X1B), WSP(float, WS_SS1)};
        gemm_phase<pg8::EpiRes<false, false>, StaticOrder, true, true, true>(lds, g, S, E, lds + XLDS_OFF, MP); }
    SEAM(8);
    if (IN(9)) { Gemm g{WSP(bf16, WS_X1B), WSP(bf16, WS_WUP), D, D, D, 0}; StaticOrder S; S.init(MP, 2 * DFF, G, bid);
        pg8::EpiUp E{WSP(float, WS_SS1), WSP(bf16, WS_HB), WSP(float, WS_HEADG), WSP(float, WS_HEADU), WSP(float, WS_TAILG), p.in[I_FCW], p.in[I_FCB], p.in[I_SFC], p.out + OFF_FCP, p.out + OFF_FCS};
        gemm_phase<pg8::EpiUp, StaticOrder, true, true, true>(lds, g, S, E, lds + XLDS_OFF, MP); }
    do { if (IN(9) && IN(11)) xcd_barrier(bar); } while (0);
    if (IN(11)) { Gemm g{WSP(bf16, WS_HB), WSP(bf16, WS_WDN), DFF, DFF, DFF, 0}; StaticOrder S; S.init(MP, D, G, bid);
        { pg8::Unit u0; for (int i = 0; S.next(i, u0); ++i) thin_ffn_fix(p, 0, 4 * u0.pm, 4); VM_WAIT(); __syncthreads(); }
        pg8::EpiRes<true, false> E{WSP(bf16, WS_X1B), WSP(bf16, WS_X1B) + (size_t)MP * D, nullptr, nullptr, WSP(bf16, WS_X2B), WSP(float, WS_SS2)};
        gemm_phase<pg8::EpiRes<true, false>, StaticOrder, true, true, true>(lds, g, S, E, lds + XLDS_OFF, MP); }
    SEAM(11);
    if (IN(12)) { Gemm g{WSP(bf16, WS_X2B), WSP(bf16, WS_WIN), D, D, D, 0}; StaticOrder S; S.init(MP, 2 * D, G, bid);
        pg8::EpiIn E{WSP(float, WS_SS2), WSP(bf16, WS_XC), WSP(bf16, WS_GATE), WSP(float, WS_HEADX), WSP(float, WS_TAILX), p.in[I_RCW], p.in[I_RCB], p.in[I_SLC], p.out + OFF_LCP, p.out + OFF_LCS};
        gemm_phase<pg8::EpiIn, StaticOrder, true, true, true>(lds, g, S, E, lds + XLDS_OFF, MP); }
    do { if (IN(12) && IN(14)) xcd_barrier(bar); } while (0);
    if (IN(14)) { Gemm g{WSP(bf16, WS_XC), WSP(bf16, WS_WAI), D, LB, LB, LB}; StaticOrder S; S.init(M, NLB * 256, G, bid);
        { pg8::Unit u0; for (int i = 0; S.next(i, u0); ++i) if (u0.pm < MP / 256) thin_rec_fix(p, 4 * u0.pm, 4, 128 * u0.pn); VM_WAIT(); __syncthreads(); }
        pg8::EpiLru E{WSP(bf16, WS_XC), p.in[I_BA], p.in[I_BI], WSP(float, WS_SP8), WSP(float, WS_LA), WSP(float, WS_BX)};
        gemm_phase<pg8::EpiLru, StaticOrder, true, true, false, false, true>(lds, g, S, E); }
    SEAM(14);
    if (IN(15)) { thin_scan1(p); }
    SEAM(15);
    if (IN(16)) { thin_scan2(p); }
    SEAM(16);
    if (IN(17)) { Gemm g{WSP(bf16, WS_Y), WSP(bf16, WS_WOUT), D, D, D, 0}; StaticOrder S; S.init(MP, D, G, bid);
        pg8::EpiRes<true, false> E{WSP(bf16, WS_X2B), WSP(bf16, WS_X2B) + (size_t)MP * D, nullptr, nullptr, WSP(bf16, WS_X3B), WSP(float, WS_SS3)};
        gemm_phase<pg8::EpiRes<true, false>, StaticOrder, true, true, true>(lds, g, S, E, lds + XLDS_OFF, MP); }
    SEAM(17);
    if (IN(18)) { Gemm g{WSP(bf16, WS_X3B), WSP(bf16, WS_WUP) + (size_t)2 * DFF * D, D, D, D, 0}; StaticOrder S; S.init(MP, 2 * DFF, G, bid);
        pg8::EpiUp E{WSP(float, WS_SS3), WSP(bf16, WS_HB), WSP(float, WS_HEADG), WSP(float, WS_HEADU), WSP(float, WS_TAILG), p.in[I_FCW] + (size_t)3 * DFF, p.in[I_FCB] + DFF, p.in[I_SFC] + (size_t)NSEQ * 2 * DFF, p.out + OFF_FCP + (size_t)NBATCH * 2 * DFF, p.out + OFF_FCS + (size_t)NSEQ * 2 * DFF};
        gemm_phase<pg8::EpiUp, StaticOrder, true, true, true>(lds, g, S, E, lds + XLDS_OFF, MP); }
    do { if (IN(18) && IN(20)) xcd_barrier(bar); } while (0);
    if (IN(20)) { Gemm g{WSP(bf16, WS_HB), WSP(bf16, WS_WDN) + (size_t)D * DFF, DFF, DFF, DFF, 0}; StaticOrder S; S.init(MP, D, G, bid);
        { pg8::Unit u0; for (int i = 0; S.next(i, u0); ++i) thin_ffn_fix(p, 1, 4 * u0.pm, 4); VM_WAIT(); __syncthreads(); }
        pg8::EpiRes<true, true> E{WSP(bf16, WS_X3B), WSP(bf16, WS_X3B) + (size_t)MP * D, p.out + OFF_YP, p.out + OFF_YS, nullptr, nullptr};
        gemm_phase<pg8::EpiRes<true, true>, StaticOrder, true, true, true>(lds, g, S, E, lds + XLDS_OFF, MP); }
#if DBG_SA_ORACLE
    if (hi == NPH) { if (hi - lo > 1) xcd_barrier(bar); dbg_sa_oracle(p, lds); }
#endif
#if DBG_F8_ORACLE
    if (hi == NPH) {
        if (hi - lo > 1) xcd_barrier(bar);
        const float* r1 = WSP(float, WS_RS); const float* r2 = WSP(float, WS_RS8); bool bad = false;
        for (size_t i = (size_t)blockIdx.x * NTHR + threadIdx.x; i < (size_t)NSEQ * PAST * 16; i += (size_t)gridDim.x * NTHR) { const float a = r1[i], b = r2[i]; if (!(fabsf(a - b) <= 0.05f * fabsf(b))) bad = true; }
        if (bad) p.out[OFF_YP + threadIdx.x] = __builtin_nanf("");
    }
#endif
#undef IN
#undef SEAM
}

#if DBG_TWICE
__global__ void dbg_snapshot(unsigned char* ws) {
    const uint4* s1 = (const uint4*)(ws + WS_RS); uint4* d1 = (uint4*)(ws + WS_RS8);
    for (size_t i = (size_t)blockIdx.x * blockDim.x + threadIdx.x; i < (size_t)NSEQ * PAST * 16 * 4 / 16; i += (size_t)gridDim.x * blockDim.x) d1[i] = s1[i];
    const uint4* s2 = (const uint4*)(ws + WS_O + (size_t)MP * D * 2); uint4* d2 = (uint4*)(ws + WS_END);
    for (size_t i = (size_t)blockIdx.x * blockDim.x + threadIdx.x; i < (size_t)MS * D * 2 / 16; i += (size_t)gridDim.x * blockDim.x) d2[i] = s2[i];
    const uint4 ff = {0xFFFFFFFFu, 0xFFFFFFFFu, 0xFFFFFFFFu, 0xFFFFFFFFu};
    for (size_t i = (size_t)blockIdx.x * blockDim.x + threadIdx.x; i < (size_t)NSEQ * PAST * 16 * 4 / 16; i += (size_t)gridDim.x * blockDim.x) ((uint4*)(ws + WS_RS))[i] = ff;
    for (size_t i = (size_t)blockIdx.x * blockDim.x + threadIdx.x; i < (size_t)MS * D * 2 / 16; i += (size_t)gridDim.x * blockDim.x) ((uint4*)(ws + WS_O + (size_t)MP * D * 2))[i] = ff;
    if (blockIdx.x == 0 && threadIdx.x == 0) *(unsigned*)(ws + WS_END + (4u << 20)) = 0u;
}
__global__ void dbg_compare(unsigned char* ws) {
    const uint4* s1 = (const uint4*)(ws + WS_RS); const uint4* d1 = (const uint4*)(ws + WS_RS8); unsigned bad = 0;
#ifndef DBG_TWICE_RTOL
#define DBG_TWICE_RTOL 0.0f
#endif
    for (size_t i = (size_t)blockIdx.x * blockDim.x + threadIdx.x; i < (size_t)NSEQ * PAST * 16 * 4 / 16; i += (size_t)gridDim.x * blockDim.x) { const uint4 a = s1[i], b = d1[i];
        if (DBG_TWICE_RTOL > 0.0f) { const float fa[4] = {__uint_as_float(a.x), __uint_as_float(a.y), __uint_as_float(a.z), __uint_as_float(a.w)}, fb[4] = {__uint_as_float(b.x), __uint_as_float(b.y), __uint_as_float(b.z), __uint_as_float(b.w)};
            for (int j = 0; j < 4; ++j) if (!(fabsf(fa[j] - fb[j]) <= DBG_TWICE_RTOL * fabsf(fb[j]))) bad |= 1u; }
        else if (a.x != b.x || a.y != b.y || a.z != b.z || a.w != b.w) bad |= 1u; }
    const uint4* s2 = (const uint4*)(ws + WS_O + (size_t)MP * D * 2); const uint4* d2 = (const uint4*)(ws + WS_END);
    for (size_t i = (size_t)blockIdx.x * blockDim.x + threadIdx.x; i < (size_t)MS * D * 2 / 16; i += (size_t)gridDim.x * blockDim.x) { const uint4 a = s2[i], b = d2[i]; if (a.x != b.x || a.y != b.y || a.z != b.z || a.w != b.w) bad |= 2u; }
    if (bad) atomicOr((unsigned*)(ws + WS_END + (4u << 20)), bad);
}
__global__ void dbg_poison(unsigned char* ws, float* out) {
    const unsigned fl = *(const unsigned*)(ws + WS_END + (4u << 20));
    if (fl & DBG_TWICE) out[(fl & 1u) ? OFF_YP + threadIdx.x : OFF_YS + threadIdx.x] = __builtin_nanf("");
}
#endif
extern "C" void kernel_launch(void* const* d_in, const int* in_sizes, int n_in, void* d_out, int out_size, void* d_ws, size_t ws_size, hipStream_t stream) {
    static int grid = 0;
    if (grid == 0) {
        if (n_in != N_IN || out_size != (int)OUT_TOTAL || ws_size < WS_END) { fprintf(stderr, "kernel_launch: unexpected shapes (n_in %d, out %d, ws %zu < %zu)\n", n_in, out_size, ws_size, (size_t)WS_END); grid = -1; return; }
        int dev = 0, cus = 0;
        if (hipGetDevice(&dev) != hipSuccess || hipDeviceGetAttribute(&cus, hipDeviceAttributeMultiprocessorCount, dev) != hipSuccess) { grid = -1; return; }
        if (hipFuncSetAttribute((const void*)fwd_kernel, hipFuncAttributeMaxDynamicSharedMemorySize, LDS_BYTES) != hipSuccess) { fprintf(stderr, "kernel_launch: hipFuncSetAttribute failed\n"); grid = -1; return; }
        int per_cu = 0;
        if (hipOccupancyMaxActiveBlocksPerMultiprocessor(&per_cu, (const void*)fwd_kernel, NTHR, LDS_BYTES) != hipSuccess || per_cu < 1) fprintf(stderr, "kernel_launch: occupancy query reports %d\n", per_cu);
        (void)hipGetLastError();
        grid = cus;
    }
    if (grid < 0) return;
    (void)in_sizes;
    if (hipMemsetAsync(d_ws, 0, CTL_ZERO_BYTES, stream) != hipSuccess) { fprintf(stderr, "kernel_launch: memset failed\n"); return; }
    Params p{};
    for (int i = 0; i < N_IN; ++i) p.in[i] = (const float*)d_in[i];
    p.out = (float*)d_out; p.ws = (unsigned char*)d_ws;
#if MK_PER_PHASE
#ifndef DBG_LAST_PH
#define DBG_LAST_PH NPH
#endif
    if (DBG_LAST_PH < NPH) (void)hipMemsetAsync(d_out, 0, OUT_TOTAL * sizeof(float), stream);
#ifndef PROBE_DOUBLE
#define PROBE_DOUBLE 0u
#endif
    for (int ph = 0; ph < DBG_LAST_PH; ++ph) { p.ph_lo = ph; p.ph_hi = ph + 1; const int reps = (((PROBE_DOUBLE) >> ph) & 1u) ? 2 : 1;
        for (int r = 0; r < reps; ++r) hipLaunchKernelGGL(fwd_kernel, dim3(grid), dim3(NTHR), LDS_BYTES, stream, p); }
#ifdef DBG_COPY_OFF
    (void)hipMemcpyAsync(d_out, (char*)d_ws + (DBG_COPY_OFF), (size_t)(DBG_COPY_BYTES), hipMemcpyDeviceToDevice, stream);
#endif
#elif DBG_TWICE
    p.ph_lo = 0; p.ph_hi = 8; hipLaunchKernelGGL(fwd_kernel, dim3(grid), dim3(NTHR), LDS_BYTES, stream, p);
    hipLaunchKernelGGL(dbg_snapshot, dim3(1024), dim3(256), 0, stream, (unsigned char*)d_ws);
    (void)hipMemsetAsync(d_ws, 0, CTL_ZERO_BYTES, stream);
    p.ph_lo = 5; p.ph_hi = 8; hipLaunchKernelGGL(fwd_kernel, dim3(grid), dim3(NTHR), LDS_BYTES, stream, p);
    hipLaunchKernelGGL(dbg_compare, dim3(1024), dim3(256), 0, stream, (unsigned char*)d_ws);
    (void)hipMemsetAsync(d_ws, 0, CTL_ZERO_BYTES, stream);
    p.ph_lo = 8; p.ph_hi = NPH; hipLaunchKernelGGL(fwd_kernel, dim3(grid), dim3(NTHR), LDS_BYTES, stream, p);
    hipLaunchKernelGGL(dbg_poison, dim3(1), dim3(256), 0, stream, (unsigned char*)d_ws, (float*)d_out);
#else
    p.ph_lo = 0; p.ph_hi = NPH; hipLaunchKernelGGL(fwd_kernel, dim3(grid), dim3(NTHR), LDS_BYTES, stream, p);
#endif
    const hipError_t le = hipPeekAtLastError();
    if (le != hipSuccess) fprintf(stderr, "kernel_launch: launch failed: %s\n", hipGetErrorName(le));
}
```

```cpp
#include <hip/hip_runtime.h>
#include <cstdio>
#include <cstdint>

constexpr int D = 1024, MP = 16384, MS = 1024, M = MP + MS, T = 2048, NBATCH = 8, NSEQ = 128, DSEQ = 8, PAST = 8192, PAGE = 128, NPAGES = 64;
constexpr int NH = 16, QKN = 64, QKR = 32, QKD = 96, VH = 64, QL = 512, KVL = 256, DFF = 3072, NLB = 8, LB = 128;
constexpr float EPS = 1e-6f;
constexpr float QSCALE = 0.10206207261596577f * 1.4426950408889634f;
constexpr int NSPLIT = 2;
constexpr int NROPE = T + DSEQ;

constexpr size_t OFF_YP = 0, OFF_YS = OFF_YP + (size_t)MP * D, OFF_CKVP = OFF_YS + (size_t)MS * D, OFF_KRP = OFF_CKVP + (size_t)MP * KVL,
                 OFF_CKVS = OFF_KRP + (size_t)MP * QKR, OFF_KRS = OFF_CKVS + (size_t)MS * KVL, OFF_LHP = OFF_KRS + (size_t)MS * QKR,
                 OFF_LHS = OFF_LHP + (size_t)NBATCH * D, OFF_LCP = OFF_LHS + (size_t)NSEQ * D, OFF_LCS = OFF_LCP + (size_t)NBATCH * 3 * D,
                 OFF_FCP = OFF_LCS + (size_t)NSEQ * 3 * D, OFF_FCS = OFF_FCP + (size_t)2 * NBATCH * 2 * DFF, OUT_TOTAL = OFF_FCS + (size_t)2 * NSEQ * 2 * DFF;
static_assert(OUT_TOTAL == 25067520, "output size");

enum { I_XP = 0, I_XS, I_CCKV, I_CKR, I_PT, I_SLH, I_SLC, I_SFC, I_NMIX, I_NFFN, I_WD, I_GQL, I_WUQ, I_GKV, I_GQN, I_GQR, I_GKN, I_GKR, I_WUK, I_WUV, I_WO,
       I_WIN, I_RCW, I_RCB, I_WA, I_BA, I_WI, I_BI, I_LAM, I_WOUT, I_WUP, I_FCW, I_FCB, I_WDN, N_IN };
static_assert(N_IN == 34, "34 inputs");

constexpr size_t al256(size_t x) { return (x + 255) & ~(size_t)255; }
constexpr size_t WS_CTL = 0, CTL_ZERO_BYTES = 1u << 20;
constexpr size_t WS_WD = CTL_ZERO_BYTES;
constexpr size_t WS_WUQ = WS_WD + (size_t)1024 * 1024 * 2;
constexpr size_t WS_WK = WS_WUQ + (size_t)1536 * 512 * 2;
constexpr size_t WS_WV = WS_WK + (size_t)1024 * 256 * 2;
constexpr size_t WS_WO = WS_WV + (size_t)1024 * 256 * 2;
constexpr size_t WS_WUP = WS_WO + (size_t)1024 * 1024 * 2;
constexpr size_t WS_WDN = WS_WUP + (size_t)2 * 6144 * 1024 * 2;
constexpr size_t WS_WIN = WS_WDN + (size_t)2 * 1024 * 3072 * 2;
constexpr size_t WS_WAI = WS_WIN + (size_t)2048 * 1024 * 2;
constexpr size_t WS_WOUT = WS_WAI + (size_t)8 * 256 * 128 * 2;
constexpr size_t WS_RCOS = WS_WOUT + (size_t)1024 * 1024 * 2;
constexpr size_t WS_RSIN = WS_RCOS + al256((size_t)NROPE * 16 * 4);
constexpr size_t WS_SP8 = WS_RSIN + al256((size_t)NROPE * 16 * 4);
constexpr size_t WS_XN = WS_SP8 + 4096;
constexpr size_t WS_CQ = WS_XN + (size_t)M * D * 2;
constexpr size_t WS_SSQ1 = WS_CQ + (size_t)M * QL * 2;
constexpr size_t WS_CKVRAW = WS_SSQ1 + (size_t)M * 16 * 4;
constexpr size_t WS_KRRAW = WS_CKVRAW + (size_t)M * KVL * 4;
constexpr size_t WS_CKVB = WS_KRRAW + (size_t)M * QKR * 4;
constexpr size_t WS_KRB = WS_CKVB + (size_t)M * KVL * 2;
constexpr size_t WS_Q = WS_KRB + (size_t)M * QKR * 2;
constexpr size_t WS_K96 = WS_Q + (size_t)M * NH * QKD * 2;
constexpr size_t WS_VT = WS_K96 + (size_t)MP * NH * QKD * 2;
constexpr size_t WS_RSN = WS_VT + (size_t)MP * NH * VH * 2;
constexpr size_t WS_QABS = WS_RSN + (size_t)MS * 16 * 4;
constexpr size_t WS_CB16 = WS_QABS + (size_t)NSEQ * 128 * KVL * 2;
constexpr size_t WS_KRB16 = WS_CB16 + (size_t)NSEQ * PAST * KVL * 2;
constexpr size_t WS_RS = WS_KRB16 + (size_t)NSEQ * PAST * QKR * 2;
constexpr size_t WS_CTXP = WS_RS + (size_t)NSEQ * PAST * 16 * 4;
constexpr size_t WS_MLM = WS_CTXP + (size_t)NSEQ * NSPLIT * 128 * KVL * 4;
constexpr size_t WS_MLL = WS_MLM + (size_t)NSEQ * NSPLIT * 128 * 4;
constexpr size_t WS_O = WS_MLL + (size_t)NSEQ * NSPLIT * 2 * 128 * 4;
constexpr size_t WS_X1 = WS_O + (size_t)M * D * 2;
constexpr size_t WS_X1B = WS_X1 + (size_t)M * D * 4;
constexpr size_t WS_SS1 = WS_X1B + (size_t)M * D * 2;
constexpr size_t WS_G = WS_SS1 + (size_t)M * 32 * 4;
constexpr size_t WS_U = WS_G + (size_t)M * DFF * 2;
constexpr size_t WS_HB = WS_U + (size_t)M * DFF * 2;
constexpr size_t WS_X2 = WS_HB + (size_t)M * DFF * 2;
constexpr size_t WS_X2B = WS_X2 + (size_t)M * D * 4;
constexpr size_t WS_SS2 = WS_X2B + (size_t)M * D * 2;
constexpr size_t WS_XR = WS_SS2 + (size_t)M * 32 * 4;
constexpr size_t WS_GATE = WS_XR + (size_t)M * D * 4;
constexpr size_t WS_XC = WS_GATE + (size_t)M * D * 2;
constexpr size_t WS_LA = WS_XC + (size_t)M * D * 2;
constexpr size_t WS_BX = WS_LA + (size_t)M * D * 4;
constexpr size_t WS_PA = WS_BX + (size_t)M * D * 4;
constexpr size_t WS_HL = WS_PA + (size_t)NBATCH * 16 * D * 4;
constexpr size_t WS_Y = WS_HL + (size_t)NBATCH * 16 * D * 4;
constexpr size_t WS_X3 = WS_Y + (size_t)M * D * 2;
constexpr size_t WS_X3B = WS_X3 + (size_t)M * D * 4;
constexpr size_t WS_SS3 = WS_X3B + (size_t)M * D * 2;
constexpr size_t WS_HEADG = WS_SS3 + (size_t)M * 32 * 4;
constexpr size_t WS_HEADU = WS_HEADG + (size_t)256 * 2 * DFF * 4;
constexpr size_t WS_TAILG = WS_HEADU + (size_t)256 * 2 * DFF * 4;
constexpr size_t WS_HEADX = WS_TAILG + (size_t)256 * 2 * DFF * 4;
constexpr size_t WS_TAILX = WS_HEADX + (size_t)256 * 3 * D * 4;
constexpr size_t WS_WK8 = WS_TAILX + (size_t)256 * 3 * D * 4;
constexpr size_t WS_CB8 = WS_WK8 + (size_t)1024 * 256;
constexpr size_t WS_RS8 = WS_CB8 + (size_t)NSEQ * PAST * KVL;
constexpr size_t WS_END = WS_RS8 + (size_t)NSEQ * PAST * 16 * 4;

namespace pg8 {
#define PG8_LAS __attribute__((address_space(3)))
typedef unsigned short bf16_t;
typedef short bf16x8 __attribute__((ext_vector_type(8)));
typedef float f32x4 __attribute__((ext_vector_type(4)));
typedef unsigned u32x4 __attribute__((ext_vector_type(4)));
typedef short bf16x16 __attribute__((ext_vector_type(16)));
typedef int v8i32 __attribute__((ext_vector_type(8)));
typedef int i32x4 __attribute__((ext_vector_type(4)));
constexpr int BM = 256, BK = 64, HALF = 128, HTB = HALF * BK * 2  , STAGE_BYTES = 8 * HTB, NXCD = 8, WGM = 8;

__host__ __device__ __forceinline__ int lds_byte(int r, int c) { const int st = (r >> 4) * 2 + (c >> 5), rr = r & 15, cc = c & 31, ob = rr * 64 + cc * 2; return st * 1024 + (ob ^ (((ob >> 9) & 1) << 5)); }
__host__ __device__ __forceinline__ void stage_rc(int b, int& R, int& C) { const int st = b / 1024, sb = b % 1024, swz = sb ^ (((sb >> 9) & 1) << 5); R = (st >> 1) * 16 + swz / 64; C = (st & 1) * 32 + (swz % 64) / 2; }
__host__ __device__ __forceinline__ int perm32(int rho) { const int n = rho >> 4, i = rho & 15; return 8 * (i >> 2) + 4 * n + (i & 3); }

struct Unit { int pm, pn; };
struct Gemm { const bf16_t* A; const bf16_t* Bt; int lda, ldb, K, a_pn_off; };

struct StaticOrder {
    int nM, nN, nwg, G, c;
    __host__ __device__ __forceinline__ void init(int M, int N, int G_, int c_) { nM = M / BM; nN = N / BM; nwg = nM * nN; G = G_; c = c_; }
    __host__ __device__ __forceinline__ bool next(int i, Unit& u) const {
        const long L = (long)i * G + c; if (L >= nwg) return false;
        int wgid = (int)L; { const int q = nwg / NXCD, r = nwg % NXCD, xcd = wgid % NXCD, off = wgid / NXCD; wgid = (xcd < r ? xcd * (q + 1) : r * (q + 1) + (xcd - r) * q) + off; }
        const int nig = WGM * nN, gid = wgid / nig, fm = gid * WGM, gsz = (nM - fm) < WGM ? (nM - fm) : WGM;
        u.pm = fm + ((wgid % nig) % gsz); u.pn = (wgid % nig) / gsz; return true;
    }
    __device__ __forceinline__ void a_ready(const Unit&) const {}
    __device__ __forceinline__ void done(const Unit&) const {}
};

struct LocalOrder {
    int pm0, nN, n;
    __host__ __device__ __forceinline__ bool next(int i, Unit& u) const { if (i >= n) return false; u.pm = pm0 + i / nN; u.pn = i % nN; return true; }
    __device__ __forceinline__ void a_ready(const Unit&) const {}
    __device__ __forceinline__ void done(const Unit&) const {}
};

typedef float f32x2_t __attribute__((ext_vector_type(2))); typedef __bf16 bf16x2_t __attribute__((ext_vector_type(2)));
__device__ __forceinline__ unsigned cvt_pk_bf16(float lo, float hi) { f32x2_t v = {lo, hi}; bf16x2_t b = __builtin_convertvector(v, bf16x2_t); return __builtin_bit_cast(unsigned, b); }
typedef float f32x2 __attribute__((ext_vector_type(2)));
typedef unsigned u32x2 __attribute__((ext_vector_type(2)));
__device__ __forceinline__ u32x4 pack8(const f32x4& a, const f32x4& b) { u32x4 w; w.x = cvt_pk_bf16(a[0], a[1]); w.y = cvt_pk_bf16(a[2], a[3]); w.z = cvt_pk_bf16(b[0], b[1]); w.w = cvt_pk_bf16(b[2], b[3]); return w; }
__device__ __forceinline__ float dot4(const f32x4& a) { return (a[0] * a[0] + a[1] * a[1]) + (a[2] * a[2] + a[3] * a[3]); }
__device__ __forceinline__ float quad_sum(float s) {
    const auto r1 = __builtin_amdgcn_permlane16_swap(__float_as_uint(s), __float_as_uint(s), false, false); s = __uint_as_float(r1[0]) + __uint_as_float(r1[1]);
    const auto r2 = __builtin_amdgcn_permlane32_swap(__float_as_uint(s), __float_as_uint(s), false, false); return __uint_as_float(r2[0]) + __uint_as_float(r2[1]);
}
__device__ __forceinline__ float sum_parts(const float* p, int n) { float s = 0.f; for (int i = 0; i < n; i += 4) { const f32x4 v = *(const f32x4*)(p + i); s += (v[0] + v[1]) + (v[2] + v[3]); } return s; }
__device__ __forceinline__ int rope_row(int row) { return row < MP ? (row & (T - 1)) : T + (row & (DSEQ - 1)); }

struct EpiDown {
    static constexpr bool PERM = true, AFTER_DRAIN = false;
    bf16_t* CQ; float* CKVRAW; float* KRRAW; float* SSQ;
    __device__ __forceinline__ void operator()(const f32x4 (&acc)[2][2][4][2], const Unit& u, int wr, int wc, int fr, int fq) const {
        const int row0 = u.pm * BM + wr * 64 + fr;
        if (u.pn < 2) {
#pragma unroll
            for (int ai = 0; ai < 2; ++ai)
#pragma unroll
                for (int m = 0; m < 4; ++m) { const int row = row0 + ai * HALF + m * 16; float ss = 0.f;
#pragma unroll
                    for (int bj = 0; bj < 2; ++bj) { ss += dot4(acc[ai][bj][m][0]) + dot4(acc[ai][bj][m][1]);
                        *(u32x4*)(CQ + (size_t)row * QL + u.pn * BM + bj * HALF + wc * 32 + 8 * fq) = pack8(acc[ai][bj][m][0], acc[ai][bj][m][1]); }
                    ss = quad_sum(ss);
                    if (fq == 0) SSQ[(size_t)row * 16 + u.pn * 4 + wc] = ss; asm volatile("" ::: "memory"); }
        } else if (u.pn == 2) {
#pragma unroll
            for (int ai = 0; ai < 2; ++ai)
#pragma unroll
                for (int m = 0; m < 4; ++m) { const int row = row0 + ai * HALF + m * 16;
#pragma unroll
                    for (int bj = 0; bj < 2; ++bj) { float* o = CKVRAW + (size_t)row * KVL + bj * HALF + wc * 32 + 8 * fq; *(f32x4*)o = acc[ai][bj][m][0]; *(f32x4*)(o + 4) = acc[ai][bj][m][1]; } }
        } else if (wc == 0) {
#pragma unroll
            for (int ai = 0; ai < 2; ++ai)
#pragma unroll
                for (int m = 0; m < 4; ++m) { const int row = row0 + ai * HALF + m * 16; float* o = KRRAW + (size_t)row * QKR + 8 * fq; *(f32x4*)o = acc[ai][0][m][0]; *(f32x4*)(o + 4) = acc[ai][0][m][1]; }
        }
    }
    __device__ __forceinline__ void strip(const f32x4 (&acc)[2], int row, int pn, int wr, int wc, int fq) const {
        const int c0 = 32 * wc + 8 * fq + 4 * wr;
        if (pn < 2) { float ss = dot4(acc[0]) + dot4(acc[1]);
#pragma unroll
            for (int bj = 0; bj < 2; ++bj) { u32x2 w; w.x = cvt_pk_bf16(acc[bj][0], acc[bj][1]); w.y = cvt_pk_bf16(acc[bj][2], acc[bj][3]); *(u32x2*)(CQ + (size_t)row * QL + pn * BM + bj * HALF + c0) = w; }
            ss = quad_sum(ss); if (fq == 0) SSQ[(size_t)row * 16 + (pn * 4 + wc) * 2 + wr] = ss;
        } else if (pn == 2) { *(f32x4*)(CKVRAW + (size_t)row * KVL + c0) = acc[0]; *(f32x4*)(CKVRAW + (size_t)row * KVL + HALF + c0) = acc[1]; }
        else if (wc == 0) *(f32x4*)(KRRAW + (size_t)row * QKR + c0) = acc[0];
    }
};

struct EpiQ {
    static constexpr bool PERM = true, AFTER_DRAIN = false;
    bf16_t* Q; const float* SSQ; const float* g_qn; const float* g_qr; const float* rcos; const float* rsin;
    __device__ __forceinline__ void operator()(const f32x4 (&acc)[2][2][4][2], const Unit& u, int wr, int wc, int fr, int fq) const {
        const int row0 = u.pm * BM + wr * 64 + fr;
        if (u.pn < 4) {
            const int h = u.pn * 4 + wc;
            f32x4 gq[2][2];
#pragma unroll
            for (int bj = 0; bj < 2; ++bj)
#pragma unroll
                for (int n = 0; n < 2; ++n) gq[bj][n] = *(const f32x4*)(g_qn + 32 * bj + 8 * fq + 4 * n);
#pragma unroll
            for (int ai = 0; ai < 2; ++ai)
#pragma unroll
                for (int m = 0; m < 4; ++m) { const int row = row0 + ai * HALF + m * 16;
                    const float rq = __builtin_amdgcn_rsqf(sum_parts(SSQ + (size_t)row * 16, row < MP ? 8 : 16) * (1.0f / QL) + EPS);
                    f32x4 v[2][2]; float ss = 0.f;
#pragma unroll
                    for (int bj = 0; bj < 2; ++bj)
#pragma unroll
                        for (int n = 0; n < 2; ++n) { v[bj][n] = acc[ai][bj][m][n] * rq; ss += dot4(v[bj][n]); }
                    ss = quad_sum(ss);
                    const float r = __builtin_amdgcn_rsqf(ss * (1.0f / QKN) + EPS) * QSCALE;
#pragma unroll
                    for (int bj = 0; bj < 2; ++bj)
                        *(u32x4*)(Q + (size_t)row * (NH * QKD) + h * QKD + 32 * bj + 8 * fq) = pack8(v[bj][0] * gq[bj][0] * r, v[bj][1] * gq[bj][1] * r); }
        } else {
            const f32x4 g1 = *(const f32x4*)(g_qr + 4 * fq), g2 = *(const f32x4*)(g_qr + 16 + 4 * fq);
#pragma unroll
            for (int ai = 0; ai < 2; ++ai)
#pragma unroll
                for (int m = 0; m < 4; ++m) { const int row = row0 + ai * HALF + m * 16;
                    const float rq = __builtin_amdgcn_rsqf(sum_parts(SSQ + (size_t)row * 16, row < MP ? 8 : 16) * (1.0f / QL) + EPS);
                    const int rr = rope_row(row);
                    const f32x4 cs = *(const f32x4*)(rcos + rr * 16 + 4 * fq), sn = *(const f32x4*)(rsin + rr * 16 + 4 * fq);
#pragma unroll
                    for (int bj = 0; bj < 2; ++bj) { const int h = (u.pn - 4) * 8 + bj * 4 + wc;
                        const f32x4 x1 = acc[ai][bj][m][0] * rq, x2 = acc[ai][bj][m][1] * rq;
                        const float ss = quad_sum(dot4(x1) + dot4(x2));
                        const float r = __builtin_amdgcn_rsqf(ss * (1.0f / QKR) + EPS);
                        const f32x4 a1 = x1 * g1 * r, a2 = x2 * g2 * r;
                        const f32x4 o1 = (a1 * cs - a2 * sn) * QSCALE, o2 = (a1 * sn + a2 * cs) * QSCALE;
                        bf16_t* qp = Q + (size_t)row * (NH * QKD) + h * QKD + QKN + 4 * fq;
                        u32x2 w1, w2; w1.x = cvt_pk_bf16(o1[0], o1[1]); w1.y = cvt_pk_bf16(o1[2], o1[3]); w2.x = cvt_pk_bf16(o2[0], o2[1]); w2.y = cvt_pk_bf16(o2[2], o2[3]);
                        *(u32x2*)qp = w1; *(u32x2*)(qp + 16) = w2; } }
        }
    }
};

struct EpiK {
    static constexpr bool PERM = true, AFTER_DRAIN = false;
    bf16_t* K96; const bf16_t* KRB; const float* g_kn; float* RSN;
    __device__ __forceinline__ void operator()(const f32x4 (&acc)[2][2][4][2], const Unit& u, int wr, int wc, int fr, int fq) const {
        const int row0 = u.pm * BM + wr * 64 + fr, h = u.pn * 4 + wc;
        if (u.pm < MP / BM) {
            const unsigned kbase = (unsigned)(((row0 >> 11) * NH + h) * T + (row0 & (T - 1))) * QKD + 8 * fq;
#pragma unroll
            for (int ai = 0; ai < 2; ++ai)
#pragma unroll
                for (int m = 0; m < 4; ++m) { float ss = 0.f;
#pragma unroll
                    for (int bj = 0; bj < 2; ++bj) ss += dot4(acc[ai][bj][m][0]) + dot4(acc[ai][bj][m][1]);
                    ss = quad_sum(ss);
                    const float r = __builtin_amdgcn_rsqf(ss * (1.0f / QKN) + EPS);
                    bf16_t* kp = K96 + kbase + (unsigned)((ai * HALF + m * 16) * QKD);
#pragma unroll
                    for (int bj = 0; bj < 2; ++bj) { const f32x4 g0 = *(const f32x4*)(g_kn + 32 * bj + 8 * fq) * r, g1 = *(const f32x4*)(g_kn + 32 * bj + 8 * fq + 4) * r;
                        *(u32x4*)(kp + 32 * bj) = pack8(acc[ai][bj][m][0] * g0, acc[ai][bj][m][1] * g1); }
                    *(u32x4*)(kp + QKN) = *(const u32x4*)(KRB + (size_t)(row0 + ai * HALF + m * 16) * QKR + 8 * fq);
                    asm volatile("" ::: "memory"); }
        } else {
#pragma unroll
            for (int ai = 0; ai < 2; ++ai)
#pragma unroll
                for (int m = 0; m < 4; ++m) { float ss = 0.f;
#pragma unroll
                    for (int bj = 0; bj < 2; ++bj) ss += dot4(acc[ai][bj][m][0]) + dot4(acc[ai][bj][m][1]);
                    ss = quad_sum(ss);
                    if (fq == 0) RSN[(size_t)(row0 + ai * HALF + m * 16 - MP) * 16 + h] = __builtin_amdgcn_rsqf(ss * (1.0f / QKN) + EPS); }
        }
    }
};

struct EpiVT {
    static constexpr bool PERM = true, AFTER_DRAIN = false;
    bf16_t* VT;
    __device__ __forceinline__ void operator()(const f32x4 (&acc)[2][2][4][2], const Unit& u, int wr, int wc, int fr, int fq) const {
        const int row0 = u.pm * BM + wr * 64 + fr;
#pragma unroll
        for (int ai = 0; ai < 2; ++ai)
#pragma unroll
            for (int m = 0; m < 4; ++m) { const int hd = row0 + ai * HALF + m * 16;
#pragma unroll
                for (int bj = 0; bj < 2; ++bj) { const int tok = u.pn * BM + bj * HALF + wc * 32 + 8 * fq;
                    *(u32x4*)(VT + ((size_t)(tok >> 11) * (NH * VH) + hd) * T + (tok & (T - 1))) = pack8(acc[ai][bj][m][0], acc[ai][bj][m][1]); } }
    }
};

struct EpiRS {
    static constexpr bool PERM = true, AFTER_DRAIN = false;
    float* RS; float inv;
    __device__ __forceinline__ void operator()(const f32x4 (&acc)[2][2][4][2], const Unit& u, int wr, int wc, int fr, int fq) const {
        const int row0 = u.pm * BM + wr * 64 + fr, h = u.pn * 4 + wc;
#pragma unroll
        for (int ai = 0; ai < 2; ++ai)
#pragma unroll
            for (int m = 0; m < 4; ++m) {
                f32x2 s2 = (f32x2){0.f, 0.f};
#pragma unroll
                for (int bj = 0; bj < 2; ++bj)
#pragma unroll
                    for (int n = 0; n < 2; ++n) { const f32x4 v = acc[ai][bj][m][n]; const f32x2 lo = (f32x2){v[0], v[1]}, hi = (f32x2){v[2], v[3]};
                        s2 = __builtin_elementwise_fma(lo, lo, s2); s2 = __builtin_elementwise_fma(hi, hi, s2); }
                const float ss = quad_sum(s2[0] + s2[1]);
                if (fq == 0) RS[(size_t)(row0 + ai * HALF + m * 16) * 16 + h] = __builtin_amdgcn_rsqf(ss * inv + EPS); }
    }
};

template <bool BASE_BF16, bool OUT_F32> struct EpiRes {
    static constexpr bool PERM = true, AFTER_DRAIN = false;
    const void* baseP; const void* baseS; float* outP; float* outS; bf16_t* outB; float* ssq;
    __device__ __forceinline__ void operator()(const f32x4 (&acc)[2][2][4][2], const Unit& u, int wr, int wc, int fr, int fq) const {
        const int row0 = u.pm * BM + wr * 64 + fr; const size_t col = (size_t)u.pn * BM + wc * 32 + 8 * fq;
        constexpr int MB = BASE_BF16 ? 4 : 2;
#pragma unroll
        for (int ai = 0; ai < 2; ++ai)
#pragma unroll
            for (int m0 = 0; m0 < 4; m0 += MB) {
                u32x4 braw[MB][2]; f32x4 bf[BASE_BF16 ? 1 : MB][2][2];
#pragma unroll
                for (int mm = 0; mm < MB; ++mm)
#pragma unroll
                    for (int bj = 0; bj < 2; ++bj) { const size_t off = (size_t)(row0 + ai * HALF + (m0 + mm) * 16) * D + col + bj * HALF;
                        if constexpr (BASE_BF16) braw[mm][bj] = *(const u32x4*)((const bf16_t*)baseP + off);
                        else { bf[mm][bj][0] = *(const f32x4*)((const float*)baseP + off); bf[mm][bj][1] = *(const f32x4*)((const float*)baseP + off + 4); } }
#pragma unroll
                for (int mm = 0; mm < MB; ++mm) { const int m = m0 + mm, row = row0 + ai * HALF + m * 16; float ss = 0.f;
#pragma unroll
                    for (int bj = 0; bj < 2; ++bj) { const size_t off = (size_t)row * D + col + bj * HALF;
                        f32x4 b0, b1;
                        if constexpr (BASE_BF16) { const u32x4 w = braw[mm][bj];
                            b0 = (f32x4){__uint_as_float(w.x << 16), __uint_as_float(w.x & 0xffff0000u), __uint_as_float(w.y << 16), __uint_as_float(w.y & 0xffff0000u)};
                            b1 = (f32x4){__uint_as_float(w.z << 16), __uint_as_float(w.z & 0xffff0000u), __uint_as_float(w.w << 16), __uint_as_float(w.w & 0xffff0000u)}; }
                        else { b0 = bf[mm][bj][0]; b1 = bf[mm][bj][1]; }
                        const f32x4 v0 = b0 + acc[ai][bj][m][0], v1 = b1 + acc[ai][bj][m][1];
                        if constexpr (OUT_F32) { *(f32x4*)(outP + off) = v0; *(f32x4*)(outP + off + 4) = v1; }
                        else { *(u32x4*)(outB + off) = pack8(v0, v1); ss += dot4(v0) + dot4(v1); } }
                    if constexpr (!OUT_F32) { ss = quad_sum(ss); if (fq == 0) ssq[(size_t)row * 32 + u.pn * 4 + wc] = ss; } }
                asm volatile("" ::: "memory"); }
    }
    __device__ __forceinline__ void strip(const f32x4 (&acc)[2], int row, int pn, int wr, int wc, int fq) const {
        float ss = 0.f;
#pragma unroll
        for (int bj = 0; bj < 2; ++bj) { const size_t col = (size_t)pn * BM + bj * HALF + wc * 32 + 8 * fq + 4 * wr, off = (size_t)row * D + col, offs = (size_t)(row - MP) * D + col;
            f32x4 b;
            if constexpr (BASE_BF16) { const u32x2 w = *(const u32x2*)((const bf16_t*)baseS + offs); b = (f32x4){__uint_as_float(w.x << 16), __uint_as_float(w.x & 0xffff0000u), __uint_as_float(w.y << 16), __uint_as_float(w.y & 0xffff0000u)}; }
            else b = *(const f32x4*)((const float*)baseS + offs);
            const f32x4 v = b + acc[bj];
            if constexpr (OUT_F32) *(f32x4*)(outS + offs) = v;
            else { u32x2 w; w.x = cvt_pk_bf16(v[0], v[1]); w.y = cvt_pk_bf16(v[2], v[3]); *(u32x2*)(outB + off) = w; ss += dot4(v); } }
        if constexpr (!OUT_F32) { ss = quad_sum(ss); if (fq == 0) ssq[(size_t)row * 32 + (pn * 4 + wc) * 2 + wr] = ss; }
    }
};

__device__ __forceinline__ float dpp_ror1(float v) { return __int_as_float(__builtin_amdgcn_update_dpp(0, __float_as_int(v), 0x121, 0xf, 0xf, false)); }
__device__ __forceinline__ float dpp_ror2(float v) { return __int_as_float(__builtin_amdgcn_update_dpp(0, __float_as_int(v), 0x122, 0xf, 0xf, false)); }
__device__ __forceinline__ float dpp_shr1(float old, float v) { return __int_as_float(__builtin_amdgcn_update_dpp(__float_as_int(old), __float_as_int(v), 0x111, 0xf, 0xf, false)); }
__device__ __forceinline__ float dpp_shr2(float old, float v) { return __int_as_float(__builtin_amdgcn_update_dpp(__float_as_int(old), __float_as_int(v), 0x112, 0xf, 0xf, false)); }
__device__ __forceinline__ float dpp_ror3(float v) { return __int_as_float(__builtin_amdgcn_update_dpp(0, __float_as_int(v), 0x123, 0xf, 0xf, false)); }
__device__ __forceinline__ float dpp_shr3(float old, float v) { return __int_as_float(__builtin_amdgcn_update_dpp(__float_as_int(old), __float_as_int(v), 0x113, 0xf, 0xf, false)); }
__device__ __forceinline__ float silu_f(float c) { return c * __builtin_amdgcn_rcpf(1.0f + __builtin_amdgcn_exp2f(-1.4426950408889634f * c)); }
struct EpiUp {
    static constexpr bool PERM = true, AFTER_DRAIN = false;
    const float* ssq; bf16_t* HB; float* HEADG; float* HEADU; float* TAILG; const float* cw; const float* cb; const float* st; float* convP; float* convS;
    __device__ __forceinline__ void operator()(const f32x4 (&acc)[2][2][4][2], const Unit& u, int wr, int wc, int fr, int fq) const {
        const int row0 = u.pm * BM + wr * 64 + fr, ch = u.pn * HALF + wc * 32 + 8 * fq;
        f32x4 w0[2], w1[2], w2[2], bb[2];
#pragma unroll
        for (int n = 0; n < 2; ++n) { w0[n] = *(const f32x4*)(cw + ch + 4 * n); w1[n] = *(const f32x4*)(cw + DFF + ch + 4 * n); w2[n] = *(const f32x4*)(cw + 2 * DFF + ch + 4 * n); bb[n] = *(const f32x4*)(cb + ch + 4 * n); }
        float rsv[8];
#pragma unroll
        for (int r = 0; r < 8; ++r) { const f32x4 pv = *(const f32x4*)(ssq + (size_t)(row0 + (r >> 2) * HALF + (r & 3) * 16) * 32 + 4 * fq);
            rsv[r] = __builtin_amdgcn_rsqf(quad_sum((pv[0] + pv[1]) + (pv[2] + pv[3])) * (1.0f / D) + EPS); }
#pragma unroll
        for (int ai = 0; ai < 2; ++ai) {
            f32x4 gp[2]; gp[0] = (f32x4){0.f, 0.f, 0.f, 0.f}; gp[1] = gp[0];
            const int blk = u.pm * 4 + ai * 2 + wr;
#pragma unroll
            for (int m = 0; m < 4; ++m) { const int row = row0 + ai * HALF + m * 16;
                const float rs = rsv[ai * 4 + m];
                f32x4 g[2], hv[2];
#pragma unroll
                for (int n = 0; n < 2; ++n) { g[n] = acc[ai][0][m][n] * rs; const f32x4 uu = acc[ai][1][m][n] * rs;
#pragma unroll
                    for (int j = 0; j < 4; ++j) { const float gm1 = dpp_shr1(dpp_ror1(gp[n][j]), g[n][j]), gm2 = dpp_shr2(dpp_ror2(gp[n][j]), g[n][j]);
                        hv[n][j] = silu_f(gm2 * w0[n][j] + gm1 * w1[n][j] + g[n][j] * w2[n][j] + bb[n][j]) * uu[j]; }
                    if (m == 0 && fr < 2) *(f32x4*)(HEADU + ((size_t)blk * 2 + fr) * DFF + ch + 4 * n) = uu; }
                *(u32x4*)(HB + (size_t)row * DFF + ch) = pack8(hv[0], hv[1]);
                if (m == 0 && fr < 2) { float* hp = HEADG + ((size_t)blk * 2 + fr) * DFF + ch; *(f32x4*)hp = g[0]; *(f32x4*)(hp + 4) = g[1]; }
                if (m == 3 && fr >= 14) { float* tp = TAILG + ((size_t)blk * 2 + (fr - 14)) * DFF + ch; *(f32x4*)tp = g[0]; *(f32x4*)(tp + 4) = g[1]; }
                const int t = row & (T - 1);
                if (t >= T - 2) { float* cp = convP + ((size_t)(row >> 11) * 2 + (t - (T - 2))) * DFF + ch; *(f32x4*)cp = g[0]; *(f32x4*)(cp + 4) = g[1]; }
                gp[0] = g[0]; gp[1] = g[1];
                asm volatile("" ::: "memory"); }
        }
    }
    __device__ __forceinline__ void strip(const f32x4 (&acc)[2], int row, int pn, int wr, int wc, int fq) const {
        const int ch = pn * HALF + wc * 32 + 8 * fq + 4 * wr, s = row & (DSEQ - 1), bs = (row - MP) >> 3;
        const float rs = __builtin_amdgcn_rsqf(sum_parts(ssq + (size_t)row * 32, 32) * (1.0f / D) + EPS);
        const f32x4 g = acc[0] * rs, uu = acc[1] * rs;
        const f32x4 s0 = *(const f32x4*)(st + ((size_t)bs * 2 + 0) * DFF + ch), s1 = *(const f32x4*)(st + ((size_t)bs * 2 + 1) * DFF + ch);
        const f32x4 w0 = *(const f32x4*)(cw + ch), w1 = *(const f32x4*)(cw + DFF + ch), w2 = *(const f32x4*)(cw + 2 * DFF + ch), bb = *(const f32x4*)(cb + ch);
        f32x4 hv;
#pragma unroll
        for (int j = 0; j < 4; ++j) { const float a1 = dpp_shr1(0.f, g[j]), a2 = dpp_shr2(0.f, g[j]);
            const float gm1 = (s == 0) ? s1[j] : a1, gm2 = (s == 0) ? s0[j] : ((s == 1) ? s1[j] : a2);
            hv[j] = silu_f(gm2 * w0[j] + gm1 * w1[j] + g[j] * w2[j] + bb[j]) * uu[j]; }
        u32x2 w; w.x = cvt_pk_bf16(hv[0], hv[1]); w.y = cvt_pk_bf16(hv[2], hv[3]); *(u32x2*)(HB + (size_t)row * DFF + ch) = w;
        if (s >= DSEQ - 2) *(f32x4*)(convS + ((size_t)bs * 2 + (s - (DSEQ - 2))) * DFF + ch) = g;
    }
};

__device__ __forceinline__ float gelu_tanh(float x) { const float t = 1.5957691216057308f * (x + 0.044715f * x * x * x); return x * __builtin_amdgcn_rcpf(1.0f + __builtin_amdgcn_exp2f(-1.4426950408889634f * t)); }
struct EpiIn {
    static constexpr bool PERM = true, AFTER_DRAIN = false;
    const float* ssq; bf16_t* XC; bf16_t* GATE; float* HEADX; float* TAILX; const float* cw; const float* cb; const float* st; float* convP; float* convS;
    __device__ __forceinline__ void operator()(const f32x4 (&acc)[2][2][4][2], const Unit& u, int wr, int wc, int fr, int fq) const {
        const int row0 = u.pm * BM + wr * 64 + fr, ch = u.pn * HALF + wc * 32 + 8 * fq;
        float rsv[8];
#pragma unroll
        for (int r = 0; r < 8; ++r) { const f32x4 pv = *(const f32x4*)(ssq + (size_t)(row0 + (r >> 2) * HALF + (r & 3) * 16) * 32 + 4 * fq);
            rsv[r] = __builtin_amdgcn_rsqf(quad_sum((pv[0] + pv[1]) + (pv[2] + pv[3])) * (1.0f / D) + EPS); }
#pragma unroll
        for (int n = 0; n < 2; ++n) {
            const f32x4 w0 = *(const f32x4*)(cw + ch + 4 * n), w1 = *(const f32x4*)(cw + D + ch + 4 * n), w2 = *(const f32x4*)(cw + 2 * D + ch + 4 * n), w3 = *(const f32x4*)(cw + 3 * D + ch + 4 * n), bb = *(const f32x4*)(cb + ch + 4 * n);
#pragma unroll
            for (int ai = 0; ai < 2; ++ai) {
                f32x4 xp = (f32x4){0.f, 0.f, 0.f, 0.f};
                const int blk = u.pm * 4 + ai * 2 + wr;
#pragma unroll
                for (int m = 0; m < 4; ++m) { const int row = row0 + ai * HALF + m * 16;
                    const float rs = rsv[ai * 4 + m];
                    const f32x4 x = acc[ai][0][m][n] * rs; f32x4 y;
#pragma unroll
                    for (int j = 0; j < 4; ++j) { const float x1 = dpp_shr1(dpp_ror1(xp[j]), x[j]), x2 = dpp_shr2(dpp_ror2(xp[j]), x[j]), x3 = dpp_shr3(dpp_ror3(xp[j]), x[j]);
                        y[j] = x3 * w0[j] + x2 * w1[j] + x1 * w2[j] + x[j] * w3[j] + bb[j]; }
                    u32x2 w; w.x = cvt_pk_bf16(y[0], y[1]); w.y = cvt_pk_bf16(y[2], y[3]); *(u32x2*)(XC + (size_t)row * D + ch + 4 * n) = w;
                    f32x4 t0 = acc[ai][1][m][n] * rs;
#pragma unroll
                    for (int j = 0; j < 4; ++j) t0[j] = gelu_tanh(t0[j]);
                    w.x = cvt_pk_bf16(t0[0], t0[1]); w.y = cvt_pk_bf16(t0[2], t0[3]); *(u32x2*)(GATE + (size_t)row * D + ch + 4 * n) = w;
                    if (m == 0 && fr < 3) *(f32x4*)(HEADX + ((size_t)blk * 3 + fr) * D + ch + 4 * n) = x;
                    if (m == 3 && fr >= 13) *(f32x4*)(TAILX + ((size_t)blk * 3 + (fr - 13)) * D + ch + 4 * n) = x;
                    const int t = row & (T - 1);
                    if (t >= T - 3) *(f32x4*)(convP + ((size_t)(row >> 11) * 3 + (t - (T - 3))) * D + ch + 4 * n) = x;
                    xp = x;
                    asm volatile("" ::: "memory"); }
            }
        }
    }
    __device__ __forceinline__ void strip(const f32x4 (&acc)[2], int row, int pn, int wr, int wc, int fq) const {
        const int ch = pn * HALF + wc * 32 + 8 * fq + 4 * wr, s = row & (DSEQ - 1), bs = (row - MP) >> 3;
        const float rs = __builtin_amdgcn_rsqf(sum_parts(ssq + (size_t)row * 32, 32) * (1.0f / D) + EPS);
        const f32x4 x = acc[0] * rs; f32x4 t0 = acc[1] * rs;
        const f32x4 s0 = *(const f32x4*)(st + ((size_t)bs * 3 + 0) * D + ch), s1 = *(const f32x4*)(st + ((size_t)bs * 3 + 1) * D + ch), s2 = *(const f32x4*)(st + ((size_t)bs * 3 + 2) * D + ch);
        const f32x4 w0 = *(const f32x4*)(cw + ch), w1 = *(const f32x4*)(cw + D + ch), w2 = *(const f32x4*)(cw + 2 * D + ch), w3 = *(const f32x4*)(cw + 3 * D + ch), bb = *(const f32x4*)(cb + ch);
        f32x4 y;
#pragma unroll
        for (int j = 0; j < 4; ++j) { const float a1 = dpp_shr1(0.f, x[j]), a2 = dpp_shr2(0.f, x[j]), a3 = dpp_shr3(0.f, x[j]);
            const float x1 = (s == 0) ? s2[j] : a1, x2 = (s == 0) ? s1[j] : ((s == 1) ? s2[j] : a2), x3 = (s == 0) ? s0[j] : ((s == 1) ? s1[j] : ((s == 2) ? s2[j] : a3));
            y[j] = x3 * w0[j] + x2 * w1[j] + x1 * w2[j] + x[j] * w3[j] + bb[j]; }
        u32x2 w; w.x = cvt_pk_bf16(y[0], y[1]); w.y = cvt_pk_bf16(y[2], y[3]); *(u32x2*)(XC + (size_t)row * D + ch) = w;
#pragma unroll
        for (int j = 0; j < 4; ++j) t0[j] = gelu_tanh(t0[j]);
        w.x = cvt_pk_bf16(t0[0], t0[1]); w.y = cvt_pk_bf16(t0[2], t0[3]); *(u32x2*)(GATE + (size_t)row * D + ch) = w;
        if (s >= DSEQ - 3) *(f32x4*)(convS + ((size_t)bs * 3 + (s - (DSEQ - 3))) * D + ch) = x;
    }
};

struct EpiLru {
    static constexpr bool PERM = true, AFTER_DRAIN = false;
    const bf16_t* XC; const float* b_a; const float* b_i; const float* sp8; float* LA; float* BX;
    __device__ __forceinline__ void operator()(const f32x4 (&acc)[2][2][4][2], const Unit& u, int wr, int wc, int fr, int fq) const {
        const int row0 = u.pm * BM + wr * 64 + fr, ch = u.pn * HALF + wc * 32 + 8 * fq;
#pragma unroll
        for (int ai = 0; ai < 2; ++ai)
#pragma unroll
            for (int m = 0; m < 4; ++m) { const int row = row0 + ai * HALF + m * 16;
                const u32x4 xw = *(const u32x4*)(XC + (size_t)row * D + ch);
                float* lp = LA + (size_t)row * D + ch; float* bp = BX + (size_t)row * D + ch;
#pragma unroll
                for (int n = 0; n < 2; ++n) {
                    const f32x4 ba = *(const f32x4*)(b_a + ch + 4 * n), bi = *(const f32x4*)(b_i + ch + 4 * n), sp = *(const f32x4*)(sp8 + ch + 4 * n);
                    f32x4 av, bv;
#pragma unroll
                    for (int j = 0; j < 4; ++j) { const float ra = acc[ai][0][m][n][j] + ba[j], ia = acc[ai][1][m][n][j] + bi[j];
                        const float r = __builtin_amdgcn_rcpf(1.0f + __expf(-ra)), gi = __builtin_amdgcn_rcpf(1.0f + __expf(-ia));
                        const float la = r * sp[j], a = __expf(la), x2 = 2.0f * la;
                        const float om = (x2 > -0.05f) ? -x2 * (1.0f + x2 * (0.5f + x2 * (0.16666667f + x2 * 0.041666668f))) : 1.0f - a * a;
                        const unsigned wv = xw[2 * n + (j >> 1)]; const float xc = __uint_as_float((j & 1) ? (wv & 0xffff0000u) : (wv << 16));
                        av[j] = a; bv[j] = __builtin_sqrtf(om) * gi * xc; }
                    *(f32x4*)(lp + 4 * n) = av; *(f32x4*)(bp + 4 * n) = bv; }
                asm volatile("" ::: "memory"); }
    }
    __device__ __forceinline__ void strip(const f32x4 (&acc)[2], int row, int pn, int wr, int wc, int fq) const {
        const int ch = pn * HALF + wc * 32 + 8 * fq + 4 * wr;
        const u32x2 xw = *(const u32x2*)(XC + (size_t)row * D + ch);
        const f32x4 ba = *(const f32x4*)(b_a + ch), bi = *(const f32x4*)(b_i + ch), sp = *(const f32x4*)(sp8 + ch);
        f32x4 av, bv;
#pragma unroll
        for (int j = 0; j < 4; ++j) { const float ra = acc[0][j] + ba[j], ia = acc[1][j] + bi[j];
            const float r = __builtin_amdgcn_rcpf(1.0f + __expf(-ra)), gi = __builtin_amdgcn_rcpf(1.0f + __expf(-ia));
            const float la = r * sp[j], a = __expf(la), x2 = 2.0f * la;
            const float om = (x2 > -0.05f) ? -x2 * (1.0f + x2 * (0.5f + x2 * (0.16666667f + x2 * 0.041666668f))) : 1.0f - a * a;
            const unsigned wv = xw[j >> 1]; const float xc = __uint_as_float((j & 1) ? (wv & 0xffff0000u) : (wv << 16));
            av[j] = a; bv[j] = __builtin_sqrtf(om) * gi * xc; }
        *(f32x4*)(LA + (size_t)row * D + ch) = av; *(f32x4*)(BX + (size_t)row * D + ch) = bv;
    }
};

__device__ __forceinline__ void glds16s(const void* sbase, unsigned voff, unsigned lds_dst) {
    unsigned keep;
    asm volatile("s_mov_b32 %0, m0\n\ts_mov_b32 m0, %3\n\ts_nop 0\n\tglobal_load_lds_dwordx4 %1, %2\n\ts_mov_b32 m0, %0" : "=&s"(keep) : "v"(voff), "s"(sbase), "s"(lds_dst) : "memory");
}
template <class Epi, class Sched, bool ALIGN_EPI = false, bool SP2 = false, bool STRIP = false, bool F8 = false, bool OPQK = false>
__device__ __forceinline__ void gemm_phase(PG8_LAS unsigned char* lds, const Gemm g, const Sched& S, const Epi& E, PG8_LAS unsigned char* xlds = nullptr, int strip_row0 = 0) {
    static_assert(!STRIP || SP2, "STRIP needs the SP2 loop"); static_assert(!F8 || (SP2 && !STRIP), "F8 is the SP2 loop without strips");
    int tid_ = threadIdx.x; asm volatile("" : "+v"(tid_));
    const int tid = tid_, wid = __builtin_amdgcn_readfirstlane(tid >> 6), lane = tid & 63, wr = wid >> 2, wc = wid & 3, fr = lane & 15, fq = lane >> 4;
    int K = g.K; if constexpr (OPQK) asm volatile("" : "+s"(K));
    const int nt = K / BK;
    unsigned voffA[2], voffB[2];
#pragma unroll
    for (int i = 0; i < 2; ++i) { int R, C; stage_rc(tid * 16 + i * 8192, R, C); const int Rb = Epi::PERM ? ((R & ~31) + perm32(R & 31)) : R;
        voffA[i] = (unsigned)(R * g.lda + C) * 2u; voffB[i] = (unsigned)(Rb * g.ldb + C) * 2u; }
    unsigned voffX = 0u; { int R, C; stage_rc((tid & 127) * 16, R, C); voffX = (unsigned)(R * g.lda + C) * 2u; }
    const int xoff = lds_byte(fr, fq * 8);
    const bool xw = STRIP && (wid < 2);
    const size_t kstep = (size_t)(BK * 2);
    const size_t hstepA = (size_t)HALF * g.lda * 2, hstepB = (size_t)HALF * g.ldb * 2;
    const size_t tstepA = 2 * hstepA, tstepB = 2 * hstepB;
    const size_t pnoffA = (size_t)g.a_pn_off * 2;
    const unsigned ldsw = (unsigned)wid * 1024u;
    const int fcol = fq * 8, fkst = 1024;
    const int aoff = lds_byte(wr * 64 + fr, fcol), boff = lds_byte(wc * 32 + fr, fcol);
#define PG8_SA(b, h) (((b) * 2 + (h)) * HTB)
#define PG8_SB(b, h) ((4 + (b) * 2 + (h)) * HTB)
#define PG8_STAGE(bufoff, gbase, voff) do { if constexpr (F8) { _Pragma("unroll") for (int _i = 0; _i < 2; ++_i) glds16s((const void*)(gbase), (voff)[_i], (unsigned)(unsigned long long)(lds + (bufoff) + ldsw + _i * 8192)); } \
        else { _Pragma("unroll") for (int _i = 0; _i < 2; ++_i) \
        __builtin_amdgcn_global_load_lds((const unsigned*)((const char*)(gbase) + (voff)[_i]), (PG8_LAS unsigned*)(lds + (bufoff) + ldsw + _i * 8192), 16, 0, 0); } } while (0)
#define PG8_LD8(base_) __builtin_shufflevector(*(const PG8_LAS i32x4*)(base_), *(const PG8_LAS i32x4*)((base_) + 1024), 0, 1, 2, 3, 4, 5, 6, 7)
#define PG8_LDA(dst, b, h) do { if constexpr (F8) { _Pragma("unroll") for (int m = 0; m < 4; ++m) A8[m] = PG8_LD8(lds + PG8_SA(b, h) + aoff + m * 2048); } \
        else { _Pragma("unroll") for (int m = 0; m < 4; ++m) _Pragma("unroll") for (int k = 0; k < 2; ++k) dst[m][k] = *(const PG8_LAS bf16x8*)(lds + PG8_SA(b, h) + aoff + m * 2048 + k * 1024); } } while (0)
#define PG8_LDB(dst, b, h) do { if constexpr (F8) { _Pragma("unroll") for (int n = 0; n < 2; ++n) dst##8[n] = PG8_LD8(lds + PG8_SB(b, h) + boff + n * 2048); } \
        else { _Pragma("unroll") for (int n = 0; n < 2; ++n) _Pragma("unroll") for (int k = 0; k < 2; ++k) dst[n][k] = *(const PG8_LAS bf16x8*)(lds + PG8_SB(b, h) + boff + n * 2048 + k * 1024); } } while (0)
#define PG8_MMA(ai, bj, At, Bt) do { __builtin_amdgcn_s_setprio(1); if constexpr (F8) { _Pragma("unroll") for (int m = 0; m < 4; ++m) _Pragma("unroll") for (int n = 0; n < 2; ++n) \
        acc[ai][bj][m][n] = __builtin_amdgcn_mfma_scale_f32_16x16x128_f8f6f4(Bt##8[n], A8[m], acc[ai][bj][m][n], 0, 0, 0, 0x7f7f7f7f, 0, 0x7f7f7f7f); } \
        else { _Pragma("unroll") for (int m = 0; m < 4; ++m) _Pragma("unroll") for (int n = 0; n < 2; ++n) _Pragma("unroll") for (int k = 0; k < 2; ++k) \
        acc[ai][bj][m][n] = __builtin_amdgcn_mfma_f32_16x16x32_bf16(Bt[n][k], At[m][k], acc[ai][bj][m][n], 0, 0, 0); } \
        __builtin_amdgcn_s_setprio(0); } while (0)
#define PG8_WAIT_V(n) asm volatile("s_waitcnt vmcnt(" #n ")" ::: "memory")
#define PG8_WAIT_V8X do { if (xw) PG8_WAIT_V(9); else PG8_WAIT_V(8); } while (0)
#define PG8_STAGE_X(b, gbase) do { if (xw) __builtin_amdgcn_global_load_lds((const unsigned*)((const char*)(gbase) + voffX), (PG8_LAS unsigned*)(xlds + (b) * 2048 + ldsw), 16, 0, 0); } while (0)
#define PG8_LDX(b) do { _Pragma("unroll") for (int k = 0; k < 2; ++k) Xf[k] = *(const PG8_LAS bf16x8*)(xlds + (b) * 2048 + xoff + k * 1024); } while (0)
#define PG8_MMX do { if (wr == 0) { _Pragma("unroll") for (int k = 0; k < 2; ++k) { acc17[0] = __builtin_amdgcn_mfma_f32_16x16x32_bf16(B0[0][k], Xf[k], acc17[0], 0, 0, 0); acc17[1] = __builtin_amdgcn_mfma_f32_16x16x32_bf16(B1[0][k], Xf[k], acc17[1], 0, 0, 0); } } \
        else { _Pragma("unroll") for (int k = 0; k < 2; ++k) { acc17[0] = __builtin_amdgcn_mfma_f32_16x16x32_bf16(B0[1][k], Xf[k], acc17[0], 0, 0, 0); acc17[1] = __builtin_amdgcn_mfma_f32_16x16x32_bf16(B1[1][k], Xf[k], acc17[1], 0, 0, 0); } } } while (0)
#define PG8_WAIT_L(n) asm volatile("s_waitcnt lgkmcnt(" #n ")" ::: "memory")
#define PG8_BAR __builtin_amdgcn_s_barrier()
#define PG8_SCHED __builtin_amdgcn_sched_barrier(0)
    Unit cur, nxt; int ui = 0;
    if (!S.next(0, cur)) return;
    f32x4 acc[2][2][4][2];
#pragma unroll
    for (int a = 0; a < 2; ++a)
#pragma unroll
        for (int b = 0; b < 2; ++b)
#pragma unroll
            for (int m = 0; m < 4; ++m)
#pragma unroll
                for (int n = 0; n < 2; ++n) acc[a][b][m][n] = (f32x4){0.f, 0.f, 0.f, 0.f};
    bf16x8 At[4][2], B0[2][2], B1[2][2];
    v8i32 A8[4], B08[2], B18[2];
    bf16x8 Xf[2]; f32x4 acc17[2]; acc17[0] = (f32x4){0.f, 0.f, 0.f, 0.f}; acc17[1] = acc17[0];
    const size_t xstep = (size_t)16 * g.lda * 2;
    const char* cA = (const char*)g.A + (size_t)cur.pm * tstepA + (size_t)cur.pn * pnoffA; const char* cB = (const char*)g.Bt + (size_t)cur.pn * tstepB;
    const char* cX = (const char*)g.A + (size_t)strip_row0 * g.lda * 2 + (size_t)cur.pm * xstep + (size_t)cur.pn * pnoffA;
    S.a_ready(cur);
    if constexpr (SP2) {
        if constexpr (STRIP) PG8_STAGE_X(0, cX);
        PG8_STAGE(PG8_SB(0, 0), cB, voffB); PG8_STAGE(PG8_SB(0, 1), cB + hstepB, voffB); PG8_STAGE(PG8_SA(0, 0), cA, voffA); PG8_STAGE(PG8_SA(0, 1), cA + hstepA, voffA);
        if (wr == 1) PG8_BAR;
        PG8_WAIT_V(2); PG8_BAR;
        PG8_STAGE(PG8_SB(1, 0), cB + kstep, voffB); PG8_STAGE(PG8_SA(1, 0), cA + kstep, voffA); PG8_STAGE(PG8_SB(1, 1), cB + hstepB + kstep, voffB);
        if constexpr (STRIP) { PG8_STAGE_X(1, cX + kstep); if (xw) PG8_WAIT_V(7); else PG8_WAIT_V(6); } else PG8_WAIT_V(6);
        PG8_BAR;
    } else {
        PG8_STAGE(PG8_SB(0, 0), cB, voffB); PG8_STAGE(PG8_SA(0, 0), cA, voffA); PG8_STAGE(PG8_SB(0, 1), cB + hstepB, voffB); PG8_STAGE(PG8_SA(0, 1), cA + hstepA, voffA);
        if (wr == 1) PG8_BAR;
        PG8_WAIT_V(4); PG8_BAR;
        PG8_STAGE(PG8_SB(1, 0), cB + kstep, voffB); PG8_STAGE(PG8_SA(1, 0), cA + kstep, voffA); PG8_STAGE(PG8_SB(1, 1), cB + hstepB + kstep, voffB);
        PG8_WAIT_V(6); PG8_BAR;
    }
    for (;;) {
        const bool has_next = S.next(ui + 1, nxt);
        const char* nA = has_next ? (const char*)g.A + (size_t)nxt.pm * tstepA + (size_t)nxt.pn * pnoffA : cA; const char* nB = has_next ? (const char*)g.Bt + (size_t)nxt.pn * tstepB : cB;
        const char* nX = has_next ? (const char*)g.A + (size_t)strip_row0 * g.lda * 2 + (size_t)nxt.pm * xstep + (size_t)nxt.pn * pnoffA : cX;
#pragma nounroll
        for (int t = 0; t < nt; t += 2) {
            const bool last = (t == nt - 2);
            const char* a1 = cA + (size_t)(t + 1) * kstep;
            const char* a2 = last ? nA : cA + (size_t)(t + 2) * kstep; const char* b2 = last ? nB : cB + (size_t)(t + 2) * kstep;
            const char* a3 = a2 + kstep; const char* b3 = b2 + kstep;
            const char* x2 = last ? nX : cX + (size_t)(t + 2) * kstep; const char* x3 = x2 + kstep;
            if (last && has_next) S.a_ready(nxt);
            if constexpr (SP2) {
            PG8_LDB(B0, 0, 0); PG8_LDB(B1, 0, 1); PG8_SCHED; PG8_LDA(At, 0, 0); if constexpr (STRIP) PG8_LDX(0); PG8_STAGE(PG8_SA(1, 1), a1 + hstepA, voffA);
            PG8_WAIT_V8X; PG8_WAIT_L(0); PG8_BAR; PG8_MMA(0, 0, At, B0); PG8_MMA(0, 1, At, B1); if constexpr (STRIP) PG8_MMX; PG8_BAR; PG8_SCHED;
            PG8_LDA(At, 0, 1); PG8_STAGE(PG8_SB(0, 0), b2, voffB); PG8_STAGE(PG8_SB(0, 1), b2 + hstepB, voffB); PG8_STAGE(PG8_SA(0, 0), a2, voffA); if constexpr (STRIP) PG8_STAGE_X(0, x2);
            PG8_WAIT_V8X; PG8_WAIT_L(0); PG8_BAR; PG8_MMA(1, 0, At, B0); PG8_MMA(1, 1, At, B1); PG8_BAR; PG8_SCHED;
            PG8_LDB(B0, 1, 0); PG8_LDB(B1, 1, 1); PG8_SCHED; PG8_LDA(At, 1, 0); if constexpr (STRIP) PG8_LDX(1); PG8_STAGE(PG8_SA(0, 1), a2 + hstepA, voffA);
            PG8_WAIT_V8X; PG8_WAIT_L(0); PG8_BAR; PG8_MMA(0, 0, At, B0); PG8_MMA(0, 1, At, B1); if constexpr (STRIP) PG8_MMX; PG8_BAR; PG8_SCHED;
            PG8_LDA(At, 1, 1); PG8_STAGE(PG8_SB(1, 0), b3, voffB); PG8_STAGE(PG8_SB(1, 1), b3 + hstepB, voffB); PG8_STAGE(PG8_SA(1, 0), a3, voffA); if constexpr (STRIP) PG8_STAGE_X(1, x3);
            PG8_WAIT_V8X; PG8_WAIT_L(0); PG8_BAR; PG8_MMA(1, 0, At, B0); PG8_MMA(1, 1, At, B1); PG8_BAR; PG8_SCHED;
            } else {
            PG8_LDB(B0, 0, 0); PG8_SCHED; PG8_LDA(At, 0, 0); PG8_STAGE(PG8_SA(1, 1), a1 + hstepA, voffA);
            PG8_WAIT_L(8); PG8_BAR; PG8_WAIT_L(0); PG8_MMA(0, 0, At, B0); PG8_BAR; PG8_SCHED;
            PG8_LDB(B1, 0, 1); PG8_STAGE(PG8_SB(0, 0), b2, voffB);
            PG8_BAR; PG8_WAIT_L(0); PG8_MMA(0, 1, At, B1); PG8_BAR;
            PG8_LDA(At, 0, 1); PG8_STAGE(PG8_SA(0, 0), a2, voffA);
            PG8_BAR; PG8_WAIT_L(0); PG8_MMA(1, 0, At, B0); PG8_BAR; PG8_SCHED;
            PG8_STAGE(PG8_SB(0, 1), b2 + hstepB, voffB);
            PG8_WAIT_V(6); PG8_BAR; PG8_MMA(1, 1, At, B1); PG8_BAR;
            PG8_LDB(B0, 1, 0); PG8_SCHED; PG8_LDA(At, 1, 0); PG8_STAGE(PG8_SA(0, 1), a2 + hstepA, voffA);
            PG8_WAIT_L(8); PG8_BAR; PG8_WAIT_L(0); PG8_MMA(0, 0, At, B0); PG8_BAR; PG8_SCHED;
            PG8_LDB(B1, 1, 1); PG8_STAGE(PG8_SB(1, 0), b3, voffB);
            PG8_BAR; PG8_WAIT_L(0); PG8_MMA(0, 1, At, B1); PG8_BAR;
            PG8_LDA(At, 1, 1); PG8_STAGE(PG8_SA(1, 0), a3, voffA);
            PG8_BAR; PG8_WAIT_L(0); PG8_MMA(1, 0, At, B0); PG8_BAR; PG8_SCHED;
            PG8_STAGE(PG8_SB(1, 1), b3 + hstepB, voffB);
            PG8_WAIT_V(6); PG8_BAR; PG8_MMA(1, 1, At, B1); PG8_BAR;
            }
        }
        if constexpr (ALIGN_EPI) { if (wr == 0) PG8_BAR; }
        if constexpr (!Epi::AFTER_DRAIN) { int fr_e = fr, fq_e = fq; asm volatile("" : "+v"(fr_e), "+v"(fq_e));
            E(acc, cur, wr, wc, fr_e, fq_e); if constexpr (STRIP) E.strip(acc17, strip_row0 + 16 * cur.pm + fr_e, cur.pn, wr, wc, fq_e); S.done(cur); }
        if (!has_next) break;
#pragma unroll
        for (int a = 0; a < 2; ++a)
#pragma unroll
            for (int b = 0; b < 2; ++b)
#pragma unroll
                for (int m = 0; m < 4; ++m)
#pragma unroll
                    for (int n = 0; n < 2; ++n) acc[a][b][m][n] = (f32x4){0.f, 0.f, 0.f, 0.f};
        cur = nxt; cA = nA; cB = nB; cX = nX; ++ui; acc17[0] = (f32x4){0.f, 0.f, 0.f, 0.f}; acc17[1] = acc17[0];
        if constexpr (ALIGN_EPI) { if (wr == 1) PG8_BAR; }
    }
    PG8_WAIT_V(0);
    if constexpr (!ALIGN_EPI) { if (wr == 0) PG8_BAR; }
    PG8_BAR;
    if constexpr (Epi::AFTER_DRAIN) { E.fused(acc, cur, wr, wc, fr, fq, lds, wid, lane); S.done(cur); }
#undef PG8_SA
#undef PG8_SB
#undef PG8_STAGE
#undef PG8_LDA
#undef PG8_LD8
#undef PG8_LDB
#undef PG8_MMA
#undef PG8_WAIT_V
#undef PG8_WAIT_V8X
#undef PG8_STAGE_X
#undef PG8_LDX
#undef PG8_MMX
#undef PG8_WAIT_L
#undef PG8_BAR
#undef PG8_SCHED
}

}

#define GAS __attribute__((address_space(1)))
#define LAS __attribute__((address_space(3)))
typedef unsigned short bf16;
typedef unsigned v4u __attribute__((ext_vector_type(4)));
typedef float f32x4 __attribute__((ext_vector_type(4)));
typedef short bf16x8 __attribute__((ext_vector_type(8)));
typedef GAS unsigned gu32;
typedef GAS unsigned long long gu64;
#define RLX_AGENT __ATOMIC_RELAXED, __HIP_MEMORY_SCOPE_AGENT
#define LDS_WAIT() asm volatile("s_waitcnt lgkmcnt(0)" ::: "memory")
#define VM_WAIT() asm volatile("s_waitcnt vmcnt(0)" ::: "memory")
__device__ __forceinline__ unsigned long long rt() { return __builtin_amdgcn_s_memrealtime(); }
__device__ __forceinline__ unsigned f2bf(float f) { unsigned u = __builtin_bit_cast(unsigned, f); return (u + 0x7fffu + ((u >> 16) & 1u)) >> 16; }
__device__ __forceinline__ unsigned pk2(float lo, float hi) { return f2bf(lo) | (f2bf(hi) << 16); }
#define XB_TMO      128
#define XB_XCNT(j)  (256  + 64 * (j))
#define XB_XSUB(j)  (1280 + 64 * (j))
#define XB_XGEN(j)  (2304 + 64 * (j))
#define XB_TOP      3328
#define XB_TOPGEN   3392
#define XCD_BAR_WORDS 3456
#define XB_SPIN_CAP (1u << 18)

__device__ __forceinline__ unsigned xb_ld(unsigned* p)              { return __hip_atomic_load(p, __ATOMIC_RELAXED, __HIP_MEMORY_SCOPE_AGENT); }
__device__ __forceinline__ unsigned xb_add(unsigned* p, unsigned v) { return __hip_atomic_fetch_add(p, v, __ATOMIC_RELAXED, __HIP_MEMORY_SCOPE_AGENT); }
__device__ __forceinline__ unsigned xb_xcc_id() { return (unsigned)__builtin_amdgcn_s_getreg((3 << 11) | 20) & 0xFu; }
#define XB_SPIN(cond, bar) do { unsigned _sp = 0; while (cond) { __builtin_amdgcn_s_sleep(1); \
    if ((++_sp & 255u) == 0u) { if (xb_ld(&(bar)[XB_TMO])) break; if (_sp > XB_SPIN_CAP) { atomicAdd(&(bar)[XB_TMO], 1u); break; } } } } while (0)

struct XcdBarrier {
    unsigned* bar; unsigned x;
    volatile LAS unsigned* st;
};

__device__ __forceinline__ XcdBarrier xcd_barrier_post(unsigned* bar, volatile LAS unsigned* st) {
    XcdBarrier b; b.bar = bar; b.x = xb_xcc_id(); b.st = st;
    if (threadIdx.x == 0) (void)xb_add(&bar[XB_XCNT(b.x)], 1u);
    return b;
}
__device__ __forceinline__ void xcd_barrier_complete(unsigned* bar, unsigned x, unsigned& nloc, unsigned& nx) {
    const unsigned G = gridDim.x * gridDim.y * gridDim.z;
    unsigned sum, cnt, mine, sp = 0u;
    for (;;) {
        sum = 0u; cnt = 0u; mine = 0u;
#pragma unroll
        for (unsigned j = 0; j < 16; ++j) { const unsigned c = xb_ld(&bar[XB_XCNT(j)]); sum += c; cnt += (c > 0u) ? 1u : 0u; mine = (j == x) ? c : mine; }
        if (sum == G) break;
        __builtin_amdgcn_s_sleep(1);
        if ((++sp & 255u) == 0u) { if (xb_ld(&bar[XB_TMO])) break; if (sp > XB_SPIN_CAP) { atomicAdd(&bar[XB_TMO], 1u); break; } }
    }
    nloc = mine > 0u ? mine : 1u; nx = cnt > 0u ? cnt : 1u;
}

__device__ __forceinline__ void xcd_barrier(const XcdBarrier& b) {
    asm volatile("s_waitcnt vmcnt(0)" ::: "memory");
    __syncthreads();
    if (threadIdx.x == 0) {
        unsigned* bar = b.bar;
        __builtin_amdgcn_s_waitcnt(0);
        unsigned nloc = b.st[0], nx = b.st[1];
        if (nloc == 0u) { xcd_barrier_complete(bar, b.x, nloc, nx); b.st[0] = nloc; b.st[1] = nx; }
        const unsigned old = xb_add(&bar[XB_XSUB(b.x)], 1u);
        const unsigned gen = old / nloc;
        if (old + 1u == (gen + 1u) * nloc) {
            __builtin_amdgcn_fence(__ATOMIC_RELEASE, "agent");
            asm volatile("s_waitcnt vmcnt(0)" ::: "memory");
            const unsigned og = xb_add(&bar[XB_TOP], 1u);
            const unsigned tg = og / nx;
            if (og + 1u == (tg + 1u) * nx) xb_add(&bar[XB_TOPGEN], 1u);
            else XB_SPIN(xb_ld(&bar[XB_TOPGEN]) == tg, bar);
            __builtin_amdgcn_fence(__ATOMIC_ACQUIRE, "agent");
            xb_add(&bar[XB_XGEN(b.x)], 1u);
            asm volatile("s_waitcnt vmcnt(0)" ::: "memory");
        } else {
            XB_SPIN(xb_ld(&bar[XB_XGEN(b.x)]) == gen, bar);
            __builtin_amdgcn_fence(__ATOMIC_ACQUIRE, "agent");
            asm volatile("s_waitcnt vmcnt(0)" ::: "memory");
        }
    }
    __syncthreads();
}

struct Params { const float* in[N_IN]; float* out; unsigned char* ws; int ph_lo, ph_hi; };
static_assert(sizeof(Params) == N_IN * 8 + 8 + 8 + 8, "Params has no padding bytes");
constexpr int NWAVES = 8, NTHR = NWAVES * 64;
#define WSP(T_, off) ((T_*)(p.ws + (off)))

__device__ __forceinline__ float wave_sum(float v) {
#pragma unroll
    for (int o = 1; o < 64; o <<= 1) v += __shfl_xor(v, o);
    return v;
}
__device__ __forceinline__ unsigned pkbf(float lo, float hi) { return pg8::cvt_pk_bf16(lo, hi); }
__device__ __forceinline__ float bf_lo(unsigned w) { return __uint_as_float(w << 16); }
__device__ __forceinline__ float bf_hi(unsigned w) { return __uint_as_float(w & 0xffff0000u); }

__device__ __forceinline__ void transpose_item(const float* W, int ldw, int src_col0, bf16* WT, int K, int dst_row0, const float* gain, int mode, LAS float* scr, int kb, int lane) {
    const int k0 = 64 * kb;
    { const int ks = lane >> 3, n4 = (lane & 7) * 4; f32x4 v[8];
#pragma unroll
      for (int i = 0; i < 8; ++i) v[i] = *(const f32x4*)(W + (size_t)(k0 + 8 * i + ks) * ldw + src_col0 + n4);
#pragma unroll
      for (int i = 0; i < 8; ++i) { const int kk = 8 * i + ks; const float g = gain ? gain[k0 + kk] : 1.0f; LAS float* d = scr + kk * 33 + n4; d[0] = v[i].x * g; d[1] = v[i].y * g; d[2] = v[i].z * g; d[3] = v[i].w * g; } }
    LDS_WAIT(); asm volatile("" ::: "memory");
    const int c = lane & 7;
#pragma unroll
    for (int j = 0; j < 4; ++j) { const int n = (lane >> 3) + 8 * j; const LAS float* s = scr + (8 * c) * 33 + n;
        const int dn = mode ? (8 * ((n >> 2) & 3) + 4 * (n >> 4) + (n & 3)) : n;
        v4u o; o.x = pkbf(s[0 * 33], s[1 * 33]); o.y = pkbf(s[2 * 33], s[3 * 33]); o.z = pkbf(s[4 * 33], s[5 * 33]); o.w = pkbf(s[6 * 33], s[7 * 33]);
        *(GAS v4u*)(WT + (size_t)(dst_row0 + dn) * K + k0 + 8 * c) = o; }
    LDS_WAIT(); asm volatile("" ::: "memory");
}

__device__ __forceinline__ void p0_prologue(const Params& p, LAS unsigned char* lds, int wave, int lane) {
    LAS float* scr = (LAS float*)(lds + wave * 16384);
    const int gw = blockIdx.x * NWAVES + wave, NGW = gridDim.x * NWAVES;
    constexpr int J0 = 16 * 25, J1 = 8 * 48, J2 = 4 * 32, J3 = 4 * 32, J4 = 16 * 32, J5 = 16 * 192, J6 = 48 * 32, J7 = 16 * 64, J8 = 128, J9 = 16 * 32;
    constexpr int NITEMS = J0 + J1 + J2 + J3 + J4 + 2 * J5 + 2 * J6 + J7 + J8 + J9;
    for (int it = gw; it < NITEMS; it += NGW) {
        int r = it;
        if (r < J0) { const int kb = r / 25, nb = r % 25; transpose_item(p.in[I_WD], 800, 32 * nb, WSP(bf16, WS_WD), 1024, 32 * nb, nullptr, 0, scr, kb, lane); continue; } r -= J0;
        if (r < J1) { const int kb = r / 48, db = r % 48; int src, mode;
            if (db < 32) { const int pn = db >> 3, bj = (db >> 2) & 1, wc = db & 3; src = (4 * pn + wc) * QKD + 32 * bj; mode = 0; }
            else { const int rb = db - 32, pr = rb >> 3, bj = (rb >> 2) & 1, wc = rb & 3; src = (8 * pr + 4 * bj + wc) * QKD + QKN; mode = 1; }
            transpose_item(p.in[I_WUQ], NH * QKD, src, WSP(bf16, WS_WUQ), QL, 32 * db, p.in[I_GQL], mode, scr, kb, lane); continue; } r -= J1;
        if (r < J2) { const int kb = r / 32, db = r % 32, pn = db >> 3, bj = (db >> 2) & 1, wc = db & 3;
            transpose_item(p.in[I_WUK], NH * QKN, (4 * pn + wc) * QKN + 32 * bj, WSP(bf16, WS_WK), KVL, 32 * db, nullptr, 0, scr, kb, lane); continue; } r -= J2;
        if (r < J3) { const int kb = r / 32, db = r % 32; transpose_item(p.in[I_WUV], NH * VH, 32 * db, WSP(bf16, WS_WV), KVL, 32 * db, nullptr, 0, scr, kb, lane); continue; } r -= J3;
        if (r < J4) { const int kb = r / 32, db = r % 32; transpose_item(p.in[I_WO], D, 32 * db, WSP(bf16, WS_WO), D, 32 * db, nullptr, 0, scr, kb, lane); continue; } r -= J4;
        if (r < 2 * J5) { const int l = r / J5, q = r % J5, kb = q / 192, db = q % 192, pn = db >> 3, bj = (db >> 2) & 1, cb = db & 3;
            transpose_item(p.in[I_WUP] + (size_t)l * D * 2 * DFF, 2 * DFF, bj * DFF + 128 * pn + 32 * cb, WSP(bf16, WS_WUP) + (size_t)l * 2 * DFF * D, D, 32 * db, p.in[I_NFFN] + l * D, 0, scr, kb, lane); continue; } r -= 2 * J5;
        if (r < 2 * J6) { const int l = r / J6, q = r % J6, kb = q / 32, db = q % 32;
            transpose_item(p.in[I_WDN] + (size_t)l * DFF * D, D, 32 * db, WSP(bf16, WS_WDN) + (size_t)l * D * DFF, DFF, 32 * db, nullptr, 0, scr, kb, lane); continue; } r -= 2 * J6;
        if (r < J7) { const int kb = r / 64, db = r % 64, pn = db >> 3, bj = (db >> 2) & 1, cb = db & 3;
            transpose_item(p.in[I_WIN], 2 * D, bj * D + 128 * pn + 32 * cb, WSP(bf16, WS_WIN), D, 32 * db, p.in[I_NMIX] + D, 0, scr, kb, lane); continue; } r -= J7;
        if (r < J8) { const int kb = r & 1, q = r >> 1, cb = q & 3, bj = (q >> 2) & 1, nb = q >> 3;
            transpose_item((bj ? p.in[I_WI] : p.in[I_WA]) + (size_t)nb * LB * LB, LB, 32 * cb, WSP(bf16, WS_WAI), LB, 256 * nb + 128 * bj + 32 * cb, nullptr, 0, scr, kb, lane); continue; } r -= J8;
        { const int kb = r / 32, db = r % 32; transpose_item(p.in[I_WOUT], D, 32 * db, WSP(bf16, WS_WOUT), D, 32 * db, nullptr, 0, scr, kb, lane); }
    }
    { GAS v4u* z = (GAS v4u*)(WSP(bf16, WS_WD) + (size_t)800 * 1024); const int n16 = 224 * 1024 * 2 / 16;
      for (int i = blockIdx.x * NTHR + threadIdx.x; i < n16; i += gridDim.x * NTHR) z[i] = (v4u){0u, 0u, 0u, 0u}; }
    for (int i = blockIdx.x * NTHR + threadIdx.x; i < NROPE * 16; i += gridDim.x * NTHR) {
        const int rr = i >> 4, fi = i & 15; const double pos = (double)(rr < T ? rr : PAST + (rr - T));
        const double inv = exp(-(double)fi * (9.210340371976184 / 16.0));
        double ang = pos * inv; const double k = rint(ang * 0.15915494309189535); ang = fma(-k, 6.283185307179586, ang); ang = fma(-k, 2.4492935982947064e-16, ang);
        const float a = (float)ang;
        WSP(float, WS_RCOS)[i] = cosf(a); WSP(float, WS_RSIN)[i] = sinf(a);
    }
    for (int i = blockIdx.x * NTHR + threadIdx.x; i < D; i += gridDim.x * NTHR) { const float l = p.in[I_LAM][i]; WSP(float, WS_SP8)[i] = -8.0f * ((l > 15.f) ? expf(-l) : log1pf(expf(-l))); }
    for (int i = blockIdx.x * NTHR + threadIdx.x; i < 1024 * 64; i += gridDim.x * NTHR) {
        const int n = i >> 6, c0 = (i & 63) * 4, pn = n >> 8, bj = (n >> 7) & 1, wc = (n >> 5) & 3, pp = n & 31, col = (4 * pn + wc) * QKN + 32 * bj + pp;
        const float* w = p.in[I_WUK] + (size_t)c0 * (NH * QKN) + col;
        int v = __builtin_amdgcn_cvt_pk_fp8_f32(16.f * w[0], 16.f * w[NH * QKN], 0, false); v = __builtin_amdgcn_cvt_pk_fp8_f32(16.f * w[2 * NH * QKN], 16.f * w[3 * NH * QKN], v, true);
        *(int*)(p.ws + WS_WK8 + (size_t)n * KVL + c0) = v;
    }
    {
        const GAS f32x4* gr = (const GAS f32x4*)p.in[I_NMIX] + lane;
        f32x4 v[4], nv[4];
#define XN_LOAD(dst, mm) do { const float* xrow_ = ((mm) < MP) ? p.in[I_XP] + (size_t)(mm) * D : p.in[I_XS] + (size_t)((mm) - MP) * D; const GAS f32x4* xr_ = (const GAS f32x4*)xrow_ + lane; \
            _Pragma("unroll") for (int j = 0; j < 4; ++j) dst[j] = xr_[64 * j]; } while (0)
        if (gw < M) XN_LOAD(v, gw);
        for (int m = gw; m < M; m += NGW) {
            if (m + NGW < M) XN_LOAD(nv, m + NGW);
            float s = 0.f;
#pragma unroll
            for (int j = 0; j < 4; ++j) s += (v[j].x * v[j].x + v[j].y * v[j].y) + (v[j].z * v[j].z + v[j].w * v[j].w);
            const float rs = __builtin_amdgcn_rsqf(wave_sum(s) * (1.f / D) + EPS);
            GAS unsigned long long* o8 = (GAS unsigned long long*)(WSP(bf16, WS_XN) + (size_t)m * D) + lane;
#pragma unroll
            for (int j = 0; j < 4; ++j) { const f32x4 g = gr[64 * j]; o8[64 * j] = (unsigned long long)pkbf(v[j].x * rs * g.x, v[j].y * rs * g.y) | ((unsigned long long)pkbf(v[j].z * rs * g.z, v[j].w * rs * g.w) << 32); }
#pragma unroll
            for (int j = 0; j < 4; ++j) v[j] = nv[j];
        }
#undef XN_LOAD
    }
}

__device__ __forceinline__ void thin_gather(const Params& p, int gw, int NGW, int lane) {
    const int* pt = (const int*)p.in[I_PT];
    f32x4 a[16];
#define GATHER_LOAD(src_) do { _Pragma("unroll") for (int i = 0; i < 16; ++i) a[i] = __builtin_nontemporal_load((const f32x4*)((src_) + (size_t)i * KVL)); } while (0)
    for (int pgi = gw; pgi < NSEQ * NPAGES; pgi += NGW) {
        const float* src = p.in[I_CCKV] + (size_t)pt[pgi] * PAGE * KVL + 4 * lane;
        unsigned char* dst8 = p.ws + WS_CB8 + (size_t)pgi * PAGE * KVL + 4 * lane;
        GATHER_LOAD(src);
#pragma unroll 1
        for (int st = 0; st < 8; ++st) {
            int o8[16];
#pragma unroll
            for (int i = 0; i < 16; ++i) { int w = __builtin_amdgcn_cvt_pk_fp8_f32(a[i].x, a[i].y, 0, false); o8[i] = __builtin_amdgcn_cvt_pk_fp8_f32(a[i].z, a[i].w, w, true); }
            if (st < 7) GATHER_LOAD(src + (size_t)(st + 1) * 16 * KVL);
#pragma unroll
            for (int i = 0; i < 16; ++i) *(GAS int*)(dst8 + ((size_t)st * 16 + i) * KVL) = o8[i];
        }
    }
#undef GATHER_LOAD
    for (int r32 = gw; r32 < NSEQ * PAST / 32; r32 += NGW) {
        const int row0 = 32 * r32, bs = row0 >> 13, key0 = row0 & (PAST - 1), pg = pt[bs * NPAGES + (key0 >> 7)];
        const float* src = p.in[I_CKR] + ((size_t)pg * PAGE + (key0 & (PAGE - 1))) * QKR + 4 * lane;
        f32x4 v[4];
#pragma unroll
        for (int i = 0; i < 4; ++i) v[i] = __builtin_nontemporal_load((const f32x4*)(src + (size_t)i * 8 * QKR));
        bf16* dst = WSP(bf16, WS_KRB16) + (size_t)row0 * QKR + 4 * lane;
#pragma unroll
        for (int i = 0; i < 4; ++i) *(GAS unsigned long long*)(dst + (size_t)i * 8 * QKR) = (unsigned long long)pkbf(v[i].x, v[i].y) | ((unsigned long long)pkbf(v[i].z, v[i].w) << 32);
    }
}

__device__ __forceinline__ void thin_ckv_krope(const Params& p, int wave, int lane) {
    const int gw = blockIdx.x * NWAVES + wave, NGW = gridDim.x * NWAVES;
    const f32x4 gkv = *(const f32x4*)(p.in[I_GKV] + 4 * lane);
    const float gkr = p.in[I_GKR][lane & 31];
    f32x4 v = (f32x4){0.f, 0.f, 0.f, 0.f}, nv = v; float kr = 0.f, nkr = 0.f;
    if (gw < M) { v = *(const f32x4*)(WSP(float, WS_CKVRAW) + (size_t)gw * KVL + 4 * lane); kr = WSP(float, WS_KRRAW)[(size_t)gw * QKR + (lane & 31)]; }
    for (int m = gw; m < M; m += NGW) {
        if (m + NGW < M) { nv = *(const f32x4*)(WSP(float, WS_CKVRAW) + (size_t)(m + NGW) * KVL + 4 * lane); nkr = WSP(float, WS_KRRAW)[(size_t)(m + NGW) * QKR + (lane & 31)]; }
        const int rr = pg8::rope_row(m), fi = lane & 15;
        const float cs = WSP(float, WS_RCOS)[rr * 16 + fi], sn = WSP(float, WS_RSIN)[rr * 16 + fi];
        const float rs = __builtin_amdgcn_rsqf(wave_sum((v.x * v.x + v.y * v.y) + (v.z * v.z + v.w * v.w)) * (1.f / KVL) + EPS);
        const f32x4 o = v * rs * gkv;
        float* oc = (m < MP) ? p.out + OFF_CKVP + (size_t)m * KVL : p.out + OFF_CKVS + (size_t)(m - MP) * KVL;
        *(f32x4*)(oc + 4 * lane) = o;
        unsigned long long w = (unsigned long long)pkbf(o.x, o.y) | ((unsigned long long)pkbf(o.z, o.w) << 32);
        *(unsigned long long*)(WSP(bf16, WS_CKVB) + (size_t)m * KVL + 4 * lane) = w;
        const float ssr = wave_sum(kr * kr) * 0.5f;
        const float n = kr * __builtin_amdgcn_rsqf(ssr * (1.f / QKR) + EPS) * gkr;
        const float other = __shfl_xor(n, 16);
        const float ro = ((lane & 16) == 0) ? (n * cs - other * sn) : (other * sn + n * cs);
        if (lane < 32) {
            float* ok = (m < MP) ? p.out + OFF_KRP + (size_t)m * QKR : p.out + OFF_KRS + (size_t)(m - MP) * QKR;
            ok[lane] = ro;
        }
        const float nb = __shfl_xor(ro, 1);
        if (lane < 32 && (lane & 1) == 0) *(unsigned*)(WSP(bf16, WS_KRB) + (size_t)m * QKR + lane) = pkbf(ro, nb);
        v = nv; kr = nkr;
    }
}

__device__ __forceinline__ void thin_qabs(const Params& p, int wave, int lane) {
    const int gw = blockIdx.x * NWAVES + wave, NGW = gridDim.x * NWAVES, l15 = lane & 15, fq = lane >> 4;
    for (int it = gw; it < NSEQ * NH; it += NGW) {
        const int bs = it >> 4, h = it & 15;
        bf16x8 af[2];
#pragma unroll
        for (int ks = 0; ks < 2; ++ks) {
            v4u w = (v4u){0u, 0u, 0u, 0u};
            if (l15 < DSEQ) {
                const v4u qv = *(const v4u*)(WSP(bf16, WS_Q) + (size_t)(MP + bs * DSEQ + l15) * (NH * QKD) + h * QKD + 32 * ks + 8 * fq);
                const f32x4 g0 = *(const f32x4*)(p.in[I_GKN] + 32 * ks + 8 * fq), g1 = *(const f32x4*)(p.in[I_GKN] + 32 * ks + 8 * fq + 4);
                w.x = pkbf(bf_lo(qv.x) * g0.x, bf_hi(qv.x) * g0.y); w.y = pkbf(bf_lo(qv.y) * g0.z, bf_hi(qv.y) * g0.w);
                w.z = pkbf(bf_lo(qv.z) * g1.x, bf_hi(qv.z) * g1.y); w.w = pkbf(bf_lo(qv.w) * g1.z, bf_hi(qv.w) * g1.w);
            }
            af[ks] = __builtin_bit_cast(bf16x8, w);
        }
#pragma unroll 4
        for (int nb = 0; nb < 16; ++nb) {
            f32x4 acc = (f32x4){0.f, 0.f, 0.f, 0.f};
#pragma unroll
            for (int ks = 0; ks < 2; ++ks) {
                const float* wp = p.in[I_WUK] + ((size_t)(16 * nb + l15) * NH + h) * QKN + 32 * ks + 8 * fq;
                const f32x4 b0 = *(const f32x4*)wp, b1 = *(const f32x4*)(wp + 4);
                v4u w; w.x = pkbf(b0.x, b0.y); w.y = pkbf(b0.z, b0.w); w.z = pkbf(b1.x, b1.y); w.w = pkbf(b1.z, b1.w);
                acc = __builtin_amdgcn_mfma_f32_16x16x32_bf16(af[ks], __builtin_bit_cast(bf16x8, w), acc, 0, 0, 0);
            }
            if (fq < 2) {
#pragma unroll
                for (int j = 0; j < 4; ++j) WSP(bf16, WS_QABS)[((size_t)bs * 128 + h * 8 + 4 * fq + j) * KVL + 16 * nb + l15] = (bf16)(pkbf(acc[j], 0.f) & 0xffffu);
            }
        }
    }
}

__device__ __forceinline__ void thin_combine_uv(const Params& p, LAS unsigned char* lds, int wave, int lane) {
    (void)lds;
    const int gw = blockIdx.x * NWAVES + wave, NGW = gridDim.x * NWAVES, l15 = lane & 15, fq = lane >> 4;
    for (int it = gw; it < NSEQ * NH; it += NGW) {
        const int bs = it >> 4, h = it & 15, col = h * 8 + (l15 & 7);
        float mx = -INFINITY, ms[NSPLIT], ls[NSPLIT], wgt[NSPLIT], L = 0.f;
#pragma unroll
        for (int s = 0; s < NSPLIT; ++s) { ms[s] = WSP(float, WS_MLM)[((size_t)bs * NSPLIT + s) * 128 + col];
            ls[s] = WSP(float, WS_MLL)[(((size_t)bs * NSPLIT + s) * 2 + 0) * 128 + col] + WSP(float, WS_MLL)[(((size_t)bs * NSPLIT + s) * 2 + 1) * 128 + col]; mx = fmaxf(mx, ms[s]); }
#pragma unroll
        for (int s = 0; s < NSPLIT; ++s) { wgt[s] = __builtin_amdgcn_exp2f(ms[s] - mx); L += ls[s] * wgt[s]; }
        const float il = l15 < DSEQ ? 1.0f / L : 0.f;
#pragma unroll
        for (int s = 0; s < NSPLIT; ++s) wgt[s] *= il;
        const float* cp = WSP(float, WS_CTXP) + ((size_t)bs * NSPLIT * 128 + col) * KVL + 8 * fq;
        const bf16* wr = WSP(bf16, WS_WV) + (size_t)(h * VH + l15) * KVL + 8 * fq;
        f32x4 acc[4];
#pragma unroll
        for (int nb = 0; nb < 4; ++nb) acc[nb] = (f32x4){0.f, 0.f, 0.f, 0.f};
#pragma unroll
        for (int ks = 0; ks < 8; ++ks) {
            f32x4 a0 = (f32x4){0.f, 0.f, 0.f, 0.f}, a1 = a0;
#pragma unroll
            for (int s = 0; s < NSPLIT; ++s) { a0 += *(const f32x4*)(cp + (size_t)s * 128 * KVL + 32 * ks) * wgt[s]; a1 += *(const f32x4*)(cp + (size_t)s * 128 * KVL + 32 * ks + 4) * wgt[s]; }
            v4u w; w.x = pkbf(a0.x, a0.y); w.y = pkbf(a0.z, a0.w); w.z = pkbf(a1.x, a1.y); w.w = pkbf(a1.z, a1.w);
            const bf16x8 xb = __builtin_bit_cast(bf16x8, w);
#pragma unroll
            for (int nb = 0; nb < 4; ++nb) acc[nb] = __builtin_amdgcn_mfma_f32_16x16x32_bf16(*(const bf16x8*)(wr + (size_t)nb * 16 * KVL + 32 * ks), xb, acc[nb], 0, 0, 0);
        }
        if (l15 < DSEQ) {
#pragma unroll
            for (int nb = 0; nb < 4; ++nb)
                *(unsigned long long*)(WSP(bf16, WS_O) + (size_t)(MP + bs * DSEQ + l15) * D + h * VH + 16 * nb + 4 * fq) = (unsigned long long)pkbf(acc[nb][0], acc[nb][1]) | ((unsigned long long)pkbf(acc[nb][2], acc[nb][3]) << 32);
        }
    }
}

__device__ __forceinline__ void thin_ffn_fix(const Params& p, int layer, int blk0, int nblk) {
    const float* cw = p.in[I_FCW] + (size_t)layer * 3 * DFF; const float* cb = p.in[I_FCB] + (size_t)layer * DFF;
    const float* HG = WSP(float, WS_HEADG); const float* HU = WSP(float, WS_HEADU); const float* TG = WSP(float, WS_TAILG);
    const int NIT = nblk * (DFF / 4);
    for (int it = threadIdx.x; it < NIT; it += NTHR) {
        const int blk = blk0 + it / (DFF / 4), ch = (it % (DFF / 4)) * 4;
        const f32x4 w0 = *(const f32x4*)(cw + ch), w1 = *(const f32x4*)(cw + DFF + ch), w2 = *(const f32x4*)(cw + 2 * DFF + ch), bb = *(const f32x4*)(cb + ch);
        f32x4 gm2 = (f32x4){0.f, 0.f, 0.f, 0.f}, gm1 = gm2;
        if ((blk & 31) != 0) { gm2 = *(const f32x4*)(TG + ((size_t)(blk - 1) * 2 + 0) * DFF + ch); gm1 = *(const f32x4*)(TG + ((size_t)(blk - 1) * 2 + 1) * DFF + ch); }
        const f32x4 g0 = *(const f32x4*)(HG + ((size_t)blk * 2 + 0) * DFF + ch), g1 = *(const f32x4*)(HG + ((size_t)blk * 2 + 1) * DFF + ch);
        const f32x4 u0 = *(const f32x4*)(HU + ((size_t)blk * 2 + 0) * DFF + ch), u1 = *(const f32x4*)(HU + ((size_t)blk * 2 + 1) * DFF + ch);
        f32x4 h0, h1;
#pragma unroll
        for (int j = 0; j < 4; ++j) { h0[j] = pg8::silu_f(gm2[j] * w0[j] + gm1[j] * w1[j] + g0[j] * w2[j] + bb[j]) * u0[j];
            h1[j] = pg8::silu_f(gm1[j] * w0[j] + g0[j] * w1[j] + g1[j] * w2[j] + bb[j]) * u1[j]; }
        bf16* hb = WSP(bf16, WS_HB) + (size_t)blk * 64 * DFF + ch;
        *(unsigned long long*)hb = (unsigned long long)pkbf(h0[0], h0[1]) | ((unsigned long long)pkbf(h0[2], h0[3]) << 32);
        *(unsigned long long*)(hb + DFF) = (unsigned long long)pkbf(h1[0], h1[1]) | ((unsigned long long)pkbf(h1[2], h1[3]) << 32);
    }
}

__device__ __forceinline__ void thin_rec_fix(const Params& p, int blk0, int nblk, int ch0) {
    const float* cw = p.in[I_RCW]; const float* cb = p.in[I_RCB]; const float* HX = WSP(float, WS_HEADX); const float* TX = WSP(float, WS_TAILX);
    for (int it = threadIdx.x; it < nblk * 32; it += NTHR) {
        const int blk = blk0 + (it >> 5), ch = ch0 + (it & 31) * 4;
        const f32x4 w0 = *(const f32x4*)(cw + ch), w1 = *(const f32x4*)(cw + D + ch), w2 = *(const f32x4*)(cw + 2 * D + ch), w3 = *(const f32x4*)(cw + 3 * D + ch), bb = *(const f32x4*)(cb + ch);
        f32x4 x3 = (f32x4){0.f, 0.f, 0.f, 0.f}, x2 = x3, x1 = x3;
        if ((blk & 31) != 0) { const float* t = TX + (size_t)(blk - 1) * 3 * D + ch; x3 = *(const f32x4*)t; x2 = *(const f32x4*)(t + D); x1 = *(const f32x4*)(t + 2 * D); }
#pragma unroll
        for (int r = 0; r < 3; ++r) { const f32x4 x0 = *(const f32x4*)(HX + ((size_t)blk * 3 + r) * D + ch);
            const f32x4 y = x3 * w0 + x2 * w1 + x1 * w2 + x0 * w3 + bb;
            *(unsigned long long*)(WSP(bf16, WS_XC) + ((size_t)blk * 64 + r) * D + ch) = (unsigned long long)pkbf(y.x, y.y) | ((unsigned long long)pkbf(y.z, y.w) << 32);
            x3 = x2; x2 = x1; x1 = x0; }
    }
}

__device__ __forceinline__ void thin_scan1(const Params& p) {
    const float* LAp = WSP(float, WS_LA); const float* BXp = WSP(float, WS_BX);
    for (int it = blockIdx.x * NTHR + threadIdx.x; it < NBATCH * 16 * D; it += gridDim.x * NTHR) {
        const int ch = it & (D - 1), bc = it >> 10; const size_t r0 = (size_t)bc * 128;
        float h = 0.f, pa = 1.f;
#pragma unroll 8
        for (int r = 0; r < 128; ++r) { const float a = LAp[(r0 + r) * D + ch], b = BXp[(r0 + r) * D + ch]; h = a * h + b; pa *= a; }
        WSP(float, WS_PA)[(size_t)bc * D + ch] = pa; WSP(float, WS_HL)[(size_t)bc * D + ch] = h;
    }
    for (int it = blockIdx.x * NTHR + threadIdx.x; it < NSEQ * D; it += gridDim.x * NTHR) {
        const int ch = it & (D - 1), bs = it >> 10; const size_t r0 = (size_t)MP + bs * DSEQ;
        float h = p.in[I_SLH][(size_t)bs * D + ch];
#pragma unroll
        for (int r = 0; r < DSEQ; ++r) { h = LAp[(r0 + r) * D + ch] * h + BXp[(r0 + r) * D + ch];
            const bf16 g = WSP(bf16, WS_GATE)[(r0 + r) * D + ch];
            WSP(bf16, WS_Y)[(r0 + r) * D + ch] = (bf16)(pkbf(h * __uint_as_float((unsigned)g << 16), 0.f) & 0xffffu); }
        p.out[OFF_LHS + (size_t)bs * D + ch] = h;
    }
}
__device__ __forceinline__ void thin_scan2(const Params& p) {
    const float* LAp = WSP(float, WS_LA); const float* BXp = WSP(float, WS_BX);
    for (int it = blockIdx.x * NTHR + threadIdx.x; it < NBATCH * 16 * D; it += gridDim.x * NTHR) {
        const int ch = it & (D - 1), bc = it >> 10, c = bc & 15; const size_t r0 = (size_t)bc * 128;
        float h = 0.f;
        for (int cc = 0; cc < c; ++cc) h = WSP(float, WS_PA)[(size_t)(bc - c + cc) * D + ch] * h + WSP(float, WS_HL)[(size_t)(bc - c + cc) * D + ch];
#pragma unroll 8
        for (int r = 0; r < 128; ++r) { h = LAp[(r0 + r) * D + ch] * h + BXp[(r0 + r) * D + ch];
            const bf16 g = WSP(bf16, WS_GATE)[(r0 + r) * D + ch];
            WSP(bf16, WS_Y)[(r0 + r) * D + ch] = (bf16)(pkbf(h * __uint_as_float((unsigned)g << 16), 0.f) & 0xffffu); }
        if (c == 15) p.out[OFF_LHP + (size_t)(bc >> 4) * D + ch] = h;
    }
}


typedef float f32x16 __attribute__((ext_vector_type(16)));
typedef short s16x4 __attribute__((ext_vector_type(4)));
#define MFMA32(a, b, c) __builtin_amdgcn_mfma_f32_32x32x16_bf16((a), (b), (c), 0, 0, 0)
#define MFMA16(a, b, c) __builtin_amdgcn_mfma_f32_16x16x32_bf16((a), (b), (c), 0, 0, 0)

struct GatherBg { f32x4 a[8]; f32x4 k; int it, n, pst; bool pend; };
__device__ __forceinline__ void bg_init(GatherBg& g, int n) { g.it = 0; g.n = n; g.pst = 0; g.pend = false; }
__device__ __forceinline__ void bg_step(const Params& p, GatherBg& g, int pg0, int tid) {
    const int lane = tid & 63, w = __builtin_amdgcn_readfirstlane(tid >> 6);
    const int* pt = (const int*)p.in[I_PT];
    if (g.pend) {
        const int pgi = pg0 + (g.pst >> 1); const size_t r0 = (size_t)pgi * PAGE + 64 * (g.pst & 1);
        unsigned char* d8 = p.ws + WS_CB8 + (r0 + 8 * w) * KVL + 4 * lane;
#pragma unroll
        for (int i = 0; i < 8; ++i) { int v = __builtin_amdgcn_cvt_pk_fp8_f32(g.a[i].x, g.a[i].y, 0, false); v = __builtin_amdgcn_cvt_pk_fp8_f32(g.a[i].z, g.a[i].w, v, true); *(GAS int*)(d8 + (size_t)i * KVL) = v; }
        *(GAS unsigned long long*)(WSP(bf16, WS_KRB16) + r0 * QKR + 4 * tid) = (unsigned long long)pkbf(g.k.x, g.k.y) | ((unsigned long long)pkbf(g.k.z, g.k.w) << 32);
        g.pend = false;
    }
    if (g.it < g.n) {
        const int pgi = pg0 + (g.it >> 1);
        if (pgi < NSEQ * NPAGES) {
            const size_t s0 = (size_t)pt[pgi] * PAGE + 64 * (g.it & 1);
            const float* src = p.in[I_CCKV] + (s0 + 8 * w) * KVL + 4 * lane;
#pragma unroll
            for (int i = 0; i < 8; ++i) g.a[i] = __builtin_nontemporal_load((const f32x4*)(src + (size_t)i * KVL));
            g.k = __builtin_nontemporal_load((const f32x4*)(p.in[I_CKR] + s0 * QKR + 4 * tid));
            g.pst = g.it; g.pend = true;
        }
        ++g.it;
    }
}

constexpr int PA_KP = 208, PA_VP = 144;
constexpr int PA_KB = 64 * PA_KP, PA_VB = 64 * PA_VP, PA_BUF = PA_KB + PA_VB;
__device__ __forceinline__ void pa_unit(const Params& p, LAS unsigned char* lds, int b, int h, int qb, GatherBg& bg, int pg0) {
    int tid_ = threadIdx.x; asm volatile("" : "+v"(tid_));
    const int tid = tid_, lane = tid & 63, w = __builtin_amdgcn_readfirstlane(tid >> 6), r32 = lane & 31, hi = lane >> 5;
    const bf16* Kg = WSP(bf16, WS_K96) + (size_t)(b * NH + h) * T * QKD;
    const bf16* Vg = WSP(bf16, WS_VT) + (size_t)(b * NH + h) * VH * T;
    const int NT = 4 * (qb + 1);
    const int qrow = b * T + qb * 256 + w * 32 + r32, qabs = qb * 256 + w * 32 + r32;
    const int kc0 = tid, kc1 = 512 + tid;
    const int kl0 = (kc0 / 12) * PA_KP + (kc0 % 12) * 16, kl1 = (kc1 / 12) * PA_KP + (kc1 % 12) * 16;
    const int vd = tid >> 3, vcc = tid & 7, vl = PA_KB + vd * PA_VP + vcc * 16;
    v4u rk0, rk1 = (v4u){0u, 0u, 0u, 0u}, rv;
#define PA_LOAD(kt) do { const bf16* ks_ = Kg + (size_t)(kt) * 64 * QKD; rk0 = *(const v4u*)(ks_ + kc0 * 8); if (tid < 256) rk1 = *(const v4u*)(ks_ + kc1 * 8); \
        rv = *(const v4u*)(Vg + (size_t)vd * T + (kt) * 64 + vcc * 8); } while (0)
#define PA_STORE(buf) do { LAS unsigned char* b_ = lds + (buf) * PA_BUF; *(LAS v4u*)(b_ + kl0) = rk0; if (tid < 256) *(LAS v4u*)(b_ + kl1) = rk1; *(LAS v4u*)(b_ + vl) = rv; } while (0)
    PA_LOAD(0);
    bf16x8 qf[6];
#pragma unroll
    for (int d0 = 0; d0 < 6; ++d0) qf[d0] = *(const bf16x8*)(WSP(bf16, WS_Q) + (size_t)qrow * (NH * QKD) + h * QKD + 16 * d0 + 8 * hi);
    __syncthreads();
    PA_STORE(0);
    __syncthreads();
    f32x16 o0, o1;
#pragma unroll
    for (int r = 0; r < 16; ++r) { o0[r] = 0.f; o1[r] = 0.f; }
    float l_run = 0.f;
    const int pi = (r32 & 0x13) | ((r32 & 4) << 1) | ((r32 & 8) >> 1);
    const int qmax_w = qb * 256 + w * 32 + 31, qmin_w = qb * 256 + w * 32;
    for (int kt = 0; kt < NT; ++kt) {
        if (kt + 1 < NT) PA_LOAD(kt + 1);
        if (kt * 64 <= qmax_w) {
            const LAS unsigned char* Kb = lds + (kt & 1) * PA_BUF; const LAS unsigned char* Vb = Kb + PA_KB;
            f32x16 p0, p1;
#pragma unroll
            for (int r = 0; r < 16; ++r) { p0[r] = 0.f; p1[r] = 0.f; }
#pragma unroll
            for (int d0 = 0; d0 < 6; ++d0) {
                const bf16x8 a0 = *(const LAS bf16x8*)(Kb + pi * PA_KP + (16 * d0 + 8 * hi) * 2);
                const bf16x8 a1 = *(const LAS bf16x8*)(Kb + (32 + pi) * PA_KP + (16 * d0 + 8 * hi) * 2);
                p0 = MFMA32(a0, qf[d0], p0); p1 = MFMA32(a1, qf[d0], p1);
            }
            if (kt * 64 + 63 > qmin_w) {
                const int kb = kt * 64 + 8 * hi;
#pragma unroll
                for (int r = 0; r < 16; ++r) { const int key = kb + 16 * (r >> 3) + (r & 7); if (key > qabs) p0[r] = -INFINITY; if (key + 32 > qabs) p1[r] = -INFINITY; }
            }
            float ls = 0.f;
#pragma unroll
            for (int r = 0; r < 16; ++r) { p0[r] = __builtin_amdgcn_exp2f(p0[r]); p1[r] = __builtin_amdgcn_exp2f(p1[r]); ls += p0[r] + p1[r]; }
            l_run += ls;
            bf16x8 pb[4];
#pragma unroll
            for (int ks = 0; ks < 2; ++ks) {
                v4u w0, w1;
                w0.x = pkbf(p0[8 * ks + 0], p0[8 * ks + 1]); w0.y = pkbf(p0[8 * ks + 2], p0[8 * ks + 3]); w0.z = pkbf(p0[8 * ks + 4], p0[8 * ks + 5]); w0.w = pkbf(p0[8 * ks + 6], p0[8 * ks + 7]);
                w1.x = pkbf(p1[8 * ks + 0], p1[8 * ks + 1]); w1.y = pkbf(p1[8 * ks + 2], p1[8 * ks + 3]); w1.z = pkbf(p1[8 * ks + 4], p1[8 * ks + 5]); w1.w = pkbf(p1[8 * ks + 6], p1[8 * ks + 7]);
                pb[ks] = __builtin_bit_cast(bf16x8, w0); pb[2 + ks] = __builtin_bit_cast(bf16x8, w1);
            }
#pragma unroll
            for (int ks = 0; ks < 4; ++ks) {
                const bf16x8 v0 = *(const LAS bf16x8*)(Vb + r32 * PA_VP + (16 * ks + 8 * hi) * 2);
                const bf16x8 v1 = *(const LAS bf16x8*)(Vb + (32 + r32) * PA_VP + (16 * ks + 8 * hi) * 2);
                o0 = MFMA32(v0, pb[ks], o0); o1 = MFMA32(v1, pb[ks], o1);
            }
        }
        if (kt + 1 < NT) PA_STORE((kt + 1) & 1);
        bg_step(p, bg, pg0, tid);
        __syncthreads();
    }
    const float lt = l_run + __shfl_xor(l_run, 32), il = 1.0f / lt;
    bf16* op = WSP(bf16, WS_O) + (size_t)qrow * D + h * VH;
#pragma unroll
    for (int g = 0; g < 4; ++g) {
        unsigned long long w0 = (unsigned long long)pkbf(o0[4 * g] * il, o0[4 * g + 1] * il) | ((unsigned long long)pkbf(o0[4 * g + 2] * il, o0[4 * g + 3] * il) << 32);
        unsigned long long w1 = (unsigned long long)pkbf(o1[4 * g] * il, o1[4 * g + 1] * il) | ((unsigned long long)pkbf(o1[4 * g + 2] * il, o1[4 * g + 3] * il) << 32);
        *(unsigned long long*)(op + 8 * g + 4 * hi) = w0; *(unsigned long long*)(op + 32 + 8 * g + 4 * hi) = w1;
    }
#undef PA_LOAD
#undef PA_STORE
}

constexpr int SA_CP = 528, SA_KP = 80, SA_PP = 144;
constexpr int SA_CB = 64 * SA_CP, SA_KB = 64 * SA_KP, SA_RB = 64 * 64, SA_BUF = SA_CB + SA_KB + SA_RB;
constexpr int SA_PT = 2 * SA_BUF, SA_SMX = SA_PT + 128 * SA_PP, SA_END = SA_SMX + 2 * 128 * 4;
__device__ __forceinline__ void sa_unit(const Params& p, LAS unsigned char* lds, int bs, int sp) {
    int tid_ = threadIdx.x; asm volatile("" : "+v"(tid_));
    const int tid = tid_, lane = tid & 63, w = __builtin_amdgcn_readfirstlane(tid >> 6), wr = w >> 2, wc = w & 3, l15 = lane & 15, fq = lane >> 4;
    bf16x8 qa[2][8], qrp[2];
#pragma unroll
    for (int n = 0; n < 2; ++n) {
        const int col = 32 * wc + 16 * n + l15;
#pragma unroll
        for (int ks = 0; ks < 8; ++ks) qa[n][ks] = *(const bf16x8*)(WSP(bf16, WS_QABS) + ((size_t)bs * 128 + col) * KVL + 32 * ks + 8 * fq);
        qrp[n] = *(const bf16x8*)(WSP(bf16, WS_Q) + (size_t)(MP + bs * DSEQ + (col & 7)) * (NH * QKD) + (col >> 3) * QKD + QKN + 8 * fq);
    }
    f32x4 ctx[8][2];
#pragma unroll
    for (int cb = 0; cb < 8; ++cb) { ctx[cb][0] = (f32x4){0.f, 0.f, 0.f, 0.f}; ctx[cb][1] = (f32x4){0.f, 0.f, 0.f, 0.f}; }
    float m_run[2] = {0.f, 0.f}, l_run[2] = {0.f, 0.f};
    const int NTC = (PAST / NSPLIT) / 64, NT = NTC + ((sp == NSPLIT - 1) ? 1 : 0);
    const size_t row0 = (size_t)bs * PAST + (size_t)sp * (PAST / NSPLIT);
    v4u rc[4], rx; bool ld8 = false;
    const int t5 = tid & 255, r5 = t5 >> 2, c5 = t5 & 3, rC = tid >> 3, cC = tid & 7;
    const int r8a = tid >> 4, c8 = tid & 15;
#define SA_LOAD(kt) do { const bool nw_ = (kt) >= NTC; const size_t rb_ = nw_ ? (size_t)MP + bs * DSEQ : row0 + (size_t)(kt) * 64; ld8 = !nw_; \
        const unsigned char* xs_ = (tid < 256) ? (const unsigned char*)((nw_ ? WSP(bf16, WS_KRB) : WSP(bf16, WS_KRB16)) + rb_ * QKR) + r5 * 64 + c5 * 16 \
                                               : (const unsigned char*)((nw_ ? WSP(float, WS_RSN) + (size_t)bs * DSEQ * 16 : WSP(float, WS_RS) + rb_ * 16)) + r5 * 64 + c5 * 16; \
        if (!nw_) { const unsigned char* s8_ = p.ws + WS_CB8 + rb_ * KVL + (size_t)tid * 16; rc[0] = *(const v4u*)s8_; rc[1] = *(const v4u*)(s8_ + 8192); } \
        else if (rC < DSEQ) { const v4u* s4_ = (const v4u*)(WSP(bf16, WS_CKVB) + (rb_ + rC) * KVL + cC * 32); rc[0] = s4_[0]; rc[1] = s4_[1]; rc[2] = s4_[2]; rc[3] = s4_[3]; } \
        else { rc[0] = (v4u){0u, 0u, 0u, 0u}; rc[1] = rc[0]; rc[2] = rc[0]; rc[3] = rc[0]; } \
        if (!nw_ || r5 < DSEQ) rx = *(const v4u*)xs_; else rx = (v4u){0u, 0u, 0u, 0u}; } while (0)
#define SA_CVT8(w_) (pkbf(__builtin_amdgcn_cvt_pk_f32_fp8((int)(w_), false)[0], __builtin_amdgcn_cvt_pk_f32_fp8((int)(w_), false)[1]))
#define SA_CVT8H(w_) (pkbf(__builtin_amdgcn_cvt_pk_f32_fp8((int)(w_), true)[0], __builtin_amdgcn_cvt_pk_f32_fp8((int)(w_), true)[1]))
#define SA_STORE(buf) do { LAS unsigned char* b_ = lds + (buf) * SA_BUF; \
        if (ld8) { const v4u a_ = rc[0], c_ = rc[1]; LAS v4u* da_ = (LAS v4u*)(b_ + r8a * SA_CP + c8 * 32); LAS v4u* dc_ = (LAS v4u*)(b_ + (32 + r8a) * SA_CP + c8 * 32); \
            da_[0] = (v4u){SA_CVT8(a_.x), SA_CVT8H(a_.x), SA_CVT8(a_.y), SA_CVT8H(a_.y)}; da_[1] = (v4u){SA_CVT8(a_.z), SA_CVT8H(a_.z), SA_CVT8(a_.w), SA_CVT8H(a_.w)}; \
            dc_[0] = (v4u){SA_CVT8(c_.x), SA_CVT8H(c_.x), SA_CVT8(c_.y), SA_CVT8H(c_.y)}; dc_[1] = (v4u){SA_CVT8(c_.z), SA_CVT8H(c_.z), SA_CVT8(c_.w), SA_CVT8H(c_.w)}; } \
        else { LAS v4u* d4_ = (LAS v4u*)(b_ + rC * SA_CP + cC * 64); d4_[0] = rc[0]; d4_[1] = rc[1]; d4_[2] = rc[2]; d4_[3] = rc[3]; } \
        *(LAS v4u*)(b_ + SA_CB + ((tid < 256) ? 0 : SA_KB) + r5 * ((tid < 256) ? SA_KP : 64) + c5 * 16) = rx; } while (0)
    SA_LOAD(0);
    __syncthreads();
    SA_STORE(0);
    __syncthreads();
    LAS unsigned char* Pt = lds + SA_PT; LAS float* SMX = (LAS float*)(lds + SA_SMX);
    for (int kt = 0; kt < NT; ++kt) {
        if (kt + 1 < NT) SA_LOAD(kt + 1);
        const LAS unsigned char* Cb = lds + (kt & 1) * SA_BUF; const LAS unsigned char* Kb = Cb + SA_CB; const LAS unsigned char* Rb = Kb + SA_KB;
        f32x4 sn[2][2];
#pragma unroll
        for (int m = 0; m < 2; ++m)
#pragma unroll
            for (int n = 0; n < 2; ++n) sn[m][n] = (f32x4){0.f, 0.f, 0.f, 0.f};
#pragma unroll
        for (int ks = 0; ks < 8; ++ks) {
            bf16x8 a[2];
#pragma unroll
            for (int m = 0; m < 2; ++m) a[m] = *(const LAS bf16x8*)(Cb + (32 * wr + 16 * m + l15) * SA_CP + (32 * ks + 8 * fq) * 2);
#pragma unroll
            for (int m = 0; m < 2; ++m)
#pragma unroll
                for (int n = 0; n < 2; ++n) sn[m][n] = MFMA16(a[m], qa[n][ks], sn[m][n]);
            if (ks & 1) __builtin_amdgcn_sched_barrier(0);
        }
#pragma unroll
        for (int m = 0; m < 2; ++m)
#pragma unroll
            for (int n = 0; n < 2; ++n)
#pragma unroll
                for (int j = 0; j < 4; ++j) sn[m][n][j] *= *(const LAS float*)(Rb + (32 * wr + 16 * m + 4 * fq + j) * 64 + (4 * wc + 2 * n + (l15 >> 3)) * 4);
        {
            bf16x8 a[2];
#pragma unroll
            for (int m = 0; m < 2; ++m) a[m] = *(const LAS bf16x8*)(Kb + (32 * wr + 16 * m + l15) * SA_KP + fq * 16);
#pragma unroll
            for (int m = 0; m < 2; ++m)
#pragma unroll
                for (int n = 0; n < 2; ++n) sn[m][n] = MFMA16(a[m], qrp[n], sn[m][n]);
        }
        const bool newtile = (kt >= NTC);
#pragma unroll
        for (int n = 0; n < 2; ++n) { const int col = 32 * wc + 16 * n + l15; float ls = 0.f;
#pragma unroll
            for (int m = 0; m < 2; ++m) { float e[4];
#pragma unroll
                for (int j = 0; j < 4; ++j) { const int key = 32 * wr + 16 * m + 4 * fq + j; float sv = sn[m][n][j];
                    if (newtile && key > (l15 & 7)) sv = -INFINITY;
                    e[j] = __builtin_amdgcn_exp2f(sv); ls += e[j]; }
                *(LAS unsigned long long*)(Pt + col * SA_PP + (32 * wr + 16 * m + 4 * fq) * 2) = (unsigned long long)pkbf(e[0], e[1]) | ((unsigned long long)pkbf(e[2], e[3]) << 32); }
            l_run[n] += ls; }
        __syncthreads();
#pragma unroll
        for (int ks = 0; ks < 2; ++ks) {
            bf16x8 pb[2];
#pragma unroll
            for (int n = 0; n < 2; ++n) pb[n] = *(const LAS bf16x8*)(Pt + (32 * wc + 16 * n + l15) * SA_PP + (32 * ks + 8 * fq) * 2);
            const LAS unsigned char* tb = Cb + (32 * ks + 8 * fq + (l15 >> 2)) * SA_CP + (128 * wr + 4 * (l15 & 3)) * 2;
#pragma unroll
            for (int cb = 0; cb < 8; ++cb) {
                const s16x4 t0 = __builtin_bit_cast(s16x4, __builtin_amdgcn_ds_read_tr16_b64_v4i16((LAS s16x4*)(tb + cb * 32)));
                const s16x4 t1 = __builtin_bit_cast(s16x4, __builtin_amdgcn_ds_read_tr16_b64_v4i16((LAS s16x4*)(tb + 4 * SA_CP + cb * 32)));
                const bf16x8 at = (bf16x8){t0[0], t0[1], t0[2], t0[3], t1[0], t1[1], t1[2], t1[3]};
                ctx[cb][0] = MFMA16(at, pb[0], ctx[cb][0]); ctx[cb][1] = MFMA16(at, pb[1], ctx[cb][1]);
                if (cb & 1) __builtin_amdgcn_sched_barrier(0);
            }
        }
        if (kt + 1 < NT) SA_STORE((kt + 1) & 1);
        __syncthreads();
    }
#pragma unroll
    for (int n = 0; n < 2; ++n) { const int col = 32 * wc + 16 * n + l15; float l = l_run[n]; l += __shfl_xor(l, 16); l += __shfl_xor(l, 32);
        if (fq == 0) { WSP(float, WS_MLL)[(((size_t)bs * NSPLIT + sp) * 2 + wr) * 128 + col] = l; if (wr == 0) WSP(float, WS_MLM)[((size_t)bs * NSPLIT + sp) * 128 + col] = m_run[n]; }
#pragma unroll
        for (int cb = 0; cb < 8; ++cb) *(f32x4*)(WSP(float, WS_CTXP) + (((size_t)bs * NSPLIT + sp) * 128 + col) * KVL + 128 * wr + 16 * cb + 4 * fq) = ctx[cb][n]; }
#undef SA_LOAD
#undef SA_STORE
#undef SA_CVT8
#undef SA_CVT8H
}

#ifndef DBG_SA_ORACLE
#define DBG_SA_ORACLE 0
#endif
#ifndef DBG_SA_TOL
#define DBG_SA_TOL 0.10f
#endif
#if DBG_SA_ORACLE
__device__ __forceinline__ void dbg_sa_oracle(const Params& p, LAS unsigned char* lds) {
    const int tid = threadIdx.x;
    LAS float* red = (LAS float*)lds;
    const int seqs[3] = {0, 77, 127};
    for (int it2 = blockIdx.x; it2 < 3 * NH * 2 * 2; it2 += gridDim.x) {
        const int it = it2 >> 1, half = it2 & 1;
        const int bs = (it / (NH * 2)) == 0 ? 0 : ((it / (NH * 2)) == 1 ? 77 : 127), h = (it / 2) % NH, q = (it & 1) ? 7 : 0;
        (void)seqs;
        const bf16* qrow = WSP(bf16, WS_Q) + (size_t)(MP + bs * DSEQ + q) * (NH * QKD) + h * QKD;
        LAS float* qs = red + 512 * 65;
        __syncthreads();
        if (tid < 96) qs[tid] = __uint_as_float((unsigned)qrow[tid] << 16) * (tid < 64 ? p.in[I_GKN][tid] : 1.0f);
        __syncthreads();
        float acc[32]; float lsum = 0.f;
#pragma unroll
        for (int d = 0; d < 32; ++d) acc[d] = 0.f;
        const int L = PAST + q + 1;
        for (int l = tid; l < L; l += NTHR) {
            const float* crow; const float* krrow;
            if (l < PAST) { const int pg = ((const int*)p.in[I_PT])[bs * NPAGES + (l >> 7)]; crow = p.in[I_CCKV] + ((size_t)pg * PAGE + (l & 127)) * KVL; krrow = p.in[I_CKR] + ((size_t)pg * PAGE + (l & 127)) * QKR; }
            else { crow = p.out + OFF_CKVS + (size_t)(bs * DSEQ + (l - PAST)) * KVL; krrow = p.out + OFF_KRS + (size_t)(bs * DSEQ + (l - PAST)) * QKR; }
            float ss = 0.f, sn = 0.f;
#pragma nounroll
            for (int dh = 0; dh < 2; ++dh) {
                float kraw[32];
#pragma unroll
                for (int d = 0; d < 32; ++d) kraw[d] = 0.f;
#pragma nounroll
                for (int c = 0; c < KVL; ++c) { const float cv = crow[c]; const float* w = p.in[I_WUK] + ((size_t)c * NH + h) * QKN + dh * 32;
#pragma unroll
                    for (int d = 0; d < 32; ++d) kraw[d] += cv * w[d]; }
#pragma unroll
                for (int d = 0; d < 32; ++d) { ss += kraw[d] * kraw[d]; sn += qs[dh * 32 + d] * kraw[d]; }
            }
            const float rs = 1.0f / sqrtf(ss * (1.0f / 64.0f) + EPS);
            float s = sn * rs;
#pragma nounroll
            for (int r = 0; r < QKR; ++r) s += qs[QKN + r] * krrow[r];
            const float pw = exp2f(s); lsum += pw;
#pragma nounroll
            for (int c = 0; c < KVL; ++c) { const float cv = crow[c] * pw; const float* w = p.in[I_WUV] + ((size_t)c * NH + h) * VH + half * 32;
#pragma unroll
                for (int d = 0; d < 32; ++d) acc[d] += cv * w[d]; }
        }
        __syncthreads();
#pragma unroll
        for (int d = 0; d < 32; ++d) red[tid * 65 + d] = acc[d];
        red[tid * 65 + 64] = lsum;
        __syncthreads();
        float tsum = 0.f;
        if (tid < 32 || tid == 64) { for (int k = 0; k < NTHR; ++k) tsum += red[k * 65 + tid]; }
        __syncthreads();
        if (tid < 32 || tid == 64) red[tid] = tsum;
        __syncthreads();
        if (tid == 0) { const float lt = red[64]; float e2 = 0.f, r2 = 0.f;
            for (int d = 0; d < 32; ++d) { const float ref = red[d] / lt; const float got = __uint_as_float((unsigned)WSP(bf16, WS_O)[(size_t)(MP + bs * DSEQ + q) * D + h * VH + half * 32 + d] << 16); e2 += (got - ref) * (got - ref); r2 += ref * ref; }
            if (!(e2 <= DBG_SA_TOL * DBG_SA_TOL * r2)) p.out[OFF_YS + it2] = __builtin_nanf(""); }
        __syncthreads();
    }
}
#endif

__device__ __forceinline__ void g1_stream(const Params& p, LAS unsigned char* lds, int bid, int wave, int lane) {
#ifndef G1S_SROWS
#define G1S_SROWS 128
#endif
    constexpr int SROWS = G1S_SROWS, SBYTES = SROWS * KVL, ROWS = PAST / NSPLIT, NST = ROWS / SROWS, NSLOT = 131072 / SBYTES, LOOK = NSLOT - 1, NPC = SROWS / 32, NRB = SROWS / 16;
    static_assert((NSLOT & (NSLOT - 1)) == 0 && NSLOT >= 2 && NST > LOOK && (NPC % 4 == 0 || NPC == 4), "g1_stream ring");
    constexpr int VMW = LOOK * NRB + (LOOK - 1) * NPC;
    const unsigned char* A = p.ws + WS_CB8 + (size_t)bid * ROWS * KVL;
    float* RS = WSP(float, WS_RS) + (size_t)bid * ROWS * 16 + 2 * wave + ((lane >> 4) & 1);
    const int l15 = lane & 15, kq = lane >> 4;
    pg8::v8i32 Bf[8][2];
#pragma unroll
    for (int cb = 0; cb < 8; ++cb) { const int h = 2 * wave + (cb >> 2), nrow = 256 * (h >> 2) + 128 * ((cb >> 1) & 1) + 32 * (h & 3) + 16 * (cb & 1) + l15;
#pragma unroll
        for (int kb = 0; kb < 2; ++kb) Bf[cb][kb] = *(const pg8::v8i32*)(p.ws + WS_WK8 + (size_t)nrow * KVL + kb * 128 + kq * 32); }
    unsigned voff[4];
#pragma unroll
    for (int t = 0; t < 4; ++t) { const int r15 = 4 * t + (lane >> 4); voff[t] = (unsigned)(((SROWS / 8) * wave + r15) * KVL + (((lane & 15) ^ r15) << 4)); }
    const unsigned ldsb = (unsigned)(unsigned long long)lds + (unsigned)(wave * (SROWS / 8) * KVL);
#define G1S_STAGE(st_, slot_) do { _Pragma("unroll") for (int t_ = 0; t_ < NPC; ++t_) pg8::glds16s((const void*)(A + (t_ >> 2) * 16 * KVL), voff[t_ & 3] + (unsigned)(st_) * SBYTES, ldsb + (unsigned)(slot_) * SBYTES + t_ * 4 * KVL); } while (0)
#pragma unroll
    for (int s0 = 0; s0 < LOOK; ++s0) G1S_STAGE(s0, s0);
    const unsigned fo = (unsigned)(l15 * KVL + (((2 * kq) ^ l15) << 4));
    asm volatile("s_waitcnt vmcnt(0)" ::: "memory");
#ifndef G1S_SC
#define G1S_SC 0
#endif
#ifndef G1S_XMFMA
#define G1S_XMFMA 0
#endif
    f32x4 dum[4] = {{0.f, 0.f, 0.f, 0.f}, {0.f, 0.f, 0.f, 0.f}, {0.f, 0.f, 0.f, 0.f}, {0.f, 0.f, 0.f, 0.f}};
    f32x4 accA[8], accB[8];
#pragma unroll
    for (int cb = 0; cb < 8; ++cb) accB[cb] = (f32x4){0.f, 0.f, 0.f, 0.f};
#define G1S_RD1(dst_, rb_, kb_, hf_) do { const unsigned o_ = ((fo ^ (unsigned)((kb_) * 128)) ^ (unsigned)((hf_) * 16)) + (rb_) * 16 * KVL; const pg8::i32x4 t_ = *(LAS const pg8::i32x4*)(sb + o_); \
        dst_[kb_][(hf_) * 4 + 0] = t_[0]; dst_[kb_][(hf_) * 4 + 1] = t_[1]; dst_[kb_][(hf_) * 4 + 2] = t_[2]; dst_[kb_][(hf_) * 4 + 3] = t_[3]; } while (0)
#define G1S_SQ(s2_, v_) do { const pg8::f32x2 lo_ = (pg8::f32x2){v_[0], v_[1]}, hi_ = (pg8::f32x2){v_[2], v_[3]}; s2_ = __builtin_elementwise_fma(lo_, lo_, s2_); s2_ = __builtin_elementwise_fma(hi_, hi_, s2_); } while (0)
#define G1S_BLK(accN, aN, accP, prow_, RDN, aX, rbx_) do { pg8::f32x2 sa_ = (pg8::f32x2){0.f, 0.f}, sb2_ = (pg8::f32x2){0.f, 0.f}; float r0_ = 0.f, r1_ = 0.f; \
        _Pragma("unroll") for (int cb_ = 0; cb_ < 8; ++cb_) { \
            accN[cb_] = __builtin_amdgcn_mfma_scale_f32_16x16x128_f8f6f4(Bf[cb_][0], aN[0], (f32x4){0.f, 0.f, 0.f, 0.f}, 0, 0, 0, G1S_SC, 0, G1S_SC); \
            if (G1S_XMFMA) dum[cb_ & 3] = __builtin_amdgcn_mfma_scale_f32_16x16x128_f8f6f4(Bf[cb_][1], aN[0], dum[cb_ & 3], 0, 0, 0, G1S_SC, 0, G1S_SC); \
            if (cb_ < 4) G1S_SQ(sa_, accP[cb_]); else G1S_SQ(sb2_, accP[cb_]); \
            if (RDN && cb_ < 4) G1S_RD1(aX, rbx_, cb_ >> 1, cb_ & 1); \
            __builtin_amdgcn_sched_barrier(0); } \
        _Pragma("unroll") for (int cb_ = 0; cb_ < 8; ++cb_) { \
            accN[cb_] = __builtin_amdgcn_mfma_scale_f32_16x16x128_f8f6f4(Bf[cb_][1], aN[1], accN[cb_], 0, 0, 0, G1S_SC, 0, G1S_SC); \
            if (cb_ == 0) { const auto x_ = __builtin_amdgcn_permlane16_swap(__float_as_uint(sa_[0] + sa_[1]), __float_as_uint(sb2_[0] + sb2_[1]), false, false); r0_ = __uint_as_float(x_[0]) + __uint_as_float(x_[1]); } \
            if (cb_ == 1) { const auto y_ = __builtin_amdgcn_permlane32_swap(__float_as_uint(r0_), __float_as_uint(r0_), false, false); r1_ = __uint_as_float(y_[0]) + __uint_as_float(y_[1]); } \
            if (cb_ == 2) r1_ = __builtin_amdgcn_rsqf(r1_ * (1.0f / (QKN * 256.0f)) + EPS); \
            if (cb_ == 3) RS[(size_t)(prow_) * 16] = r1_; \
            __builtin_amdgcn_sched_barrier(0); } } while (0)
#pragma nounroll
    for (int st = 0; st < NST; ++st) {
        if (st) asm volatile("s_waitcnt vmcnt(%0)" :: "n"(VMW) : "memory");
        asm volatile("s_waitcnt lgkmcnt(0)" ::: "memory");
        __builtin_amdgcn_s_barrier();
        { const int nx = st + LOOK < NST ? st + LOOK : NST - 1; G1S_STAGE(nx, (st + LOOK) & (NSLOT - 1)); }
        LAS const unsigned char* sb = lds + (st & (NSLOT - 1)) * SBYTES;
        const int prow = ((st * SROWS - 16) & (ROWS - 1)) + l15;
        pg8::v8i32 Ac[2], An[2];
        G1S_RD1(Ac, 0, 0, 0); G1S_RD1(Ac, 0, 0, 1); G1S_RD1(Ac, 0, 1, 0); G1S_RD1(Ac, 0, 1, 1);
        __builtin_amdgcn_sched_barrier(0);
#pragma unroll
        for (int rb = 0; rb < NRB; rb += 2) {
            G1S_BLK(accA, Ac, accB, (rb ? st * SROWS + (rb - 1) * 16 + l15 : prow), true, An, rb + 1);
            G1S_BLK(accB, An, accA, (st * SROWS + rb * 16 + l15), (rb + 2 < NRB), Ac, rb + 2);
        }
    }
    { pg8::f32x2 sa = (pg8::f32x2){0.f, 0.f}, sb2 = (pg8::f32x2){0.f, 0.f};
#pragma unroll
      for (int cb = 0; cb < 4; ++cb) { G1S_SQ(sa, accB[cb]); G1S_SQ(sb2, accB[4 + cb]); }
      const auto x = __builtin_amdgcn_permlane16_swap(__float_as_uint(sa[0] + sa[1]), __float_as_uint(sb2[0] + sb2[1]), false, false); const float w = __uint_as_float(x[0]) + __uint_as_float(x[1]);
      const auto y = __builtin_amdgcn_permlane32_swap(__float_as_uint(w), __float_as_uint(w), false, false);
      RS[(size_t)(ROWS - 16 + l15) * 16] = __builtin_amdgcn_rsqf((__uint_as_float(y[0]) + __uint_as_float(y[1])) * (1.0f / (QKN * 256.0f)) + EPS); }
    if (G1S_XMFMA) asm volatile("" :: "v"(dum[0]), "v"(dum[1]), "v"(dum[2]), "v"(dum[3]));
#undef G1S_RD1
#undef G1S_SQ
#undef G1S_BLK
#undef G1S_STAGE
}

#ifndef DBG_F8_ORACLE
#define DBG_F8_ORACLE 0
#endif
#ifndef DBG_SA_ORACLE
#define DBG_SA_ORACLE 0
#endif
#ifndef DBG_SA_TOL
#define DBG_SA_TOL 0.10f
#endif
#ifndef DBG_TWICE
#define DBG_TWICE 0
#endif
#ifndef DBG_NANPOISON
#define DBG_NANPOISON 0
#endif
#ifndef MK_PER_PHASE
#define MK_PER_PHASE 0
#endif
constexpr int NPH = 21;
constexpr int NPA = 128;
constexpr int RING_BYTES = 131072, MISC_OFF = RING_BYTES + 320, XLDS_OFF = RING_BYTES + 4096, LDS_BYTES = 147456;
constexpr int CW_BAR = 4096;
static_assert((CW_BAR + XCD_BAR_WORDS) * 4 <= (int)CTL_ZERO_BYTES && SA_END <= RING_BYTES && 2 * PA_BUF <= RING_BYTES && pg8::STAGE_BYTES <= RING_BYTES, "LDS / CTL maps");

__global__ void __launch_bounds__(NTHR, 2) fwd_kernel(Params p) {
    extern __shared__ __attribute__((aligned(16))) unsigned char lds_raw[];
    LAS unsigned char* lds = (LAS unsigned char*)lds_raw;
    const int tid = threadIdx.x, lane = tid & 63, wave = __builtin_amdgcn_readfirstlane(tid >> 6);
    volatile LAS unsigned* MISC = (volatile LAS unsigned*)(lds + MISC_OFF);
    for (int u = tid; u < (LDS_BYTES - RING_BYTES) / 4; u += NTHR) ((LAS unsigned*)(lds + RING_BYTES))[u] = 0u;
    __syncthreads();
    const int lo = p.ph_lo, hi = p.ph_hi;
    XcdBarrier bar; bar.bar = (unsigned*)p.ws + CW_BAR; bar.x = 0; bar.st = nullptr;
    if (hi - lo > 1) bar = xcd_barrier_post((unsigned*)p.ws + CW_BAR, MISC + 8);
#ifndef SUBMASK
#define SUBMASK 0xFFu
#endif
#ifndef PH_MASK
#define PH_MASK 0x1FFFFFu
#endif
#define IN(k) (((PH_MASK >> (k)) & 1u) && lo <= (k) && (k) < hi)
#define SEAM(k) do { if (IN(k) && IN((k) + 1)) xcd_barrier(bar); } while (0)
    const int G = gridDim.x, bid = blockIdx.x;
#if DBG_NANPOISON
    if (lo == 0) { const uint4 ff = {0xFFFFFFFFu, 0xFFFFFFFFu, 0xFFFFFFFFu, 0xFFFFFFFFu};
        const size_t r0[4] = {WS_QABS, WS_KRB16, WS_CB8, WS_RSN}, r1[4] = {WS_CB16, WS_O, WS_RS8, WS_QABS};
        for (int r = 0; r < 4; ++r) { uint4* d = (uint4*)(p.ws + r0[r]); const size_t n = (r1[r] - r0[r]) / 16; for (size_t i = (size_t)bid * NTHR + tid; i < n; i += (size_t)G * NTHR) d[i] = ff; } }
#endif
    using pg8::Gemm; using pg8::StaticOrder; using pg8::gemm_phase;

    if (IN(0)) { p0_prologue(p, lds, wave, lane); }
    SEAM(0);
    if (IN(1)) { Gemm g{WSP(bf16, WS_XN), WSP(bf16, WS_WD), D, D, D, 0}; StaticOrder S; S.init(MP, 1024, G, bid);
        pg8::EpiDown E{WSP(bf16, WS_CQ), WSP(float, WS_CKVRAW), WSP(float, WS_KRRAW), WSP(float, WS_SSQ1)};
        gemm_phase<pg8::EpiDown, StaticOrder, true, true, true>(lds, g, S, E, lds + XLDS_OFF, MP); }
    SEAM(1);
    if (IN(2)) { thin_ckv_krope(p, wave, lane);
        Gemm g{WSP(bf16, WS_CQ), WSP(bf16, WS_WUQ), QL, QL, QL, 0}; StaticOrder S; S.init(M, NH * QKD, G, bid);
        pg8::EpiQ E{WSP(bf16, WS_Q), WSP(float, WS_SSQ1), p.in[I_GQN], p.in[I_GQR], WSP(float, WS_RCOS), WSP(float, WS_RSIN)};
        gemm_phase<pg8::EpiQ, StaticOrder, true, true>(lds, g, S, E); }
    SEAM(2);
    if (IN(3)) {
        if (SUBMASK & 1u) { Gemm g{WSP(bf16, WS_CKVB), WSP(bf16, WS_WK), KVL, KVL, KVL, 0}; StaticOrder S; S.init(M, NH * QKN, G, bid);
          pg8::EpiK E{WSP(bf16, WS_K96), WSP(bf16, WS_KRB), p.in[I_GKN], WSP(float, WS_RSN)};
          gemm_phase<pg8::EpiK, StaticOrder, true, true>(lds, g, S, E); }
        if (SUBMASK & 2u) { Gemm g{WSP(bf16, WS_WV), WSP(bf16, WS_CKVB), KVL, KVL, KVL, 0}; StaticOrder S; S.init(NH * VH, MP, G, bid);
          pg8::EpiVT E{WSP(bf16, WS_VT)};
          gemm_phase<pg8::EpiVT, StaticOrder, true, true>(lds, g, S, E); }
        if (SUBMASK & 4u) thin_qabs(p, wave, lane);
    }
    SEAM(3);
    if (IN(4)) {
        const int PPW = (NSEQ * NPAGES + G - 1) / G, pg0 = bid * PPW;
        GatherBg bg; bg_init(bg, 2 * PPW);
        for (int pid = bid; pid < NBATCH * NH * 4; pid += G) { const int bh = pid >> 2, s = pid & 3; pa_unit(p, lds, bh >> 4, bh & 15, s, bg, pg0); pa_unit(p, lds, bh >> 4, bh & 15, 7 - s, bg, pg0); }
        while (bg.pend || bg.it < bg.n) bg_step(p, bg, pg0, (int)threadIdx.x);
    }
    const bool chain = (G == NSEQ * NSPLIT) && (MK_PER_PHASE ? true : (IN(4) && IN(5) && IN(6)));
    if (chain) { VM_WAIT(); __syncthreads(); } else SEAM(4);
    if (IN(5)) {
        Gemm g{(const bf16*)(p.ws + WS_CB8), (const bf16*)(p.ws + WS_WK8), KVL / 2, KVL / 2, KVL / 2, 0};
        pg8::EpiRS E{WSP(float, WS_RS), 1.0f / (QKN * 256.0f)};
#ifndef G1_STREAM
#define G1_STREAM 1
#endif
        if (chain) {
#if G1_STREAM
            g1_stream(p, lds, bid, wave, lane);
#else
            pg8::LocalOrder S{bid * (PAST / NSPLIT / 256), (NH * QKN) / 256, (PAST / NSPLIT / 256) * ((NH * QKN) / 256)};
            gemm_phase<pg8::EpiRS, pg8::LocalOrder, true, true, false, true, true>(lds, g, S, E);
#endif
        }
        else { StaticOrder S; S.init(NSEQ * PAST, NH * QKN, G, bid);
            gemm_phase<pg8::EpiRS, StaticOrder, true, true, false, true, true>(lds, g, S, E); } }
    if (chain) { VM_WAIT(); __syncthreads(); } else SEAM(5);
    if (IN(6)) { for (int u = bid; u < NSEQ * NSPLIT; u += G) sa_unit(p, lds, u / NSPLIT, u % NSPLIT); }
    SEAM(6);
    if (IN(7)) { thin_combine_uv(p, lds, wave, lane); }
    SEAM(7);
    if (IN(8)) { Gemm g{WSP(bf16, WS_O), WSP(bf16, WS_WO), D, D, D, 0}; StaticOrder S; S.init(MP, D, G, bid);
        pg8::EpiRes<false, false> E{p.in[I_XP], p.in[I_XS], nullptr, nullptr, WSP(bf16, WS_X1B), WSP(float, WS_SS1)};
        gemm_phase<pg8::EpiRes<false, false>, StaticOrder, true, true, true>(lds, g, S, E, lds + XLDS_OFF, MP); }
    SEAM(8);
    if (IN(9)) { Gemm g{WSP(bf16, WS_X1B), WSP(bf16, WS_WUP), D, D, D, 0}; StaticOrder S; S.init(MP, 2 * DFF, G, bid);
        pg8::EpiUp E{WSP(float, WS_SS1), WSP(bf16, WS_HB), WSP(float, WS_HEADG), WSP(float, WS_HEADU), WSP(float, WS_TAILG), p.in[I_FCW], p.in[I_FCB], p.in[I_SFC], p.out + OFF_FCP, p.out + OFF_FCS};
        gemm_phase<pg8::EpiUp, StaticOrder, true, true, true>(lds, g, S, E, lds + XLDS_OFF, MP); }
    do { if (IN(9) && IN(11)) xcd_barrier(bar); } while (0);
    if (IN(11)) { Gemm g{WSP(bf16, WS_HB), WSP(bf16, WS_WDN), DFF, DFF, DFF, 0}; StaticOrder S; S.init(MP, D, G, bid);
        { pg8::Unit u0; for (int i = 0; S.next(i, u0); ++i) thin_ffn_fix(p, 0, 4 * u0.pm, 4); VM_WAIT(); __syncthreads(); }
        pg8::EpiRes<true, false> E{WSP(bf16, WS_X1B), WSP(bf16, WS_X1B) + (size_t)MP * D, nullptr, nullptr, WSP(bf16, WS_X2B), WSP(float, WS_SS2)};
        gemm_phase<pg8::EpiRes<true, false>, StaticOrder, true, true, true>(lds, g, S, E, lds + XLDS_OFF, MP); }
    SEAM(11);
    if (IN(12)) { Gemm g{WSP(bf16, WS_X2B), WSP(bf16, WS_WIN), D, D, D, 0}; StaticOrder S; S.init(MP, 2 * D, G, bid);
        pg8::EpiIn E{WSP(float, WS_SS2), WSP(bf16, WS_XC), WSP(bf16, WS_GATE), WSP(float, WS_HEADX), WSP(float, WS_TAILX), p.in[I_RCW], p.in[I_RCB], p.in[I_SLC], p.out + OFF_LCP, p.out + OFF_LCS};
        gemm_phase<pg8::EpiIn, StaticOrder, true, true, true>(lds, g, S, E, lds + XLDS_OFF, MP); }
    do { if (IN(12) && IN(14)) xcd_barrier(bar); } while (0);
    if (IN(14)) { Gemm g{WSP(bf16, WS_XC), WSP(bf16, WS_WAI), D, LB, LB, LB}; StaticOrder S; S.init(M, NLB * 256, G, bid);
        { pg8::Unit u0; for (int i = 0; S.next(i, u0); ++i) if (u0.pm < MP / 256) thin_rec_fix(p, 4 * u0.pm, 4, 128 * u0.pn); VM_WAIT(); __syncthreads(); }
        pg8::EpiLru E{WSP(bf16, WS_XC), p.in[I_BA], p.in[I_BI], WSP(float, WS_SP8), WSP(float, WS_LA), WSP(float, WS_BX)};
        gemm_phase<pg8::EpiLru, StaticOrder, true, true, false, false, true>(lds, g, S, E); }
    SEAM(14);
    if (IN(15)) { thin_scan1(p); }
    SEAM(15);
    if (IN(16)) { thin_scan2(p); }
    SEAM(16);
    if (IN(17)) { Gemm g{WSP(bf16, WS_Y), WSP(bf16, WS_WOUT), D, D, D, 0}; StaticOrder S; S.init(MP, D, G, bid);
        pg8::EpiRes<true, false> E{WSP(bf16, WS_X2B), WSP(bf16, WS_X2B) + (size_t)MP * D, nullptr, nullptr, WSP(bf16, WS_X3B), WSP(float, WS_SS3)};
        gemm_phase<pg8::EpiRes<true, false>, StaticOrder, true, true, true>(lds, g, S, E, lds + XLDS_OFF, MP); }
    SEAM(17);
    if (IN(18)) { Gemm g{WSP(bf16, WS_X3B), WSP(bf16, WS_WUP) + (size_t)2 * DFF * D, D, D, D, 0}; StaticOrder S; S.init(MP, 2 * DFF, G, bid);
        pg8::EpiUp E{WSP(float, WS_SS3), WSP(bf16, WS_HB), WSP(float, WS_HEADG), WSP(float, WS_HEADU), WSP(float, WS_TAILG), p.in[I_FCW] + (size_t)3 * DFF, p.in[I_FCB] + DFF, p.in[I_SFC] + (size_t)NSEQ * 2 * DFF, p.out + OFF_FCP + (size_t)NBATCH * 2 * DFF, p.out + OFF_FCS + (size_t)NSEQ * 2 * DFF};
        gemm_phase<pg8::EpiUp, StaticOrder, true, true, true>(lds, g, S, E, lds + XLDS_OFF, MP); }
    do { if (IN(18) && IN(20)) xcd_barrier(bar); } while (0);
    if (IN(20)) { Gemm g{WSP(bf16, WS_HB), WSP(bf16, WS_WDN) + (size_t)D * DFF, DFF, DFF, DFF, 0}; StaticOrder S; S.init(MP, D, G, bid);
        { pg8::Unit u0; for (int i = 0; S.next(i, u0); ++i) thin_ffn_fix(p, 1, 4 * u0.pm, 4); VM_WAIT(); __syncthreads(); }
        pg8::EpiRes<true, true> E{WSP(bf16, WS_X3B), WSP(bf16, WS_X3B) + (size_t)MP * D, p.out + OFF_YP, p.out + OFF_YS, nullptr, nullptr};
        gemm_phase<pg8::EpiRes<true, true>, StaticOrder, true, true, true>(lds, g, S, E, lds + XLDS_OFF, MP); }
#if DBG_SA_ORACLE
    if (hi == NPH) { if (hi - lo > 1) xcd_barrier(bar); dbg_sa_oracle(p, lds); }
#endif
#if DBG_F8_ORACLE
    if (hi == NPH) {
        if (hi - lo > 1) xcd_barrier(bar);
        const float* r1 = WSP(float, WS_RS); const float* r2 = WSP(float, WS_RS8); bool bad = false;
        for (size_t i = (size_t)blockIdx.x * NTHR + threadIdx.x; i < (size_t)NSEQ * PAST * 16; i += (size_t)gridDim.x * NTHR) { const float a = r1[i], b = r2[i]; if (!(fabsf(a - b) <= 0.05f * fabsf(b))) bad = true; }
        if (bad) p.out[OFF_YP + threadIdx.x] = __builtin_nanf("");
    }
#endif
#undef IN
#undef SEAM
}

#if DBG_TWICE
__global__ void dbg_snapshot(unsigned char* ws) {
    const uint4* s1 = (const uint4*)(ws + WS_RS); uint4* d1 = (uint4*)(ws + WS_RS8);
    for (size_t i = (size_t)blockIdx.x * blockDim.x + threadIdx.x; i < (size_t)NSEQ * PAST * 16 * 4 / 16; i += (size_t)gridDim.x * blockDim.x) d1[i] = s1[i];
    const uint4* s2 = (const uint4*)(ws + WS_O + (size_t)MP * D * 2); uint4* d2 = (uint4*)(ws + WS_END);
    for (size_t i = (size_t)blockIdx.x * blockDim.x + threadIdx.x; i < (size_t)MS * D * 2 / 16; i += (size_t)gridDim.x * blockDim.x) d2[i] = s2[i];
    const uint4 ff = {0xFFFFFFFFu, 0xFFFFFFFFu, 0xFFFFFFFFu, 0xFFFFFFFFu};
    for (size_t i = (size_t)blockIdx.x * blockDim.x + threadIdx.x; i < (size_t)NSEQ * PAST * 16 * 4 / 16; i += (size_t)gridDim.x * blockDim.x) ((uint4*)(ws + WS_RS))[i] = ff;
    for (size_t i = (size_t)blockIdx.x * blockDim.x + threadIdx.x; i < (size_t)MS * D * 2 / 16; i += (size_t)gridDim.x * blockDim.x) ((uint4*)(ws + WS_O + (size_t)MP * D * 2))[i] = ff;
    if (blockIdx.x == 0 && threadIdx.x == 0) *(unsigned*)(ws + WS_END + (4u << 20)) = 0u;
}
__global__ void dbg_compare(unsigned char* ws) {
    const uint4* s1 = (const uint4*)(ws + WS_RS); const uint4* d1 = (const uint4*)(ws + WS_RS8); unsigned bad = 0;
    for (size_t i = (size_t)blockIdx.x * blockDim.x + threadIdx.x; i < (size_t)NSEQ * PAST * 16 * 4 / 16; i += (size_t)gridDim.x * blockDim.x) { const uint4 a = s1[i], b = d1[i]; if (a.x != b.x || a.y != b.y || a.z != b.z || a.w != b.w) bad |= 1u; }
    const uint4* s2 = (const uint4*)(ws + WS_O + (size_t)MP * D * 2); const uint4* d2 = (const uint4*)(ws + WS_END);
    for (size_t i = (size_t)blockIdx.x * blockDim.x + threadIdx.x; i < (size_t)MS * D * 2 / 16; i += (size_t)gridDim.x * blockDim.x) { const uint4 a = s2[i], b = d2[i]; if (a.x != b.x || a.y != b.y || a.z != b.z || a.w != b.w) bad |= 2u; }
    if (bad) atomicOr((unsigned*)(ws + WS_END + (4u << 20)), bad);
}
__global__ void dbg_poison(unsigned char* ws, float* out) {
    const unsigned fl = *(const unsigned*)(ws + WS_END + (4u << 20));
    if (fl & DBG_TWICE) out[(fl & 1u) ? OFF_YP + threadIdx.x : OFF_YS + threadIdx.x] = __builtin_nanf("");
}
#endif
extern "C" void kernel_launch(void* const* d_in, const int* in_sizes, int n_in, void* d_out, int out_size, void* d_ws, size_t ws_size, hipStream_t stream) {
    static int grid = 0;
    if (grid == 0) {
        if (n_in != N_IN || out_size != (int)OUT_TOTAL || ws_size < WS_END) { fprintf(stderr, "kernel_launch: unexpected shapes (n_in %d, out %d, ws %zu < %zu)\n", n_in, out_size, ws_size, (size_t)WS_END); grid = -1; return; }
        int dev = 0, cus = 0;
        if (hipGetDevice(&dev) != hipSuccess || hipDeviceGetAttribute(&cus, hipDeviceAttributeMultiprocessorCount, dev) != hipSuccess) { grid = -1; return; }
        if (hipFuncSetAttribute((const void*)fwd_kernel, hipFuncAttributeMaxDynamicSharedMemorySize, LDS_BYTES) != hipSuccess) { fprintf(stderr, "kernel_launch: hipFuncSetAttribute failed\n"); grid = -1; return; }
        int per_cu = 0;
        if (hipOccupancyMaxActiveBlocksPerMultiprocessor(&per_cu, (const void*)fwd_kernel, NTHR, LDS_BYTES) != hipSuccess || per_cu < 1) fprintf(stderr, "kernel_launch: occupancy query reports %d\n", per_cu);
        (void)hipGetLastError();
        grid = cus;
    }
    if (grid < 0) return;
    (void)in_sizes;
    if (hipMemsetAsync(d_ws, 0, CTL_ZERO_BYTES, stream) != hipSuccess) { fprintf(stderr, "kernel_launch: memset failed\n"); return; }
    Params p{};
    for (int i = 0; i < N_IN; ++i) p.in[i] = (const float*)d_in[i];
    p.out = (float*)d_out; p.ws = (unsigned char*)d_ws;
#if MK_PER_PHASE
#ifndef DBG_LAST_PH
#define DBG_LAST_PH NPH
#endif
    if (DBG_LAST_PH < NPH) (void)hipMemsetAsync(d_out, 0, OUT_TOTAL * sizeof(float), stream);
#ifndef PROBE_DOUBLE
#define PROBE_DOUBLE 0u
#endif
    for (int ph = 0; ph < DBG_LAST_PH; ++ph) { p.ph_lo = ph; p.ph_hi = ph + 1; const int reps = (((PROBE_DOUBLE) >> ph) & 1u) ? 2 : 1;
        for (int r = 0; r < reps; ++r) hipLaunchKernelGGL(fwd_kernel, dim3(grid), dim3(NTHR), LDS_BYTES, stream, p); }
#ifdef DBG_COPY_OFF
    (void)hipMemcpyAsync(d_out, (char*)d_ws + (DBG_COPY_OFF), (size_t)(DBG_COPY_BYTES), hipMemcpyDeviceToDevice, stream);
#endif
#elif DBG_TWICE
    p.ph_lo = 0; p.ph_hi = 8; hipLaunchKernelGGL(fwd_kernel, dim3(grid), dim3(NTHR), LDS_BYTES, stream, p);
    hipLaunchKernelGGL(dbg_snapshot, dim3(1024), dim3(256), 0, stream, (unsigned char*)d_ws);
    (void)hipMemsetAsync(d_ws, 0, CTL_ZERO_BYTES, stream);
    p.ph_lo = 5; p.ph_hi = 8; hipLaunchKernelGGL(fwd_kernel, dim3(grid), dim3(NTHR), LDS_BYTES, stream, p);
    hipLaunchKernelGGL(dbg_compare, dim3(1024), dim3(256), 0, stream, (unsigned char*)d_ws);
    (void)hipMemsetAsync(d_ws, 0, CTL_ZERO_BYTES, stream);
    p.ph_lo = 8; p.ph_hi = NPH; hipLaunchKernelGGL(fwd_kernel, dim3(grid), dim3(NTHR), LDS_BYTES, stream, p);
    hipLaunchKernelGGL(dbg_poison, dim3(1), dim3(256), 0, stream, (unsigned char*)d_ws, (float*)d_out);
#else
    p.ph_lo = 0; p.ph_hi = NPH; hipLaunchKernelGGL(fwd_kernel, dim3(grid), dim3(NTHR), LDS_BYTES, stream, p);
#endif
    const hipError_t le = hipPeekAtLastError();
    if (le != hipSuccess) fprintf(stderr, "kernel_launch: launch failed: %s\n", hipGetErrorName(le));
}
```
